# Optimizing an MI355X kernel written in HIP

```python
import jax
import jax.numpy as jnp
from jax import lax
import numpy as np

D_MODEL = 1024
BATCH = 4
SEQ = 4096
DEPTH = 2

CTX_LEN = 256
GRID_W = 64
EPS = 1e-6

NA_HEADS = 8
NA_HEAD_DIM = 64
NA_WIN_ROWS = 8
NA_WIN_COLS = 16

GLA_HEADS = 4
GLA_DK = 64
GLA_DV = 128
GLA_RANK = 16
GLA_TAU = 16.0

RET_HEADS = 8
RET_DK = 128
RET_DV = 256

CHUNK = 64
ROPE_BASE = 10000.0

D_FF = 2816
CONV_W = 3

N_EVEN = (DEPTH + 1) // 2
N_ODD = DEPTH // 2

NA_W = NA_HEADS * NA_HEAD_DIM
GLA_QK_W = GLA_HEADS * GLA_DK
GLA_V_W = GLA_HEADS * GLA_DV
EVEN_SIZES = (NA_W, NA_W, NA_W, GLA_QK_W, GLA_QK_W, GLA_V_W, GLA_V_W, GLA_RANK, GLA_RANK)
EVEN_IN = sum(EVEN_SIZES)
EVEN_OUT = NA_W + GLA_V_W
RET_QK_W = RET_HEADS * RET_DK
RET_V_W = RET_HEADS * RET_DV
ODD_SIZES = (RET_QK_W, RET_QK_W, RET_V_W, RET_V_W)
ODD_IN = sum(ODD_SIZES)
ODD_OUT = RET_V_W

kernel_name = "hybrid_na_gla_retention_dit"


def rms_norm(x, g):
    xf = x.astype(jnp.float32)
    y = xf * lax.rsqrt(jnp.mean(xf * xf, axis=-1, keepdims=True) + EPS)
    return (y * g.astype(jnp.float32)).astype(x.dtype)


def group_norm_heads(o, g):
    mu = jnp.mean(o, axis=-1, keepdims=True)
    var = jnp.mean(jnp.square(o - mu), axis=-1, keepdims=True)
    return (o - mu) * lax.rsqrt(var + EPS) * g.astype(jnp.float32)


def split_cols(p, sizes):
    return jnp.split(p, np.cumsum(sizes)[:-1].tolist(), axis=-1)


def to_heads(t, n_heads):
    return t.reshape(t.shape[0], t.shape[1], n_heads, -1)


def to_bhtd(t, n_heads):
    return jnp.swapaxes(to_heads(t, n_heads), 1, 2).astype(jnp.float32)


def rev_time(a):
    return jnp.flip(a, axis=2)


def axial_rope_tables(n_tokens, rot_dim):
    pos = jnp.arange(n_tokens, dtype=jnp.int32)
    row = (pos // GRID_W).astype(jnp.float32)
    col = (pos % GRID_W).astype(jnp.float32)
    axis_dim = rot_dim // 2
    inv_freq = ROPE_BASE ** (-jnp.arange(0, axis_dim, 2, dtype=jnp.float32) / axis_dim)
    ang = jnp.concatenate([row[:, None] * inv_freq, col[:, None] * inv_freq], axis=-1)
    return jnp.cos(ang), jnp.sin(ang)


def apply_axial_rope(x, cos, sin):
    b, t, h, dim = x.shape
    nf = dim // 4
    xr = x.astype(jnp.float32).reshape(b, t, h, 2, 2, nf)
    x1, x2 = xr[..., 0, :], xr[..., 1, :]
    c = cos.reshape(t, 1, 2, nf)
    s = sin.reshape(t, 1, 2, nf)
    out = jnp.stack([x1 * c - x2 * s, x2 * c + x1 * s], axis=-2)
    return out.reshape(b, t, h, dim).astype(x.dtype)


def neighbourhood_attention(q, k, v, kc, vc, rpb):
    bsz, seq, nh, d = q.shape
    rows = seq // GRID_W
    wr = min(NA_WIN_ROWS, rows)
    wc = NA_WIN_COLS
    qg = (q * (d ** -0.5)).reshape(bsz, rows, GRID_W, nh, d)
    kg = k.reshape(bsz, rows, GRID_W, nh, d)
    vg = v.reshape(bsz, rows, GRID_W, nh, d)
    cols = jnp.arange(GRID_W)
    col_start = jnp.clip(cols - wc // 2, 0, GRID_W - wc)
    col_idx = col_start[:, None] + jnp.arange(wc)[None, :]
    col_off = col_idx - cols[:, None] + (NA_WIN_COLS - 1)
    bias_c = rpb[:, :, col_off]

    def row_block(r):
        r0 = jnp.clip(r - wr // 2, 0, rows - wr)
        k_strip = lax.dynamic_slice_in_dim(kg, r0, wr, axis=1)
        v_strip = lax.dynamic_slice_in_dim(vg, r0, wr, axis=1)
        k_win = k_strip[:, :, col_idx]
        v_win = v_strip[:, :, col_idx]
        q_r = lax.dynamic_index_in_dim(qg, r, axis=1, keepdims=False)
        row_off = r0 + jnp.arange(wr) - r + (NA_WIN_ROWS - 1)
        bias = jnp.transpose(bias_c[:, row_off], (0, 2, 1, 3))
        s_loc = jnp.einsum('bqhd,biqjhd->bhqij', q_r, k_win) + bias[None]
        s_ctx = jnp.einsum('bqhd,bkhd->bhqk', q_r, kc)
        s = jnp.concatenate([s_loc.reshape(bsz, nh, GRID_W, wr * wc), s_ctx], axis=-1)
        p = jax.nn.softmax(s.astype(jnp.float32), axis=-1).astype(v.dtype)
        p_loc = p[..., :wr * wc].reshape(bsz, nh, GRID_W, wr, wc)
        p_ctx = p[..., wr * wc:]
        return (jnp.einsum('bhqij,biqjhd->bqhd', p_loc, v_win)
                + jnp.einsum('bhqk,bkhd->bqhd', p_ctx, vc))

    out = lax.map(row_block, jnp.arange(rows))
    return jnp.moveaxis(out, 0, 1).reshape(bsz, seq, nh * d)


def context_attention(qc, kc, vc):
    scale = qc.shape[-1] ** -0.5
    s = jnp.einsum('bqhd,bkhd->bhqk', qc * scale, kc).astype(jnp.float32)
    p = jax.nn.softmax(s, axis=-1).astype(vc.dtype)
    o = jnp.einsum('bhqk,bkhd->bqhd', p, vc)
    return o.reshape(o.shape[0], o.shape[1], -1)


def gla_chunked(q, k, v, g, state0):
    bsz, nh, t, dk = q.shape
    dv = v.shape[-1]
    n = t // CHUNK
    q = q.reshape(bsz, nh, n, CHUNK, dk)
    k = k.reshape(bsz, nh, n, CHUNK, dk)
    v = v.reshape(bsz, nh, n, CHUNK, dv)
    b = jnp.cumsum(g.reshape(bsz, nh, n, CHUNK, dk), axis=3)
    b_last = b[:, :, :, -1:, :]
    q_in = q * jnp.exp(b)
    k_in = k * jnp.exp(-b)
    mask = jnp.tril(jnp.ones((CHUNK, CHUNK), dtype=bool))
    att = jnp.where(mask, jnp.einsum('bhnid,bhnjd->bhnij', q_in, k_in), 0.0)
    o_intra = jnp.einsum('bhnij,bhnjv->bhniv', att, v)
    chunk_kv = jnp.einsum('bhnjd,bhnjv->bhndv', k * jnp.exp(b_last - b), v)
    chunk_decay = jnp.exp(b_last[:, :, :, 0, :])

    def step(s, inp):
        dec, kv = inp
        return dec[..., None] * s + kv, s

    s_final, s_start = lax.scan(step, state0, (jnp.moveaxis(chunk_decay, 2, 0), jnp.moveaxis(chunk_kv, 2, 0)))
    s_start = jnp.moveaxis(s_start, 0, 2)
    o_inter = jnp.einsum('bhnid,bhndv->bhniv', q_in, s_start)
    return (o_intra + o_inter).reshape(bsz, nh, t, dv), s_final


def retention_chunked(q, k, v, log_gamma, state0):
    bsz, nh, t, dk = q.shape
    dv = v.shape[-1]
    n = t // CHUNK
    q = q.reshape(bsz, nh, n, CHUNK, dk)
    k = k.reshape(bsz, nh, n, CHUNK, dk)
    v = v.reshape(bsz, nh, n, CHUNK, dv)
    idx = jnp.arange(CHUNK, dtype=jnp.float32)
    lg = log_gamma.astype(jnp.float32)[:, None]
    diff = idx[:, None] - idx[None, :]
    decay = jnp.where(diff >= 0, jnp.exp(lg[:, :, None] * jnp.maximum(diff, 0.0)), 0.0)
    att = jnp.einsum('bhnid,bhnjd->bhnij', q, k) * decay[None, :, None]
    o_intra = jnp.einsum('bhnij,bhnjv->bhniv', att, v)
    q_dec = jnp.exp(lg * (idx + 1.0))[None, :, None, :, None]
    k_dec = jnp.exp(lg * (CHUNK - 1.0 - idx))[None, :, None, :, None]
    chunk_kv = jnp.einsum('bhnjd,bhnjv->bhndv', k * k_dec, v)
    chunk_decay = jnp.exp(lg * CHUNK)[None, :, :, None]

    def step(s, kv):
        return chunk_decay * s + kv, s

    s_final, s_start = lax.scan(step, state0, jnp.moveaxis(chunk_kv, 2, 0))
    s_start = jnp.moveaxis(s_start, 0, 2)
    o_inter = jnp.einsum('bhnid,bhndv->bhniv', q * q_dec, s_start)
    return (o_intra + o_inter).reshape(bsz, nh, t, dv), s_final


def na_gla_mixer(h, hc, w_in, w_out, rpb, w_a_fwd, b_a_fwd, w_a_bwd, b_a_bwd, norm_g, need_ctx):
    f32 = jnp.float32
    bsz = h.shape[0]
    na_q, na_k, na_v, gq, gk, gv, gr, ga_f, ga_b = split_cols(h @ w_in, EVEN_SIZES)
    na_qc, na_kc, na_vc, gqc, gkc, gvc, grc, gac_f, gac_b = split_cols(hc @ w_in, EVEN_SIZES)

    kc_na, vc_na = to_heads(na_kc, NA_HEADS), to_heads(na_vc, NA_HEADS)
    a_lat = neighbourhood_attention(to_heads(na_q, NA_HEADS), to_heads(na_k, NA_HEADS),
                                    to_heads(na_v, NA_HEADS), kc_na, vc_na, rpb)

    def log_gate(a, w, b):
        z = (a @ w + b).astype(f32)
        return to_bhtd(jax.nn.log_sigmoid(z), GLA_HEADS) / GLA_TAU

    def gla_qkvg(q, k, v, a_f, a_b):
        return (to_bhtd(q, GLA_HEADS) * GLA_DK ** -0.5, to_bhtd(k, GLA_HEADS), to_bhtd(v, GLA_HEADS),
                log_gate(a_f, w_a_fwd, b_a_fwd), log_gate(a_b, w_a_bwd, b_a_bwd))

    q, k, v, g_f, g_b = gla_qkvg(gq, gk, gv, ga_f, ga_b)
    qc, kc, vc, gc_f, gc_b = gla_qkvg(gqc, gkc, gvc, gac_f, gac_b)
    zero = jnp.zeros((bsz, GLA_HEADS, GLA_DK, GLA_DV), f32)
    oc_f, s_f = gla_chunked(qc, kc, vc, gc_f, zero)
    oc_b, s_b = gla_chunked(rev_time(qc), rev_time(kc), rev_time(vc), rev_time(gc_b), zero)
    o_f, _ = gla_chunked(q, k, v, g_f, s_f)
    o_b, _ = gla_chunked(rev_time(q), rev_time(k), rev_time(v), rev_time(g_b), s_b)

    def gla_readout(o, r):
        o = rms_norm(jnp.swapaxes(o, 1, 2), norm_g)
        o = o.reshape(o.shape[0], o.shape[1], -1) * jax.nn.silu(r.astype(f32))
        return o.astype(h.dtype)

    y = jnp.concatenate([a_lat, gla_readout(o_f + rev_time(o_b), gr)], axis=-1) @ w_out
    if not need_ctx:
        return y, None
    a_ctx = context_attention(to_heads(na_qc, NA_HEADS), kc_na, vc_na)
    yc = jnp.concatenate([a_ctx, gla_readout(oc_f + rev_time(oc_b), grc)], axis=-1) @ w_out
    return y, yc


def retention_mixer(h, hc, w_in, w_out, decay_fwd, decay_bwd, norm_g, rope_cos, rope_sin, need_ctx):
    f32 = jnp.float32
    bsz = h.shape[0]
    q, k, v, g = split_cols(h @ w_in, ODD_SIZES)
    qc, kc, vc, gc = split_cols(hc @ w_in, ODD_SIZES)
    q = jnp.swapaxes(apply_axial_rope(to_heads(q, RET_HEADS), rope_cos, rope_sin), 1, 2).astype(f32)
    k = jnp.swapaxes(apply_axial_rope(to_heads(k, RET_HEADS), rope_cos, rope_sin), 1, 2).astype(f32) * RET_DK ** -0.5
    v = to_bhtd(v, RET_HEADS)
    qc = to_bhtd(qc, RET_HEADS)
    kc = to_bhtd(kc, RET_HEADS) * RET_DK ** -0.5
    vc = to_bhtd(vc, RET_HEADS)
    lg_f = jax.nn.log_sigmoid(decay_fwd.astype(f32))
    lg_b = jax.nn.log_sigmoid(decay_bwd.astype(f32))
    zero = jnp.zeros((bsz, RET_HEADS, RET_DK, RET_DV), f32)
    oc_f, s_f = retention_chunked(qc, kc, vc, lg_f, zero)
    oc_b, s_b = retention_chunked(rev_time(qc), rev_time(kc), rev_time(vc), lg_b, zero)
    o_f, _ = retention_chunked(q, k, v, lg_f, s_f)
    o_b, _ = retention_chunked(rev_time(q), rev_time(k), rev_time(v), lg_b, s_b)

    def readout(o, gate):
        o = group_norm_heads(jnp.swapaxes(o, 1, 2), norm_g)
        o = o.reshape(o.shape[0], o.shape[1], -1) * jax.nn.silu(gate.astype(f32))
        return o.astype(h.dtype) @ w_out

    y = readout(o_f + rev_time(o_b), g)
    if not need_ctx:
        return y, None
    return y, readout(oc_f + rev_time(oc_b), gc)


def conv_ffn(h, w_up, conv_w, conv_b, w_down):
    u = h @ w_up
    t = u.shape[1]
    pad = CONV_W // 2
    up = jnp.pad(u, ((0, 0), (pad, pad), (0, 0)))
    u = sum(up[:, i:i + t] * conv_w[i] for i in range(CONV_W)) + conv_b
    a, b = jnp.split(u, 2, axis=-1)
    return (jax.nn.silu(a) * b) @ w_down


def setup_inputs(seed: int = 0) -> dict:
    key = jax.random.key(seed)
    keys = iter(jax.random.split(key, 32))
    f32 = jnp.float32

    def normal(shape, scale):
        return jax.random.normal(next(keys), shape, f32) * scale

    def gain(shape):
        return 1.0 + normal(shape, 0.02)

    D = D_MODEL
    ret_decay_init = jnp.log(2.0 ** (5.0 + jnp.arange(RET_HEADS, dtype=f32)) - 1.0)
    return {
        "x": normal((BATCH, SEQ, D), 1.0),
        "c": normal((BATCH, D), 1.0),
        "ctx": normal((BATCH, CTX_LEN, D), 1.0),
        "c_ctx": normal((D,), 1.0),
        "w_mod": normal((DEPTH, D, 6 * D), 0.5 * D ** -0.5),
        "b_mod": normal((DEPTH, 6 * D), 0.02),
        "norm1_g": gain((DEPTH, D)),
        "norm2_g": gain((DEPTH, D)),
        "na_gla_w_in": normal((N_EVEN, D, EVEN_IN), D ** -0.5),
        "na_gla_w_out": normal((N_EVEN, EVEN_OUT, D), EVEN_OUT ** -0.5),
        "na_rpb": normal((N_EVEN, NA_HEADS, 2 * NA_WIN_ROWS - 1, 2 * NA_WIN_COLS - 1), 0.1),
        "gla_w_a_fwd": normal((N_EVEN, GLA_RANK, GLA_QK_W), GLA_RANK ** -0.5),
        "gla_b_a_fwd": normal((N_EVEN, GLA_QK_W), 0.1),
        "gla_w_a_bwd": normal((N_EVEN, GLA_RANK, GLA_QK_W), GLA_RANK ** -0.5),
        "gla_b_a_bwd": normal((N_EVEN, GLA_QK_W), 0.1),
        "gla_norm_g": gain((N_EVEN, GLA_DV)),
        "ret_w_in": normal((N_ODD, D, ODD_IN), D ** -0.5),
        "ret_w_out": normal((N_ODD, ODD_OUT, D), ODD_OUT ** -0.5),
        "ret_decay_fwd": ret_decay_init + normal((N_ODD, RET_HEADS), 0.05),
        "ret_decay_bwd": ret_decay_init + normal((N_ODD, RET_HEADS), 0.05),
        "ret_norm_g": gain((N_ODD, RET_HEADS, RET_DV)),
        "ffn_w_up": normal((DEPTH, D, 2 * D_FF), D ** -0.5),
        "ffn_conv_w": normal((DEPTH, CONV_W, 2 * D_FF), CONV_W ** -0.5),
        "ffn_conv_b": normal((DEPTH, 2 * D_FF), 0.02),
        "ffn_w_down": normal((DEPTH, D_FF, D), D_FF ** -0.5),
        "final_norm_g": gain((D,)),
    }


def reference(x, c, ctx, c_ctx, w_mod, b_mod, norm1_g, norm2_g, na_gla_w_in, na_gla_w_out, na_rpb,
              gla_w_a_fwd, gla_b_a_fwd, gla_w_a_bwd, gla_b_a_bwd, gla_norm_g,
              ret_w_in, ret_w_out, ret_decay_fwd, ret_decay_bwd, ret_norm_g,
              ffn_w_up, ffn_conv_w, ffn_conv_b, ffn_w_down, final_norm_g):
    seq = x.shape[1]
    rope_cos, rope_sin = axial_rope_tables(seq, RET_DK)
    silu_c = jax.nn.silu(c)
    silu_cc = jax.nn.silu(c_ctx)
    xc = ctx
    for layer in range(DEPTH):
        need_ctx = layer < DEPTH - 1
        mod = silu_c @ w_mod[layer] + b_mod[layer]
        mod_c = silu_cc @ w_mod[layer] + b_mod[layer]
        sh1, sc1, g1, sh2, sc2, g2 = jnp.split(mod[:, None, :], 6, axis=-1)
        sh1c, sc1c, g1c, sh2c, sc2c, g2c = jnp.split(mod_c, 6, axis=-1)
        h = rms_norm(x, norm1_g[layer]) * (1.0 + sc1) + sh1
        hc = rms_norm(xc, norm1_g[layer]) * (1.0 + sc1c) + sh1c
        j = layer // 2
        if layer % 2 == 0:
            y, yc = na_gla_mixer(h, hc, na_gla_w_in[j], na_gla_w_out[j], na_rpb[j],
                                 gla_w_a_fwd[j], gla_b_a_fwd[j], gla_w_a_bwd[j], gla_b_a_bwd[j],
                                 gla_norm_g[j], need_ctx)
        else:
            y, yc = retention_mixer(h, hc, ret_w_in[j], ret_w_out[j], ret_decay_fwd[j], ret_decay_bwd[j],
                                    ret_norm_g[j], rope_cos, rope_sin, need_ctx)
        x = x + g1 * y
        h2 = rms_norm(x, norm2_g[layer]) * (1.0 + sc2) + sh2
        x = x + g2 * conv_ffn(h2, ffn_w_up[layer], ffn_conv_w[layer], ffn_conv_b[layer], ffn_w_down[layer])
        if need_ctx:
            xc = xc + g1c * yc
            hc2 = rms_norm(xc, norm2_g[layer]) * (1.0 + sc2c) + sh2c
            xc = xc + g2c * conv_ffn(hc2, ffn_w_up[layer], ffn_conv_w[layer], ffn_conv_b[layer], ffn_w_down[layer])
    return rms_norm(x, final_norm_g)
```

```cpp
#include <hip/hip_runtime.h>
#include <cstdio>
#include <cstdint>
namespace pg8 {
#define PG8_LAS __attribute__((address_space(3)))
typedef unsigned short bf16_t;
typedef short bf16x8 __attribute__((ext_vector_type(8)));
typedef float f32x4 __attribute__((ext_vector_type(4)));
typedef unsigned u32x4 __attribute__((ext_vector_type(4)));
constexpr int BM = 256, BK = 64, HALF = 128, HTB = HALF * BK * 2  , STAGE_BYTES = 8 * HTB, NXCD = 8, WGM = 8;

__host__ __device__ __forceinline__ int lds_byte(int r, int c) { const int st = (r >> 4) * 2 + (c >> 5), rr = r & 15, cc = c & 31, ob = rr * 64 + cc * 2; return st * 1024 + (ob ^ (((ob >> 9) & 1) << 5)); }
__host__ __device__ __forceinline__ void stage_rc(int b, int& R, int& C) { const int st = b / 1024, sb = b % 1024, swz = sb ^ (((sb >> 9) & 1) << 5); R = (st >> 1) * 16 + swz / 64; C = (st & 1) * 32 + (swz % 64) / 2; }
__host__ __device__ __forceinline__ int perm32(int rho) { const int n = rho >> 4, i = rho & 15; return 8 * (i >> 2) + 4 * n + (i & 3); }

struct Unit { int pm, pn; };
struct Gemm { const bf16_t* A; const bf16_t* Bt; int M, N, K; };

struct StaticOrder {
    int nM, nN, nwg, G, c;
    __host__ __device__ void init(int M, int N, int G_, int c_) { nM = M / BM; nN = N / BM; nwg = nM * nN; G = G_; c = c_; }
    __host__ __device__ bool next(int i, Unit& u) const {
        const long L = (long)i * G + c; if (L >= nwg) return false;
        int wgid = (int)L; { const int q = nwg / NXCD, r = nwg % NXCD, xcd = wgid % NXCD, off = wgid / NXCD; wgid = (xcd < r ? xcd * (q + 1) : r * (q + 1) + (xcd - r) * q) + off; }
        const int nig = WGM * nN, gid = wgid / nig, fm = gid * WGM, gsz = (nM - fm) < WGM ? (nM - fm) : WGM;
        u.pm = fm + ((wgid % nig) % gsz); u.pn = (wgid % nig) / gsz; return true;
    }
    __device__ __forceinline__ void a_ready(const Unit&) const {}
    __device__ __forceinline__ void done(const Unit&) const {}
};

__device__ __forceinline__ unsigned cvt_pk_bf16(float lo, float hi) { unsigned r; asm volatile("v_cvt_pk_bf16_f32 %0, %1, %2" : "=v"(r) : "v"(lo), "v"(hi)); return r; }

constexpr size_t PJ_MiB = 1u << 20;
constexpr size_t PJ0_NAQ = 79 * PJ_MiB, PJ0_NAK = 96 * PJ_MiB, PJ0_NAV = 113 * PJ_MiB, PJ0_GQ = 130 * PJ_MiB, PJ0_GK = PJ0_GQ + 8704 * 1024, PJ0_GV = 147 * PJ_MiB, PJ0_GR = 164 * PJ_MiB, PJ0_GA = 181 * PJ_MiB;
constexpr size_t PJ1_RQ = 54 * PJ_MiB, PJ1_RK = 86 * PJ_MiB, PJ1_RV = 120 * PJ_MiB, PJ1_RG = 188 * PJ_MiB, PJ1_ROPE = 1 * PJ_MiB + 512 * 1024;
typedef float f32x2 __attribute__((ext_vector_type(2)));
typedef unsigned u32x2 __attribute__((ext_vector_type(2)));
__device__ __forceinline__ void store8bf(bf16_t* p, f32x4 v0, f32x4 v1) {
    u32x4 w; w.x = cvt_pk_bf16(v0[0], v0[1]); w.y = cvt_pk_bf16(v0[2], v0[3]); w.z = cvt_pk_bf16(v1[0], v1[1]); w.w = cvt_pk_bf16(v1[2], v1[3]);
    *(u32x4*)p = w;
}
struct EpiProj0 {
    static constexpr bool PERM = true, AFTER_DRAIN = false;
    unsigned char* ws;
    __device__ __forceinline__ void operator()(const f32x4 (&acc)[2][2][4][2], const Unit& u, int wr, int wc, int fr, int fq) const {
#pragma unroll
        for (int ai = 0; ai < 2; ++ai)
#pragma unroll
            for (int m = 0; m < 4; ++m) {
                const int row = u.pm * BM + ai * HALF + wr * 64 + m * 16 + fr;
                int b, rin; if (row < 16384) { b = row >> 12; rin = row & 4095; } else { b = (row - 16384) >> 8; rin = 4096 + ((row - 16384) & 255); }
#pragma unroll
                for (int bj = 0; bj < 2; ++bj) {
                    const int C0 = u.pn * BM + bj * HALF;
                    const f32x4 v0 = acc[ai][bj][m][0], v1 = acc[ai][bj][m][1];
                    if (C0 < 1536) {
                        const int t = C0 >> 9, head = ((C0 & 511) >> 6) + (wc >> 1), d = 32 * (wc & 1) + 8 * fq;
                        bf16_t* base = (bf16_t*)(ws + (t == 0 ? PJ0_NAQ : (t == 1 ? PJ0_NAK : PJ0_NAV))); const float sc = t == 0 ? 0.125f : 1.0f;
                        store8bf(base + ((size_t)((b * 8 + head) * 4352 + rin) * 64 + d), v0 * sc, v1 * sc);
                    } else if (C0 < 2048) {
                        const bool isq = C0 < 1792; bf16_t* base = (bf16_t*)(ws + (isq ? PJ0_GQ : PJ0_GK)); const int cb = C0 - (isq ? 1536 : 1792); const float sc = isq ? 0.125f : 1.0f;
                        store8bf(base + (size_t)row * 256 + cb + 32 * wc + 8 * fq, v0 * sc, v1 * sc);
                    } else if (C0 < 3072) {
                        const bool isv = C0 < 2560; bf16_t* base = (bf16_t*)(ws + (isv ? PJ0_GV : PJ0_GR)); const int cb = C0 - (isv ? 2048 : 2560);
                        store8bf(base + (size_t)row * 512 + cb + 32 * wc + 8 * fq, v0, v1);
                    } else if (C0 == 3072) {
                        if (wc == 0) { float* p = (float*)(ws + PJ0_GA) + (size_t)row * 32 + 8 * fq; *(f32x4*)p = v0; *(f32x4*)(p + 4) = v1; }
                    }
                }
            }
    }
};
struct EpiRes {
    static constexpr bool PERM = false, AFTER_DRAIN = false;
    const float* baseL; const float* baseC; float* outL; float* outC; const float* gate;
    __device__ __forceinline__ void operator()(const f32x4 (&acc)[2][2][4][2], const Unit& u, int wr, int wc, int fr, int fq) const {
        const bool lat = u.pm < 64; const int tm = lat ? u.pm : u.pm - 64, bi = lat ? (u.pm >> 4) : 4;
        const float* base = (lat ? baseL : baseC) + (size_t)tm * BM * 1024; float* out = (lat ? outL : outC) + (size_t)tm * BM * 1024;
        const int col0 = u.pn * BM + wc * 32 + 4 * fq;
        f32x4 gv[2][2];
#pragma unroll
        for (int bj = 0; bj < 2; ++bj)
#pragma unroll
            for (int n = 0; n < 2; ++n) gv[bj][n] = *(const f32x4*)(gate + bi * 6144 + col0 + bj * HALF + n * 16);
#pragma unroll
        for (int ai = 0; ai < 2; ++ai)
#pragma unroll
            for (int m = 0; m < 4; ++m) { const size_t off = (size_t)(ai * HALF + wr * 64 + m * 16 + fr) * 1024 + col0;
#pragma unroll
                for (int bj = 0; bj < 2; ++bj)
#pragma unroll
                    for (int n = 0; n < 2; ++n) { const f32x4 bs = *(const f32x4*)(base + off + bj * HALF + n * 16); *(f32x4*)(out + off + bj * HALF + n * 16) = bs + gv[bj][n] * acc[ai][bj][m][n]; }
                if (m & 1) asm volatile("" ::: "memory"); }
    }
};
template <int CTRL> __device__ __forceinline__ float dpp_mov(float old, float src) {
    return __builtin_bit_cast(float, __builtin_amdgcn_update_dpp(__builtin_bit_cast(int, old), __builtin_bit_cast(int, src), CTRL, 0xf, 0xf, false));
}
struct EpiUp {
    static constexpr bool PERM = true, AFTER_DRAIN = false;
    bf16_t* act; float* edge; const float* cw; const float* cb;
    template <int M> __device__ __forceinline__ f32x4 conv_m(const f32x4 (&acc)[4][2], int n, const f32x4& w0, const f32x4& w1, const f32x4& w2, const f32x4& bs) const {
        f32x4 y;
#pragma unroll
        for (int e = 0; e < 4; ++e) {
            const float x = acc[M][n][e];
            const float tp = M > 0 ? dpp_mov<0x121>(0.f, acc[M > 0 ? M - 1 : 0][n][e]) : 0.f;
            const float pv = dpp_mov<0x111>(tp, x);
            const float tn = M < 3 ? dpp_mov<0x12F>(0.f, acc[M < 3 ? M + 1 : 3][n][e]) : 0.f;
            const float nx = dpp_mov<0x101>(tn, x);
            y[e] = w0[e] * pv + w1[e] * x + w2[e] * nx + bs[e];
        }
        return y;
    }
    template <int M> __device__ __forceinline__ void row_m(const f32x4 (&aa)[4][2], const f32x4 (&ab)[4][2], int n, const f32x4 (&wa)[4], const f32x4 (&wb)[4], int blk, int fr, int jn) const {
        f32x4 ya = conv_m<M>(aa, n, wa[0], wa[1], wa[2], wa[3]);
#pragma unroll
        for (int e = 0; e < 4; ++e) { const float a = ya[e]; ya[e] = a * __builtin_amdgcn_rcpf(1.0f + __expf(-a)); }
        const f32x4 yb = conv_m<M>(ab, n, wb[0], wb[1], wb[2], wb[3]);
        const f32x4 r = ya * yb;
        u32x2 w; w.x = cvt_pk_bf16(r[0], r[1]); w.y = cvt_pk_bf16(r[2], r[3]);
        const bool is_edge = (M == 0 && fr == 0) || (M == 3 && fr == 15);
        if (!is_edge) *(u32x2*)(act + (size_t)(blk * 64 + M * 16 + fr) * 2816 + jn) = w;
        if (M == 0) { if (fr < 2) { float* p = edge + ((size_t)(blk * 4 + fr) * 5632 + jn); *(f32x4*)p = aa[0][n]; *(f32x4*)(p + 2816) = ab[0][n]; } }
        if (M == 3) { if (fr >= 14) { float* p = edge + ((size_t)(blk * 4 + fr - 12) * 5632 + jn); *(f32x4*)p = aa[3][n]; *(f32x4*)(p + 2816) = ab[3][n]; } }
        asm volatile("" ::: "memory");
    }
    __device__ __forceinline__ void operator()(const f32x4 (&acc)[2][2][4][2], const Unit& u, int wr, int wc, int fr, int fq) const {
        const int j0 = u.pn * 128 + wc * 32 + 8 * fq;
#pragma unroll
        for (int n = 0; n < 2; ++n) {
            const int jn = j0 + 4 * n;
            f32x4 wa[4], wb[4];
#pragma unroll
            for (int i = 0; i < 3; ++i) { wa[i] = *(const f32x4*)(cw + i * 5632 + jn); wb[i] = *(const f32x4*)(cw + i * 5632 + 2816 + jn); }
            wa[3] = *(const f32x4*)(cb + jn); wb[3] = *(const f32x4*)(cb + 2816 + jn);
#pragma unroll
            for (int ai = 0; ai < 2; ++ai) {
                const int blk = u.pm * 4 + ai * 2 + wr;
                row_m<0>(acc[ai][0], acc[ai][1], n, wa, wb, blk, fr, jn);
                row_m<1>(acc[ai][0], acc[ai][1], n, wa, wb, blk, fr, jn);
                row_m<2>(acc[ai][0], acc[ai][1], n, wa, wb, blk, fr, jn);
                row_m<3>(acc[ai][0], acc[ai][1], n, wa, wb, blk, fr, jn);
            }
        }
    }
};
struct EpiProj1 {
    static constexpr bool PERM = true, AFTER_DRAIN = false;
    unsigned char* ws;
    __device__ __forceinline__ void operator()(const f32x4 (&acc)[2][2][4][2], const Unit& u, int wr, int wc, int fr, int fq) const {
#pragma unroll
        for (int ai = 0; ai < 2; ++ai)
#pragma unroll
            for (int m = 0; m < 4; ++m) {
                const int row = u.pm * BM + ai * HALF + wr * 64 + m * 16 + fr; const bool lat = u.pm < 64;
                const int s = row & 4095, pos = (wc >> 1) == 0 ? (s >> 6) : (s & 63);
#pragma unroll
                for (int bj = 0; bj < 2; ++bj) {
                    const int C0 = u.pn * BM + bj * HALF;
                    f32x4 v0 = acc[ai][bj][m][0], v1 = acc[ai][bj][m][1];
                    if (C0 < 2048) {
                        const bool isq = C0 < 1024; if (isq && !lat) continue;
                        if (lat) {
                            const f32x2* rp = (const f32x2*)(ws + PJ1_ROPE) + pos * 32 + 16 * (wc & 1) + 4 * fq;
                            const f32x4 cs0 = *(const f32x4*)rp, cs1 = *(const f32x4*)(rp + 2);
                            const f32x4 c = {cs0[0], cs0[2], cs1[0], cs1[2]}, sn = {cs0[1], cs0[3], cs1[1], cs1[3]};
                            const f32x4 o1 = v0 * c - v1 * sn, o2 = v1 * c + v0 * sn; v0 = o1; v1 = o2;
                        }
                        if (!isq) { v0 = v0 * 0.08838834764831845f; v1 = v1 * 0.08838834764831845f; }
                        store8bf((bf16_t*)(ws + (isq ? PJ1_RQ : PJ1_RK)) + (size_t)row * 1024 + (C0 & 1023) + 32 * wc + 8 * fq, v0, v1);
                    } else if (C0 < 4096) {
                        store8bf((bf16_t*)(ws + PJ1_RV) + (size_t)row * 2048 + (C0 - 2048) + 32 * wc + 8 * fq, v0, v1);
                    } else {
                        if (lat) store8bf((bf16_t*)(ws + PJ1_RG) + (size_t)row * 2048 + (C0 - 4096) + 32 * wc + 8 * fq, v0, v1);
                    }
                }
            }
    }
};

template <class Epi, class Sched, bool ALIGN_EPI = false, bool SP2 = false>
__device__ __forceinline__ void gemm_phase(PG8_LAS unsigned char* lds, const Gemm g, const Sched& S, const Epi& E) {
    const int tid = threadIdx.x, wid = __builtin_amdgcn_readfirstlane(tid >> 6), lane = tid & 63, wr = wid >> 2, wc = wid & 3, fr = lane & 15, fq = lane >> 4;
    const int K = g.K, nt = K / BK;
    unsigned voffA[2], voffB[2];
#pragma unroll
    for (int i = 0; i < 2; ++i) { int R, C; stage_rc(tid * 16 + i * 8192, R, C); const int Rb = Epi::PERM ? ((R & ~31) + perm32(R & 31)) : R;
        voffA[i] = (unsigned)(R * K + C) * 2u; voffB[i] = (unsigned)(Rb * K + C) * 2u; }
    const size_t kstep = (size_t)(BK * 2);
    const size_t hstep = (size_t)HALF * K * 2;
    const size_t tstep = 2 * hstep;
    const unsigned ldsw = (unsigned)wid * 1024u;
    const int aoff = lds_byte(wr * 64 + fr, fq * 8), boff = lds_byte(wc * 32 + fr, fq * 8);
#define PG8_SA(b, h) (((b) * 2 + (h)) * HTB)
#define PG8_SB(b, h) ((4 + (b) * 2 + (h)) * HTB)
#define PG8_STAGE(bufoff, gbase, voff) do { _Pragma("unroll") for (int _i = 0; _i < 2; ++_i) \
        __builtin_amdgcn_global_load_lds((const unsigned*)((const char*)(gbase) + (voff)[_i]), (PG8_LAS unsigned*)(lds + (bufoff) + ldsw + _i * 8192), 16, 0, 0); } while (0)
#define PG8_LDA(dst, b, h) do { _Pragma("unroll") for (int m = 0; m < 4; ++m) _Pragma("unroll") for (int k = 0; k < 2; ++k) dst[m][k] = *(const PG8_LAS bf16x8*)(lds + PG8_SA(b, h) + aoff + m * 2048 + k * 1024); } while (0)
#define PG8_LDB(dst, b, h) do { _Pragma("unroll") for (int n = 0; n < 2; ++n) _Pragma("unroll") for (int k = 0; k < 2; ++k) dst[n][k] = *(const PG8_LAS bf16x8*)(lds + PG8_SB(b, h) + boff + n * 2048 + k * 1024); } while (0)
#define PG8_MMA(ai, bj, At, Bt) do { __builtin_amdgcn_s_setprio(1); _Pragma("unroll") for (int m = 0; m < 4; ++m) _Pragma("unroll") for (int n = 0; n < 2; ++n) _Pragma("unroll") for (int k = 0; k < 2; ++k) \
        acc[ai][bj][m][n] = __builtin_amdgcn_mfma_f32_16x16x32_bf16(Bt[n][k], At[m][k], acc[ai][bj][m][n], 0, 0, 0); __builtin_amdgcn_s_setprio(0); } while (0)
#define PG8_WAIT_V(n) asm volatile("s_waitcnt vmcnt(" #n ")" ::: "memory")
#define PG8_WAIT_L(n) asm volatile("s_waitcnt lgkmcnt(" #n ")" ::: "memory")
#define PG8_BAR __builtin_amdgcn_s_barrier()
#define PG8_SCHED __builtin_amdgcn_sched_barrier(0)
    Unit cur, nxt; int ui = 0;
    if (!S.next(0, cur)) return;
    f32x4 acc[2][2][4][2];
#pragma unroll
    for (int a = 0; a < 2; ++a)
#pragma unroll
        for (int b = 0; b < 2; ++b)
#pragma unroll
            for (int m = 0; m < 4; ++m)
#pragma unroll
                for (int n = 0; n < 2; ++n) acc[a][b][m][n] = (f32x4){0.f, 0.f, 0.f, 0.f};
    bf16x8 At[4][2], B0[2][2], B1[2][2];
    const char* cA = (const char*)g.A + (size_t)cur.pm * tstep; const char* cB = (const char*)g.Bt + (size_t)cur.pn * tstep;
    S.a_ready(cur);
    if constexpr (SP2) {
        PG8_STAGE(PG8_SB(0, 0), cB, voffB); PG8_STAGE(PG8_SB(0, 1), cB + hstep, voffB); PG8_STAGE(PG8_SA(0, 0), cA, voffA); PG8_STAGE(PG8_SA(0, 1), cA + hstep, voffA);
        if (wr == 1) PG8_BAR;
        PG8_WAIT_V(2); PG8_BAR;
        PG8_STAGE(PG8_SB(1, 0), cB + kstep, voffB); PG8_STAGE(PG8_SA(1, 0), cA + kstep, voffA); PG8_STAGE(PG8_SB(1, 1), cB + hstep + kstep, voffB);
        PG8_WAIT_V(6); PG8_BAR;
    } else {
        PG8_STAGE(PG8_SB(0, 0), cB, voffB); PG8_STAGE(PG8_SA(0, 0), cA, voffA); PG8_STAGE(PG8_SB(0, 1), cB + hstep, voffB); PG8_STAGE(PG8_SA(0, 1), cA + hstep, voffA);
        if (wr == 1) PG8_BAR;
        PG8_WAIT_V(4); PG8_BAR;
        PG8_STAGE(PG8_SB(1, 0), cB + kstep, voffB); PG8_STAGE(PG8_SA(1, 0), cA + kstep, voffA); PG8_STAGE(PG8_SB(1, 1), cB + hstep + kstep, voffB);
        PG8_WAIT_V(6); PG8_BAR;
    }
    for (;;) {
        const bool has_next = S.next(ui + 1, nxt);
        const char* nA = has_next ? (const char*)g.A + (size_t)nxt.pm * tstep : cA; const char* nB = has_next ? (const char*)g.Bt + (size_t)nxt.pn * tstep : cB;
        for (int t = 0; t < nt; t += 2) {
            const bool last = (t == nt - 2);
            const char* a1 = cA + (size_t)(t + 1) * kstep;
            const char* a2 = last ? nA : cA + (size_t)(t + 2) * kstep; const char* b2 = last ? nB : cB + (size_t)(t + 2) * kstep;
            const char* a3 = a2 + kstep; const char* b3 = b2 + kstep;
            if (last && has_next) S.a_ready(nxt);
            if constexpr (SP2) {
            PG8_LDB(B0, 0, 0); PG8_LDB(B1, 0, 1); PG8_SCHED; PG8_LDA(At, 0, 0); PG8_STAGE(PG8_SA(1, 1), a1 + hstep, voffA);
            PG8_WAIT_V(8); PG8_WAIT_L(0); PG8_BAR; PG8_MMA(0, 0, At, B0); PG8_MMA(0, 1, At, B1); PG8_BAR; PG8_SCHED;
            PG8_LDA(At, 0, 1); PG8_STAGE(PG8_SB(0, 0), b2, voffB); PG8_STAGE(PG8_SB(0, 1), b2 + hstep, voffB); PG8_STAGE(PG8_SA(0, 0), a2, voffA);
            PG8_WAIT_V(8); PG8_WAIT_L(0); PG8_BAR; PG8_MMA(1, 0, At, B0); PG8_MMA(1, 1, At, B1); PG8_BAR; PG8_SCHED;
            PG8_LDB(B0, 1, 0); PG8_LDB(B1, 1, 1); PG8_SCHED; PG8_LDA(At, 1, 0); PG8_STAGE(PG8_SA(0, 1), a2 + hstep, voffA);
            PG8_WAIT_V(8); PG8_WAIT_L(0); PG8_BAR; PG8_MMA(0, 0, At, B0); PG8_MMA(0, 1, At, B1); PG8_BAR; PG8_SCHED;
            PG8_LDA(At, 1, 1); PG8_STAGE(PG8_SB(1, 0), b3, voffB); PG8_STAGE(PG8_SB(1, 1), b3 + hstep, voffB); PG8_STAGE(PG8_SA(1, 0), a3, voffA);
            PG8_WAIT_V(8); PG8_WAIT_L(0); PG8_BAR; PG8_MMA(1, 0, At, B0); PG8_MMA(1, 1, At, B1); PG8_BAR; PG8_SCHED;
            } else {
            PG8_LDB(B0, 0, 0); PG8_SCHED; PG8_LDA(At, 0, 0); PG8_STAGE(PG8_SA(1, 1), a1 + hstep, voffA);
            PG8_WAIT_L(8); PG8_BAR; PG8_WAIT_L(0); PG8_MMA(0, 0, At, B0); PG8_BAR; PG8_SCHED;
            PG8_LDB(B1, 0, 1); PG8_STAGE(PG8_SB(0, 0), b2, voffB);
            PG8_BAR; PG8_WAIT_L(0); PG8_MMA(0, 1, At, B1); PG8_BAR;
            PG8_LDA(At, 0, 1); PG8_STAGE(PG8_SA(0, 0), a2, voffA);
            PG8_BAR; PG8_WAIT_L(0); PG8_MMA(1, 0, At, B0); PG8_BAR; PG8_SCHED;
            PG8_STAGE(PG8_SB(0, 1), b2 + hstep, voffB);
            PG8_WAIT_V(6); PG8_BAR; PG8_MMA(1, 1, At, B1); PG8_BAR;
            PG8_LDB(B0, 1, 0); PG8_SCHED; PG8_LDA(At, 1, 0); PG8_STAGE(PG8_SA(0, 1), a2 + hstep, voffA);
            PG8_WAIT_L(8); PG8_BAR; PG8_WAIT_L(0); PG8_MMA(0, 0, At, B0); PG8_BAR; PG8_SCHED;
            PG8_LDB(B1, 1, 1); PG8_STAGE(PG8_SB(1, 0), b3, voffB);
            PG8_BAR; PG8_WAIT_L(0); PG8_MMA(0, 1, At, B1); PG8_BAR;
            PG8_LDA(At, 1, 1); PG8_STAGE(PG8_SA(1, 0), a3, voffA);
            PG8_BAR; PG8_WAIT_L(0); PG8_MMA(1, 0, At, B0); PG8_BAR; PG8_SCHED;
            PG8_STAGE(PG8_SB(1, 1), b3 + hstep, voffB);
            PG8_WAIT_V(6); PG8_BAR; PG8_MMA(1, 1, At, B1); PG8_BAR;
            }
        }
        if constexpr (ALIGN_EPI) { if (wr == 0) PG8_BAR; }
        if constexpr (!Epi::AFTER_DRAIN) { E(acc, cur, wr, wc, fr, fq); S.done(cur); }
        if (!has_next) break;
#pragma unroll
        for (int a = 0; a < 2; ++a)
#pragma unroll
            for (int b = 0; b < 2; ++b)
#pragma unroll
                for (int m = 0; m < 4; ++m)
#pragma unroll
                    for (int n = 0; n < 2; ++n) acc[a][b][m][n] = (f32x4){0.f, 0.f, 0.f, 0.f};
        cur = nxt; cA = nA; cB = nB; ++ui;
        if constexpr (ALIGN_EPI) { if (wr == 1) PG8_BAR; }
    }
    PG8_WAIT_V(0);
    if constexpr (!ALIGN_EPI) { if (wr == 0) PG8_BAR; }
    PG8_BAR;
    if constexpr (Epi::AFTER_DRAIN) { E.fused(acc, cur, wr, wc, fr, fq, lds, wid, lane); S.done(cur); }
#undef PG8_SA
#undef PG8_SB
#undef PG8_STAGE
#undef PG8_LDA
#undef PG8_LDB
#undef PG8_MMA
#undef PG8_WAIT_V
#undef PG8_WAIT_L
#undef PG8_BAR
#undef PG8_SCHED
}
}
#define GAS __attribute__((address_space(1)))
#define LAS __attribute__((address_space(3)))
typedef unsigned short bf16;
typedef unsigned v4u __attribute__((ext_vector_type(4)));
typedef float f32x4 __attribute__((ext_vector_type(4)));
typedef short bf16x8 __attribute__((ext_vector_type(8)));
typedef GAS unsigned gu32;
typedef GAS unsigned long long gu64;
#define RLX_AGENT __ATOMIC_RELAXED, __HIP_MEMORY_SCOPE_AGENT
#define LDS_WAIT() asm volatile("s_waitcnt lgkmcnt(0)" ::: "memory")
#define VM_WAIT() asm volatile("s_waitcnt vmcnt(0)" ::: "memory")
__device__ __forceinline__ unsigned long long rt() { return __builtin_amdgcn_s_memrealtime(); }
__device__ __forceinline__ unsigned f2bf(float f) { unsigned u = __builtin_bit_cast(unsigned, f); return (u + 0x7fffu + ((u >> 16) & 1u)) >> 16; }
__device__ __forceinline__ unsigned pk2(float lo, float hi) { return f2bf(lo) | (f2bf(hi) << 16); }
typedef float f32x2v __attribute__((ext_vector_type(2)));

#define XB_TMO      128
#define XB_XCNT(j)  (256  + 64 * (j))
#define XB_XSUB(j)  (1280 + 64 * (j))
#define XB_XGEN(j)  (2304 + 64 * (j))
#define XB_TOP      3328
#define XB_TOPGEN   3392
#define XCD_BAR_WORDS 3456
#define XB_SPIN_CAP (1u << 24)

__device__ __forceinline__ unsigned xb_ld(unsigned* p)              { return __hip_atomic_load(p, __ATOMIC_RELAXED, __HIP_MEMORY_SCOPE_AGENT); }
__device__ __forceinline__ unsigned xb_add(unsigned* p, unsigned v) { return __hip_atomic_fetch_add(p, v, __ATOMIC_RELAXED, __HIP_MEMORY_SCOPE_AGENT); }
__device__ __forceinline__ unsigned xb_xcc_id() { return (unsigned)__builtin_amdgcn_s_getreg((3 << 11) | 20) & 0xFu; }
#define XB_SPIN(cond, bar) do { unsigned _sp = 0; while (cond) { __builtin_amdgcn_s_sleep(1); \
    if ((++_sp & 255u) == 0u) { if (xb_ld(&(bar)[XB_TMO])) break; if (_sp > XB_SPIN_CAP) { atomicAdd(&(bar)[XB_TMO], 1u); break; } } } } while (0)

struct XcdBarrier {
    unsigned* bar; unsigned x;
    volatile LAS unsigned* st;
};

__device__ __forceinline__ XcdBarrier xcd_barrier_post(unsigned* bar, volatile LAS unsigned* st) {
    XcdBarrier b; b.bar = bar; b.x = xb_xcc_id(); b.st = st;
    if (threadIdx.x == 0) (void)xb_add(&bar[XB_XCNT(b.x)], 1u);
    return b;
}
__device__ __forceinline__ void xcd_barrier_complete(unsigned* bar, unsigned x, unsigned& nloc, unsigned& nx) {
    const unsigned G = gridDim.x * gridDim.y * gridDim.z;
    unsigned sum, cnt, mine, sp = 0u;
    for (;;) {
        sum = 0u; cnt = 0u; mine = 0u;
#pragma unroll
        for (unsigned j = 0; j < 16; ++j) { const unsigned c = xb_ld(&bar[XB_XCNT(j)]); sum += c; cnt += (c > 0u) ? 1u : 0u; mine = (j == x) ? c : mine; }
        if (sum == G) break;
        __builtin_amdgcn_s_sleep(1);
        if ((++sp & 255u) == 0u) { if (xb_ld(&bar[XB_TMO])) break; if (sp > XB_SPIN_CAP) { atomicAdd(&bar[XB_TMO], 1u); break; } }
    }
    nloc = mine > 0u ? mine : 1u; nx = cnt > 0u ? cnt : 1u;
}

__device__ __forceinline__ void xcd_barrier(const XcdBarrier& b) {
    asm volatile("s_waitcnt vmcnt(0)" ::: "memory");
    __syncthreads();
    if (threadIdx.x == 0) {
        unsigned* bar = b.bar;
        __builtin_amdgcn_s_waitcnt(0);
        unsigned nloc = b.st[0], nx = b.st[1];
        if (nloc == 0u) { xcd_barrier_complete(bar, b.x, nloc, nx); b.st[0] = nloc; b.st[1] = nx; }
        const unsigned old = xb_add(&bar[XB_XSUB(b.x)], 1u);
        const unsigned gen = old / nloc;
        if (old + 1u == (gen + 1u) * nloc) {
            __builtin_amdgcn_fence(__ATOMIC_RELEASE, "agent");
            asm volatile("s_waitcnt vmcnt(0)" ::: "memory");
            const unsigned og = xb_add(&bar[XB_TOP], 1u);
            const unsigned tg = og / nx;
            if (og + 1u == (tg + 1u) * nx) xb_add(&bar[XB_TOPGEN], 1u);
            else XB_SPIN(xb_ld(&bar[XB_TOPGEN]) == tg, bar);
            __builtin_amdgcn_fence(__ATOMIC_ACQUIRE, "agent");
            xb_add(&bar[XB_XGEN(b.x)], 1u);
            asm volatile("s_waitcnt vmcnt(0)" ::: "memory");
        } else {
            XB_SPIN(xb_ld(&bar[XB_XGEN(b.x)]) == gen, bar);
            __builtin_amdgcn_fence(__ATOMIC_ACQUIRE, "agent");
            asm volatile("s_waitcnt vmcnt(0)" ::: "memory");
        }
    }
    __syncthreads();
}

constexpr int NWAVES = 8;
constexpr int NB = 4, SEQ = 4096, CTXL = 256, DM = 1024, ML = NB * SEQ, MC = NB * CTXL, MT = ML + MC;
constexpr int DFF = 2816, NUP = 2 * DFF, N0P = 3328, N1 = 6144;
constexpr float EPS = 1e-6f;
constexpr size_t MiB = 1u << 20;
constexpr size_t WS_CTL = 0, CTL_ZERO_BYTES = 64 * 1024;
constexpr size_t WS_MOD = 1 * MiB;
constexpr size_t WS_ROPE = 1 * MiB + 512 * 1024;
constexpr size_t WS_XC = 2 * MiB;
constexpr size_t WS_WIN1T = 8 * MiB;
constexpr size_t WS_H = 20 * MiB;
constexpr size_t WS_WIN0T = 54 * MiB, WS_WO0T = WS_WIN0T + 6656 * 1024, WS_WUPT0 = WS_WO0T + 2 * MiB, WS_WDNT0 = WS_WUPT0 + 11 * MiB;
constexpr size_t WS_NAQ = 79 * MiB, WS_NAK = 96 * MiB, WS_NAV = 113 * MiB;
constexpr size_t WS_GQ = 130 * MiB, WS_GK = WS_GQ + 8704 * 1024, WS_GV = 147 * MiB, WS_GR = 164 * MiB, WS_GA = 181 * MiB;
constexpr size_t WS_CAT = 184 * MiB;
constexpr size_t WS_X218 = 218 * MiB;
constexpr size_t WS_ACT0 = 80 * MiB, WS_EDGE0 = 174 * MiB;
constexpr size_t WS_WO1T = 252 * MiB;
constexpr size_t WS_RQ = 54 * MiB, WS_RK = 86 * MiB, WS_RV = 120 * MiB, WS_RG = 188 * MiB;
constexpr size_t WS_WUPT1 = 54 * MiB, WS_WDNT1 = 65 * MiB, WS_ACT1 = 72 * MiB, WS_EDGE1 = 160 * MiB;
constexpr size_t WS_END = 256 * MiB;
static_assert(WS_NAQ == pg8::PJ0_NAQ && WS_NAK == pg8::PJ0_NAK && WS_NAV == pg8::PJ0_NAV && WS_GQ == pg8::PJ0_GQ && WS_GK == pg8::PJ0_GK && WS_GV == pg8::PJ0_GV && WS_GR == pg8::PJ0_GR && WS_GA == pg8::PJ0_GA, "proj0 map");
static_assert(WS_RQ == pg8::PJ1_RQ && WS_RK == pg8::PJ1_RK && WS_RV == pg8::PJ1_RV && WS_RG == pg8::PJ1_RG && WS_ROPE == pg8::PJ1_ROPE, "proj1 map");
constexpr int CW_BAR = 4096;
constexpr int RING_OFF = 0, RING_BYTES = 131072, LDSCTL_OFF = RING_BYTES, MISC_OFF = LDSCTL_OFF + 320, LDS_BYTES = 147456;

struct Args { const float* in[26]; float* out; unsigned char* ws; int ph_lo, ph_hi; };
struct Frame {
    LAS unsigned char* lds; int tid, lane, wave, G, bid;
    const Args* a; float* out; unsigned char* ws;
};
#define IN_X 0
#define IN_C 1
#define IN_CTX 2
#define IN_CCTX 3
#define IN_WMOD 4
#define IN_BMOD 5
#define IN_N1G 6
#define IN_N2G 7
#define IN_WIN0 8
#define IN_WO0 9
#define IN_RPB 10
#define IN_WAF 11
#define IN_BAF 12
#define IN_WAB 13
#define IN_BAB 14
#define IN_GNG 15
#define IN_WIN1 16
#define IN_WO1 17
#define IN_DECF 18
#define IN_DECB 19
#define IN_RNG 20
#define IN_WUP 21
#define IN_CW 22
#define IN_CB 23
#define IN_WDN 24
#define IN_FNG 25

__device__ __forceinline__ float wave_sum(float v) {
#pragma unroll
    for (int o = 1; o < 64; o <<= 1) v += __shfl_xor(v, o);
    return v;
}
__device__ __forceinline__ float wave_max(float v) {
#pragma unroll
    for (int o = 1; o < 64; o <<= 1) v = fmaxf(v, __shfl_xor(v, o));
    return v;
}
__device__ __forceinline__ float bf2f(bf16 b) { return __builtin_bit_cast(float, (unsigned)b << 16); }
__device__ __forceinline__ float silu_f(float a) { return a / (1.0f + __expf(-a)); }
__device__ __forceinline__ float logsig_f(float z) { return fminf(z, 0.f) - log1pf(__expf(-fabsf(z))); }

struct MapId { int nsrc; __device__ __forceinline__ int operator()(int n) const { return n < nsrc ? n : -1; } };
struct MapUp { __device__ __forceinline__ int operator()(int n) const { return ((n >> 7) & 1) * DFF + (n >> 8) * 128 + (n & 127); } };
struct MapIn1 { __device__ __forceinline__ int operator()(int n) const {
    if (n >= 2048) return n;
    const int p = n & 127, wc = p >> 5, fq = (p >> 3) & 3, nn = (p >> 2) & 1, e = p & 3;
    return (n & ~127) + (wc >> 1) * 64 + nn * 32 + (wc & 1) * 16 + 4 * fq + e; } };
template <class MAP> __device__ __forceinline__ void transpose_item(const float* W, int K, int Nsrc, int Ndst, bf16* WT, LAS float* scr, int item, int lane, const MAP& map) {
    const int nblk = Ndst / 32, kb = item / nblk, nb = item % nblk, k0 = 64 * kb, n0 = 32 * nb;
    const int sc = map(n0 + (lane & 31));
#pragma unroll 8
    for (int i = 0; i < 32; ++i) { const int kk = 2 * i + (lane >> 5); scr[kk * 33 + (lane & 31)] = sc >= 0 ? W[(size_t)(k0 + kk) * Nsrc + sc] : 0.f; }
    LDS_WAIT(); asm volatile("" ::: "memory");
    const int c = lane & 7;
#pragma unroll
    for (int j = 0; j < 4; ++j) { const int n = (lane >> 3) + 8 * j; const LAS float* s = scr + (8 * c) * 33 + n;
        v4u o; o.x = pk2(s[0 * 33], s[1 * 33]); o.y = pk2(s[2 * 33], s[3 * 33]); o.z = pk2(s[4 * 33], s[5 * 33]); o.w = pk2(s[6 * 33], s[7 * 33]);
        *(GAS v4u*)(WT + (size_t)(n0 + n) * K + k0 + 8 * c) = o; }
    LDS_WAIT(); asm volatile("" ::: "memory");
}
template <class MAP> __device__ __forceinline__ void transpose_all(Frame& F, const float* W, int K, int Nsrc, int Ndst, bf16* WT, const MAP& map) {
    LAS float* scr = (LAS float*)(F.lds + RING_OFF + F.wave * 16384);
    const int gw = F.wave * F.G + F.bid, NGW = F.G * NWAVES, nitems = (K / 64) * (Ndst / 32);
    for (int it = gw; it < nitems; it += NGW) transpose_item(W, K, Nsrc, Ndst, WT, scr, it, F.lane, map);
}

__device__ __forceinline__ void phase_prep(Frame& F) {
    unsigned char* ws = F.ws;
    transpose_all(F, F.a->in[IN_WIN0], 1024, 3104, N0P, (bf16*)(ws + WS_WIN0T), MapId{3104});
    transpose_all(F, F.a->in[IN_WO0], 1024, 1024, 1024, (bf16*)(ws + WS_WO0T), MapId{1024});
    transpose_all(F, F.a->in[IN_WUP], 1024, NUP, NUP, (bf16*)(ws + WS_WUPT0), MapUp{});
    transpose_all(F, F.a->in[IN_WDN], DFF, 1024, 1024, (bf16*)(ws + WS_WDNT0), MapId{1024});
    transpose_all(F, F.a->in[IN_WIN1], 1024, N1, N1, (bf16*)(ws + WS_WIN1T), MapIn1{});
    transpose_all(F, F.a->in[IN_WO1], 2048, 1024, 1024, (bf16*)(ws + WS_WO1T), MapId{1024});
    __syncthreads();
    LAS float* sv = (LAS float*)(F.lds);
    LAS float* red = (LAS float*)(F.lds + 32768);
    for (int i = F.tid; i < 5 * 1024; i += 512) { const int bi = i >> 10, k = i & 1023; const float v = bi < 4 ? F.a->in[IN_C][bi * 1024 + k] : F.a->in[IN_CCTX][k]; sv[i] = silu_f(v); }
    __syncthreads();
    float* mod = (float*)(ws + WS_MOD);
    for (int it = F.bid; it < 2 * 96; it += F.G) {
        const int l = it / 96, n = (it % 96) * 64 + (F.tid & 63), kp = F.tid >> 6;
        const float* w = F.a->in[IN_WMOD] + (size_t)l * 1024 * 6144 + n;
        float a0 = 0.f, a1 = 0.f, a2 = 0.f, a3 = 0.f, a4 = 0.f;
#pragma unroll 8
        for (int kk = 0; kk < 128; ++kk) { const int k = kp * 128 + kk; const float wv = w[(size_t)k * 6144];
            a0 += sv[k] * wv; a1 += sv[1024 + k] * wv; a2 += sv[2048 + k] * wv; a3 += sv[3072 + k] * wv; a4 += sv[4096 + k] * wv; }
        const int c = F.tid & 63;
        red[(kp * 5 + 0) * 64 + c] = a0; red[(kp * 5 + 1) * 64 + c] = a1; red[(kp * 5 + 2) * 64 + c] = a2; red[(kp * 5 + 3) * 64 + c] = a3; red[(kp * 5 + 4) * 64 + c] = a4;
        __syncthreads();
        if (F.tid < 320) { const int bi = F.tid >> 6, cc = F.tid & 63; float s = 0.f;
#pragma unroll
            for (int p = 0; p < 8; ++p) s += red[(p * 5 + bi) * 64 + cc];
            const int nn = (it % 96) * 64 + cc;
            mod[((size_t)l * 5 + bi) * 6144 + nn] = s + F.a->in[IN_BMOD][l * 6144 + nn]; }
        __syncthreads();
    }
    if (F.bid == 0) { f32x2v* rope = (f32x2v*)(ws + WS_ROPE);
        for (int i = F.tid; i < 64 * 32; i += 512) { const int pos = i >> 5, f = i & 31; const float inv = powf(10000.f, -(float)(2 * f) / 64.f), ang = (float)pos * inv; rope[i] = (f32x2v){cosf(ang), sinf(ang)}; } }
}

__device__ __forceinline__ void phase_modnorm(Frame& F, const float* xl, const float* xc, int nrows, const float* g, const float* modl  , int shoff) {
    bf16* H = (bf16*)(F.ws + WS_H);
    const int gw = F.wave * F.G + F.bid, NGW = F.G * NWAVES;
    for (int m = gw; m < nrows; m += NGW) {
        const float* src = m < ML ? xl + (size_t)m * DM : xc + (size_t)(m - ML) * DM; const int bi = m < ML ? (m >> 12) : 4;
        const float* sh = modl + bi * 6144 + shoff; const float* sc = sh + 1024;
        f32x4 v[4]; float ss = 0.f;
#pragma unroll
        for (int j = 0; j < 4; ++j) { v[j] = *(const f32x4*)(src + 256 * j + 4 * F.lane); ss += (v[j].x * v[j].x + v[j].y * v[j].y) + (v[j].z * v[j].z + v[j].w * v[j].w); }
        const float rstd = 1.0f / sqrtf(wave_sum(ss) * (1.f / DM) + EPS);
#pragma unroll
        for (int j = 0; j < 4; ++j) { const int k = 256 * j + 4 * F.lane; const f32x4 gg = *(const f32x4*)(g + k), s1 = *(const f32x4*)(sc + k), s0 = *(const f32x4*)(sh + k);
            const f32x4 h = v[j] * rstd * gg * (s1 + 1.0f) + s0;
            *(unsigned long long*)(H + (size_t)m * DM + k) = (unsigned long long)pk2(h.x, h.y) | ((unsigned long long)pk2(h.z, h.w) << 32); }
    }
}
__device__ __forceinline__ void phase_final(Frame& F) {
    const float* g = F.a->in[IN_FNG]; const int gw = F.wave * F.G + F.bid, NGW = F.G * NWAVES;
    for (int m = gw; m < ML; m += NGW) { float* p = F.out + (size_t)m * DM; f32x4 v[4]; float ss = 0.f;
#pragma unroll
        for (int j = 0; j < 4; ++j) { v[j] = *(const f32x4*)(p + 256 * j + 4 * F.lane); ss += (v[j].x * v[j].x + v[j].y * v[j].y) + (v[j].z * v[j].z + v[j].w * v[j].w); }
        const float rstd = 1.0f / sqrtf(wave_sum(ss) * (1.f / DM) + EPS);
#pragma unroll
        for (int j = 0; j < 4; ++j) { const int k = 256 * j + 4 * F.lane; *(f32x4*)(p + k) = v[j] * rstd * *(const f32x4*)(g + k); } }
}
__device__ __forceinline__ void phase_fixup(Frame& F, const float* edge, bf16* act, int nblk, const float* cw, const float* cb) {
    const int total = nblk * 2 * (DFF / 4);
    for (int i = F.bid * 512 + F.tid; i < total; i += F.G * 512) {
        const int j = (i % (DFF / 4)) * 4, e = (i / (DFF / 4)) & 1, blk = i / (DFF / 2);
        const int row = blk * 64 + (e ? 63 : 0);
        bool has_prev = true, has_next = true;
        if (e == 0) { has_prev = row < ML ? (row & 4095) != 0 : ((row - ML) & 255) != 0; } else { has_next = row < ML ? (row & 4095) != 4095 : ((row - ML) & 255) != 255; }
        const float* pp = e == 0 ? edge + (size_t)((blk - 1) * 4 + 3) * NUP : edge + (size_t)(blk * 4 + 2) * NUP;
        const float* pc = edge + (size_t)(blk * 4 + (e ? 3 : 0)) * NUP;
        const float* pn = e == 0 ? edge + (size_t)(blk * 4 + 1) * NUP : edge + (size_t)((blk + 1) * 4 + 0) * NUP;
        f32x4 y[2];
#pragma unroll
        for (int h = 0; h < 2; ++h) { const int c = h * DFF + j; const f32x4 z = {0.f, 0.f, 0.f, 0.f};
            const f32x4 xp = has_prev ? *(const f32x4*)(pp + c) : z, xc = *(const f32x4*)(pc + c), xn = has_next ? *(const f32x4*)(pn + c) : z;
            y[h] = *(const f32x4*)(cw + c) * xp + *(const f32x4*)(cw + NUP + c) * xc + *(const f32x4*)(cw + 2 * NUP + c) * xn + *(const f32x4*)(cb + c); }
        f32x4 r;
#pragma unroll
        for (int q = 0; q < 4; ++q) r[q] = silu_f(y[0][q]) * y[1][q];
        *(unsigned long long*)(act + (size_t)row * DFF + j) = (unsigned long long)pk2(r.x, r.y) | ((unsigned long long)pk2(r.z, r.w) << 32);
    }
}
__device__ __forceinline__ void phase_na_simple(Frame& F) {
    const bf16* naq = (const bf16*)(F.ws + WS_NAQ); const bf16* nak = (const bf16*)(F.ws + WS_NAK); const bf16* nav = (const bf16*)(F.ws + WS_NAV);
    bf16* cat = (bf16*)(F.ws + WS_CAT); const float* rpb = F.a->in[IN_RPB];
    const int gw = F.wave * F.G + F.bid, NGW = F.G * NWAVES, ntask = NB * 8 * 4352, lane = F.lane;
    for (int t = gw; t < ntask; t += NGW) {
        const int qi = t % 4352, bh = t / 4352, h = bh & 7, b = bh >> 3; const bool lat = qi < 4096;
        const size_t hb = (size_t)bh * 4352;
        float q[64];
        { const v4u* qp = (const v4u*)(naq + (hb + qi) * 64);
#pragma unroll
          for (int j = 0; j < 8; ++j) { const v4u w = qp[j];
#pragma unroll
              for (int e = 0; e < 4; ++e) { q[8 * j + 2 * e] = __builtin_bit_cast(float, w[e] << 16); q[8 * j + 2 * e + 1] = __builtin_bit_cast(float, w[e] & 0xffff0000u); } } }
        const int qr = qi >> 6, qc = qi & 63, r0 = min(max(qr - 4, 0), 56), c0 = min(max(qc - 8, 0), 48);
        float sc[6]; float mx = -1e30f;
#pragma unroll
        for (int i = 0; i < 6; ++i) {
            const int kidx = lane + 64 * i; int tok; float bias = 0.f; bool valid = true;
            if (i < 2) { const int ki = r0 + (kidx >> 4), kj = c0 + (kidx & 15); tok = ki * 64 + kj; valid = lat; if (lat) bias = rpb[(h * 15 + (ki - qr + 7)) * 31 + (kj - qc + 15)]; }
            else tok = 4096 + kidx - 128;
            float d = 0.f;
            if (valid) { const v4u* kp = (const v4u*)(nak + (hb + tok) * 64);
#pragma unroll
                for (int j = 0; j < 8; ++j) { const v4u w = kp[j];
#pragma unroll
                    for (int e = 0; e < 4; ++e) { d += q[8 * j + 2 * e] * __builtin_bit_cast(float, w[e] << 16); d += q[8 * j + 2 * e + 1] * __builtin_bit_cast(float, w[e] & 0xffff0000u); } } }
            sc[i] = valid ? d + bias : -1e30f; mx = fmaxf(mx, sc[i]);
        }
        mx = wave_max(mx); float l = 0.f;
#pragma unroll
        for (int i = 0; i < 6; ++i) { sc[i] = sc[i] > -1e29f ? __expf(sc[i] - mx) : 0.f; l += sc[i]; }
        l = wave_sum(l);
        float o = 0.f;
#pragma unroll
        for (int i = 0; i < 6; ++i) {
            if (i < 2 && !lat) continue;
            for (int j = 0; j < 64; ++j) { const int kidx = j + 64 * i; int tok;
                if (i < 2) tok = (r0 + (kidx >> 4)) * 64 + c0 + (kidx & 15); else tok = 4096 + kidx - 128;
                o += __shfl(sc[i], j) * bf2f(nav[(hb + tok) * 64 + lane]); }
        }
        const int row = lat ? b * 4096 + qi : ML + b * 256 + (qi - 4096);
        cat[(size_t)row * 1024 + h * 64 + lane] = (bf16)f2bf(o / l);
    }
}
__device__ __forceinline__ void phase_gla_gates_simple(Frame& F) {
    const float* ga = (const float*)(F.ws + WS_GA); float* E = (float*)(F.ws + WS_H);
    const int total = 2 * MT * 256;
    for (int idx = F.bid * 512 + F.tid; idx < total; idx += F.G * 512) {
        const int c = idx & 255, m = (idx >> 8) % MT, dir = idx / (MT * 256);
        const float* w = (dir ? F.a->in[IN_WAB] : F.a->in[IN_WAF]); const float* g = ga + (size_t)m * 32 + dir * 16; float z = (dir ? F.a->in[IN_BAB] : F.a->in[IN_BAF])[c];
#pragma unroll
        for (int r = 0; r < 16; ++r) z += g[r] * w[r * 256 + c];
        E[idx] = __expf(logsig_f(z) * (1.f / 16.f));
    }
}
__device__ __forceinline__ int seq_row(int b, int p, int dir) {
    if (p < CTXL) return ML + b * CTXL + (dir ? CTXL - 1 - p : p);
    const int s = p - CTXL; return b * SEQ + (dir ? SEQ - 1 - s : s);
}
__device__ __forceinline__ void phase_gla_rec_simple(Frame& F) {
    const bf16* gq = (const bf16*)(F.ws + WS_GQ); const bf16* gk = (const bf16*)(F.ws + WS_GK); const bf16* gv = (const bf16*)(F.ws + WS_GV);
    const float* E = (const float*)(F.ws + WS_H);
    const int gw = F.wave * F.G + F.bid, NGW = F.G * NWAVES, lane = F.lane;
    for (int t = gw; t < 64; t += NGW) {
        const int dvg = t & 1, dir = (t >> 1) & 1, h = (t >> 2) & 3, b = t >> 4;
        float* O = (float*)(F.ws + (dir ? WS_NAQ : WS_X218));
        float S[64];
#pragma unroll
        for (int i = 0; i < 64; ++i) S[i] = 0.f;
        for (int p = 0; p < CTXL + SEQ; ++p) {
            const int m = __builtin_amdgcn_readfirstlane(seq_row(b, p, dir));
            const float v = bf2f(gv[(size_t)m * 512 + h * 128 + dvg * 64 + lane]);
            const float* e = E + ((size_t)dir * MT + m) * 256 + h * 64; const bf16* kp = gk + (size_t)m * 256 + h * 64; const bf16* qp = gq + (size_t)m * 256 + h * 64;
            float o = 0.f;
#pragma unroll
            for (int i = 0; i < 64; ++i) { S[i] = e[i] * S[i] + bf2f(kp[i]) * v; o += bf2f(qp[i]) * S[i]; }
            O[(size_t)m * 512 + h * 128 + dvg * 64 + lane] = o;
        }
    }
}
__device__ __forceinline__ void phase_gla_out_simple(Frame& F) {
    const float* Of = (const float*)(F.ws + WS_X218); const float* Ob = (const float*)(F.ws + WS_NAQ); const bf16* gr = (const bf16*)(F.ws + WS_GR); bf16* cat = (bf16*)(F.ws + WS_CAT);
    const float* gng = F.a->in[IN_GNG]; const int gw = F.wave * F.G + F.bid, NGW = F.G * NWAVES, lane = F.lane;
    for (int t = gw; t < MT * 4; t += NGW) { const int h = t & 3, m = t >> 2; const size_t o0 = (size_t)m * 512 + h * 128;
        const float a = Of[o0 + lane] + Ob[o0 + lane], c = Of[o0 + 64 + lane] + Ob[o0 + 64 + lane];
        const float rs = 1.0f / sqrtf(wave_sum(a * a + c * c) * (1.f / 128.f) + EPS);
        cat[(size_t)m * 1024 + 512 + h * 128 + lane] = (bf16)f2bf(a * rs * gng[lane] * silu_f(bf2f(gr[o0 + lane])));
        cat[(size_t)m * 1024 + 512 + h * 128 + 64 + lane] = (bf16)f2bf(c * rs * gng[64 + lane] * silu_f(bf2f(gr[o0 + 64 + lane]))); }
}
__device__ __forceinline__ void phase_ret_rec_simple(Frame& F, int hg) {
    const bf16* rq = (const bf16*)(F.ws + WS_RQ); const bf16* rk = (const bf16*)(F.ws + WS_RK); const bf16* rv = (const bf16*)(F.ws + WS_RV); bf16* O = (bf16*)(F.ws + WS_H);
    const int gw = F.wave * F.G + F.bid, NGW = F.G * NWAVES, lane = F.lane;
    for (int t = gw; t < 64; t += NGW) {
        const int dvg = t & 3, h4 = (t >> 2) & 3, b = t >> 4, h = hg * 4 + h4;
        for (int dir = 0; dir < 2; ++dir) {
            const float dec = (dir ? F.a->in[IN_DECB] : F.a->in[IN_DECF])[h]; const float gam = 1.0f / (1.0f + __expf(-dec));
            float S[128];
#pragma unroll
            for (int i = 0; i < 128; ++i) S[i] = 0.f;
            for (int p = 0; p < CTXL + SEQ; ++p) {
                const int m = __builtin_amdgcn_readfirstlane(seq_row(b, p, dir));
                const float v = bf2f(rv[(size_t)m * 2048 + h * 256 + dvg * 64 + lane]);
                const bf16* kp = rk + (size_t)m * 1024 + h * 128;
#pragma unroll
                for (int i = 0; i < 128; ++i) S[i] = gam * S[i] + bf2f(kp[i]) * v;
                if (m < ML) { const bf16* qp = rq + (size_t)m * 1024 + h * 128; float o = 0.f;
#pragma unroll
                    for (int i = 0; i < 128; ++i) o += bf2f(qp[i]) * S[i];
                    bf16* op = O + (size_t)m * 1024 + h4 * 256 + dvg * 64 + lane;
                    if (dir) o += bf2f(*op);
                    *op = (bf16)f2bf(o); }
            }
            asm volatile("s_waitcnt vmcnt(0)" ::: "memory");
        }
    }
}
__device__ __forceinline__ void phase_ret_out_simple(Frame& F, int hg) {
    const bf16* O = (const bf16*)(F.ws + WS_H); bf16* rg = (bf16*)(F.ws + WS_RG); const float* rng = F.a->in[IN_RNG];
    const int gw = F.wave * F.G + F.bid, NGW = F.G * NWAVES, lane = F.lane;
    for (int t = gw; t < ML * 4; t += NGW) { const int h4 = t & 3, m = t >> 2, h = hg * 4 + h4;
        float o[4]; float s = 0.f;
#pragma unroll
        for (int j = 0; j < 4; ++j) { o[j] = bf2f(O[(size_t)m * 1024 + h4 * 256 + 64 * j + lane]); s += o[j]; }
        const float mu = wave_sum(s) * (1.f / 256.f); float q = 0.f;
#pragma unroll
        for (int j = 0; j < 4; ++j) { o[j] -= mu; q += o[j] * o[j]; }
        const float rs = 1.0f / sqrtf(wave_sum(q) * (1.f / 256.f) + EPS);
#pragma unroll
        for (int j = 0; j < 4; ++j) { bf16* gp = rg + (size_t)m * 2048 + h * 256 + 64 * j + lane; *gp = (bf16)f2bf(o[j] * rs * rng[h * 256 + 64 * j + lane] * silu_f(bf2f(*gp))); } }
}

constexpr int NPHASE = 23;
__global__ void __launch_bounds__(NWAVES * 64, 2) mk_fwd(Args args) {
    extern __shared__ __attribute__((aligned(16))) unsigned char lds[];
    Frame F;
    F.lds = (LAS unsigned char*)lds; F.tid = threadIdx.x; F.lane = F.tid & 63; F.wave = __builtin_amdgcn_readfirstlane(F.tid >> 6); F.G = gridDim.x; F.bid = blockIdx.x;
    F.a = &args;
    F.out = args.out; F.ws = args.ws;
    unsigned char* ws = args.ws;
    for (int u = F.tid; u < (LDS_BYTES - LDSCTL_OFF) / 4; u += NWAVES * 64) ((LAS unsigned*)(F.lds + LDSCTL_OFF))[u] = 0u;
    __syncthreads();
    const int lo = args.ph_lo, hi = args.ph_hi;
    XcdBarrier bar; bar.bar = (unsigned*)(ws + WS_CTL) + CW_BAR; bar.x = 0; bar.st = nullptr;
    if (hi - lo > 1) bar = xcd_barrier_post((unsigned*)(ws + WS_CTL) + CW_BAR, (volatile LAS unsigned*)(F.lds + MISC_OFF) + 8);
    float* mod = (float*)(ws + WS_MOD); float* xc = (float*)(ws + WS_XC); bf16* H = (bf16*)(ws + WS_H);
#define IN(k) (lo <= (k) && (k) < hi)
#define SEAM(k) do { if ((k) + 1 < hi) xcd_barrier(bar); } while (0)
#define GEMM_RES(ph_, A_, Bt_, M_, K_, bL_, bC_, gate_) do { pg8::Gemm g{(const bf16*)(A_), (const bf16*)(Bt_), (M_), 1024, (K_)}; pg8::StaticOrder S; S.init((M_), 1024, F.G, F.bid); \
        pg8::EpiRes E{(bL_), (bC_), F.out, xc, (gate_)}; pg8::gemm_phase<pg8::EpiRes, pg8::StaticOrder, true, true>(F.lds + RING_OFF, g, S, E); } while (0)
#define GEMM_UP(l_, M_) do { pg8::Gemm g{H, (const bf16*)(ws + ((l_) ? WS_WUPT1 : WS_WUPT0)), (M_), NUP, 1024}; pg8::StaticOrder S; S.init((M_), NUP, F.G, F.bid); \
        pg8::EpiUp E{(bf16*)(ws + ((l_) ? WS_ACT1 : WS_ACT0)), (float*)(ws + ((l_) ? WS_EDGE1 : WS_EDGE0)), F.a->in[IN_CW] + (l_) * 3 * NUP, F.a->in[IN_CB] + (l_) * NUP}; \
        pg8::gemm_phase<pg8::EpiUp, pg8::StaticOrder, true, true>(F.lds + RING_OFF, g, S, E); } while (0)
    if (IN(0)) { phase_prep(F); SEAM(0); }
    if (IN(1)) { phase_modnorm(F, F.a->in[IN_X], F.a->in[IN_CTX], MT, F.a->in[IN_N1G], mod, 0); SEAM(1); }
    if (IN(2)) { pg8::Gemm g{H, (const bf16*)(ws + WS_WIN0T), MT, N0P, 1024}; pg8::StaticOrder S; S.init(MT, N0P, F.G, F.bid);
        pg8::EpiProj0 E{ws}; pg8::gemm_phase<pg8::EpiProj0, pg8::StaticOrder, true, true>(F.lds + RING_OFF, g, S, E); SEAM(2); }
    if (IN(3)) { phase_na_simple(F); phase_gla_gates_simple(F); SEAM(3); }
    if (IN(4)) { phase_gla_rec_simple(F); SEAM(4); }
    if (IN(5)) { phase_gla_out_simple(F); SEAM(5); }
    if (IN(6)) { GEMM_RES(6, ws + WS_CAT, ws + WS_WO0T, MT, 1024, F.a->in[IN_X], F.a->in[IN_CTX], mod + 2048); SEAM(6); }
    if (IN(7)) { phase_modnorm(F, F.out, xc, MT, F.a->in[IN_N2G], mod, 3072); SEAM(7); }
    if (IN(8)) { GEMM_UP(0, MT); SEAM(8); }
    if (IN(9)) { phase_fixup(F, (const float*)(ws + WS_EDGE0), (bf16*)(ws + WS_ACT0), MT / 64, F.a->in[IN_CW], F.a->in[IN_CB]); SEAM(9); }
    if (IN(10)) { GEMM_RES(10, ws + WS_ACT0, ws + WS_WDNT0, MT, DFF, F.out, xc, mod + 5120); SEAM(10); }
    if (IN(11)) { phase_modnorm(F, F.out, xc, MT, F.a->in[IN_N1G] + 1024, mod + 5 * 6144, 0); SEAM(11); }
    if (IN(12)) { pg8::Gemm g{H, (const bf16*)(ws + WS_WIN1T), MT, N1, 1024}; pg8::StaticOrder S; S.init(MT, N1, F.G, F.bid);
        pg8::EpiProj1 E{ws}; pg8::gemm_phase<pg8::EpiProj1, pg8::StaticOrder, true, true>(F.lds + RING_OFF, g, S, E); SEAM(12); }
    if (IN(13)) { phase_ret_rec_simple(F, 0); SEAM(13); }
    if (IN(14)) { phase_ret_out_simple(F, 0); SEAM(14); }
    if (IN(15)) { phase_ret_rec_simple(F, 1); SEAM(15); }
    if (IN(16)) { phase_ret_out_simple(F, 1); SEAM(16); }
    if (IN(17)) {
        transpose_all(F, F.a->in[IN_WUP] + (size_t)1024 * NUP, 1024, NUP, NUP, (bf16*)(ws + WS_WUPT1), MapUp{});
        transpose_all(F, F.a->in[IN_WDN] + (size_t)DFF * 1024, DFF, 1024, 1024, (bf16*)(ws + WS_WDNT1), MapId{1024});
        __syncthreads();
        GEMM_RES(17, ws + WS_RG, ws + WS_WO1T, ML, 2048, F.out, xc, mod + 5 * 6144 + 2048); SEAM(17); }
    if (IN(18)) { phase_modnorm(F, F.out, xc, ML, F.a->in[IN_N2G] + 1024, mod + 5 * 6144, 3072); SEAM(18); }
    if (IN(19)) { GEMM_UP(1, ML); SEAM(19); }
    if (IN(20)) { phase_fixup(F, (const float*)(ws + WS_EDGE1), (bf16*)(ws + WS_ACT1), ML / 64, F.a->in[IN_CW] + 3 * NUP, F.a->in[IN_CB] + NUP); SEAM(20); }
    if (IN(21)) { GEMM_RES(21, ws + WS_ACT1, ws + WS_WDNT1, ML, DFF, F.out, xc, mod + 5 * 6144 + 5120); SEAM(21); }
    if (IN(22)) { phase_final(F); }
}

#ifndef MK_ONE_LAUNCH
#define MK_ONE_LAUNCH 1
#endif
extern "C" void kernel_launch(void* const* d_in, const int* in_sizes, int n_in, void* d_out, int out_size, void* d_ws, size_t ws_size, hipStream_t stream) {
    static int grid = 0;
    if (grid == 0) {
        if (n_in != 26 || out_size != ML * DM || ws_size < WS_END) { fprintf(stderr, "kernel_launch: unexpected shapes: n_in %d out %d ws %zu\n", n_in, out_size, ws_size); grid = -1; return; }
        int dev = 0, cus = 0, per_cu = 0;
        if (hipGetDevice(&dev) != hipSuccess || hipDeviceGetAttribute(&cus, hipDeviceAttributeMultiprocessorCount, dev) != hipSuccess) { grid = -1; return; }
        if (hipFuncSetAttribute((const void*)mk_fwd, hipFuncAttributeMaxDynamicSharedMemorySize, LDS_BYTES) != hipSuccess) { fprintf(stderr, "kernel_launch: hipFuncSetAttribute failed\n"); grid = -1; return; }
        if (hipOccupancyMaxActiveBlocksPerMultiprocessor(&per_cu, (const void*)mk_fwd, NWAVES * 64, LDS_BYTES) != hipSuccess || per_cu < 1) { fprintf(stderr, "kernel_launch: occupancy query says %d blocks per CU\n", per_cu); }
        (void)hipGetLastError();
        grid = cus;
    }
    if (grid < 0) return;
    (void)hipMemsetAsync((char*)d_ws + WS_CTL, 0, CTL_ZERO_BYTES, stream);
    Args a{};
    for (int i = 0; i < 26; ++i) a.in[i] = (const float*)d_in[i];
    a.out = (float*)d_out; a.ws = (unsigned char*)d_ws;
#if MK_ONE_LAUNCH
    a.ph_lo = 0; a.ph_hi = NPHASE;
    void* kargs[] = {&a};
    hipError_t e = hipLaunchCooperativeKernel((const void*)mk_fwd, dim3(grid), dim3(NWAVES * 64), kargs, LDS_BYTES, stream);
    if (e != hipSuccess) fprintf(stderr, "kernel_launch: cooperative launch failed: %s\n", hipGetErrorString(e));
#else
    for (int ph = 0; ph < NPHASE; ++ph) { a.ph_lo = ph; a.ph_hi = ph + 1; hipLaunchKernelGGL(mk_fwd, dim3(grid), dim3(NWAVES * 64), LDS_BYTES, stream, a); }
#endif
}
```

```cpp
#include <hip/hip_runtime.h>
#include <cstdio>
#include <cstdint>
namespace pg8 {
#define PG8_LAS __attribute__((address_space(3)))
typedef unsigned short bf16_t;
typedef short bf16x8 __attribute__((ext_vector_type(8)));
typedef float f32x4 __attribute__((ext_vector_type(4)));
typedef unsigned u32x4 __attribute__((ext_vector_type(4)));
constexpr int BM = 256, BK = 64, HALF = 128, HTB = HALF * BK * 2  , STAGE_BYTES = 8 * HTB, NXCD = 8, WGM = 8;

__host__ __device__ __forceinline__ int lds_byte(int r, int c) { const int st = (r >> 4) * 2 + (c >> 5), rr = r & 15, cc = c & 31, ob = rr * 64 + cc * 2; return st * 1024 + (ob ^ (((ob >> 9) & 1) << 5)); }
__host__ __device__ __forceinline__ void stage_rc(int b, int& R, int& C) { const int st = b / 1024, sb = b % 1024, swz = sb ^ (((sb >> 9) & 1) << 5); R = (st >> 1) * 16 + swz / 64; C = (st & 1) * 32 + (swz % 64) / 2; }
__host__ __device__ __forceinline__ int perm32(int rho) { const int n = rho >> 4, i = rho & 15; return 8 * (i >> 2) + 4 * n + (i & 3); }

struct Unit { int pm, pn; };
struct Gemm { const bf16_t* A; const bf16_t* Bt; int M, N, K; };

struct StaticOrder {
    int nM, nN, nwg, G, c;
    __host__ __device__ void init(int M, int N, int G_, int c_) { nM = M / BM; nN = N / BM; nwg = nM * nN; G = G_; c = c_; }
    __host__ __device__ bool next(int i, Unit& u) const {
        const long L = (long)i * G + c; if (L >= nwg) return false;
        int wgid = (int)L; { const int q = nwg / NXCD, r = nwg % NXCD, xcd = wgid % NXCD, off = wgid / NXCD; wgid = (xcd < r ? xcd * (q + 1) : r * (q + 1) + (xcd - r) * q) + off; }
        const int nig = WGM * nN, gid = wgid / nig, fm = gid * WGM, gsz = (nM - fm) < WGM ? (nM - fm) : WGM;
        u.pm = fm + ((wgid % nig) % gsz); u.pn = (wgid % nig) / gsz; return true;
    }
    __device__ __forceinline__ void a_ready(const Unit&) const {}
    __device__ __forceinline__ void done(const Unit&) const {}
};

__device__ __forceinline__ unsigned cvt_pk_bf16(float lo, float hi) { unsigned r; asm volatile("v_cvt_pk_bf16_f32 %0, %1, %2" : "=v"(r) : "v"(lo), "v"(hi)); return r; }

constexpr size_t PJ_MiB = 1u << 20;
constexpr size_t PJ0_NAQ = 79 * PJ_MiB, PJ0_NAK = 96 * PJ_MiB, PJ0_NAV = 113 * PJ_MiB, PJ0_GQ = 130 * PJ_MiB, PJ0_GK = PJ0_GQ + 8704 * 1024, PJ0_GV = 147 * PJ_MiB, PJ0_GR = 164 * PJ_MiB, PJ0_GA = 181 * PJ_MiB;
constexpr size_t PJ1_RQ = 54 * PJ_MiB, PJ1_RK = 86 * PJ_MiB, PJ1_RV = 120 * PJ_MiB, PJ1_RG = 188 * PJ_MiB, PJ1_ROPE = 1 * PJ_MiB + 512 * 1024;
typedef float f32x2 __attribute__((ext_vector_type(2)));
typedef unsigned u32x2 __attribute__((ext_vector_type(2)));
__device__ __forceinline__ void store8bf(bf16_t* p, f32x4 v0, f32x4 v1) {
    u32x4 w; w.x = cvt_pk_bf16(v0[0], v0[1]); w.y = cvt_pk_bf16(v0[2], v0[3]); w.z = cvt_pk_bf16(v1[0], v1[1]); w.w = cvt_pk_bf16(v1[2], v1[3]);
    *(u32x4*)p = w;
}
struct EpiProj0 {
    static constexpr bool PERM = true, AFTER_DRAIN = false;
    unsigned char* ws;
    __device__ __forceinline__ void operator()(const f32x4 (&acc)[2][2][4][2], const Unit& u, int wr, int wc, int fr, int fq) const {
#pragma unroll
        for (int ai = 0; ai < 2; ++ai)
#pragma unroll
            for (int m = 0; m < 4; ++m) {
                const int row = u.pm * BM + ai * HALF + wr * 64 + m * 16 + fr;
                int b, rin; if (row < 16384) { b = row >> 12; rin = row & 4095; } else { b = (row - 16384) >> 8; rin = 4096 + ((row - 16384) & 255); }
#pragma unroll
                for (int bj = 0; bj < 2; ++bj) {
                    const int C0 = u.pn * BM + bj * HALF;
                    const f32x4 v0 = acc[ai][bj][m][0], v1 = acc[ai][bj][m][1];
                    if (C0 < 1536) {
                        const int t = C0 >> 9, head = ((C0 & 511) >> 6) + (wc >> 1), d = 32 * (wc & 1) + 8 * fq;
                        bf16_t* base = (bf16_t*)(ws + (t == 0 ? PJ0_NAQ : (t == 1 ? PJ0_NAK : PJ0_NAV))); const float sc = t == 0 ? 0.125f : 1.0f;
                        store8bf(base + ((size_t)((b * 8 + head) * 4352 + rin) * 64 + d), v0 * sc, v1 * sc);
                    } else if (C0 < 2048) {
                        const bool isq = C0 < 1792; bf16_t* base = (bf16_t*)(ws + (isq ? PJ0_GQ : PJ0_GK)); const int cb = C0 - (isq ? 1536 : 1792); const float sc = isq ? 0.125f : 1.0f;
                        store8bf(base + (size_t)row * 256 + cb + 32 * wc + 8 * fq, v0 * sc, v1 * sc);
                    } else if (C0 < 3072) {
                        const bool isv = C0 < 2560; bf16_t* base = (bf16_t*)(ws + (isv ? PJ0_GV : PJ0_GR)); const int cb = C0 - (isv ? 2048 : 2560);
                        store8bf(base + (size_t)row * 512 + cb + 32 * wc + 8 * fq, v0, v1);
                    } else if (C0 == 3072) {
                        if (wc == 0) { float* p = (float*)(ws + PJ0_GA) + (size_t)row * 32 + 8 * fq; *(f32x4*)p = v0; *(f32x4*)(p + 4) = v1; }
                    }
                }
            }
    }
};
struct EpiRes {
    static constexpr bool PERM = false, AFTER_DRAIN = false;
    const float* baseL; const float* baseC; float* outL; float* outC; const float* gate;
    __device__ __forceinline__ void operator()(const f32x4 (&acc)[2][2][4][2], const Unit& u, int wr, int wc, int fr, int fq) const {
        const bool lat = u.pm < 64; const int tm = lat ? u.pm : u.pm - 64, bi = lat ? (u.pm >> 4) : 4;
        const float* base = (lat ? baseL : baseC) + (size_t)tm * BM * 1024; float* out = (lat ? outL : outC) + (size_t)tm * BM * 1024;
        const int col0 = u.pn * BM + wc * 32 + 4 * fq;
        f32x4 gv[2][2];
#pragma unroll
        for (int bj = 0; bj < 2; ++bj)
#pragma unroll
            for (int n = 0; n < 2; ++n) gv[bj][n] = *(const f32x4*)(gate + bi * 6144 + col0 + bj * HALF + n * 16);
#pragma unroll
        for (int ai = 0; ai < 2; ++ai)
#pragma unroll
            for (int m = 0; m < 4; ++m) { const size_t off = (size_t)(ai * HALF + wr * 64 + m * 16 + fr) * 1024 + col0;
#pragma unroll
                for (int bj = 0; bj < 2; ++bj)
#pragma unroll
                    for (int n = 0; n < 2; ++n) { const f32x4 bs = *(const f32x4*)(base + off + bj * HALF + n * 16); *(f32x4*)(out + off + bj * HALF + n * 16) = bs + gv[bj][n] * acc[ai][bj][m][n]; }
                if (m & 1) asm volatile("" ::: "memory"); }
    }
};
template <int CTRL> __device__ __forceinline__ float dpp_mov(float old, float src) {
    return __builtin_bit_cast(float, __builtin_amdgcn_update_dpp(__builtin_bit_cast(int, old), __builtin_bit_cast(int, src), CTRL, 0xf, 0xf, false));
}
struct EpiUp {
    static constexpr bool PERM = true, AFTER_DRAIN = false;
    bf16_t* act; float* edge; const float* cw; const float* cb;
    template <int M> __device__ __forceinline__ f32x4 conv_m(const f32x4 (&acc)[4][2], int n, const f32x4& w0, const f32x4& w1, const f32x4& w2, const f32x4& bs) const {
        f32x4 y;
#pragma unroll
        for (int e = 0; e < 4; ++e) {
            const float x = acc[M][n][e];
            const float tp = M > 0 ? dpp_mov<0x121>(0.f, acc[M > 0 ? M - 1 : 0][n][e]) : 0.f;
            const float pv = dpp_mov<0x111>(tp, x);
            const float tn = M < 3 ? dpp_mov<0x12F>(0.f, acc[M < 3 ? M + 1 : 3][n][e]) : 0.f;
            const float nx = dpp_mov<0x101>(tn, x);
            y[e] = w0[e] * pv + w1[e] * x + w2[e] * nx + bs[e];
        }
        return y;
    }
    template <int M> __device__ __forceinline__ void row_m(const f32x4 (&aa)[4][2], const f32x4 (&ab)[4][2], int n, const f32x4 (&wa)[4], const f32x4 (&wb)[4], int blk, int fr, int jn) const {
        f32x4 ya = conv_m<M>(aa, n, wa[0], wa[1], wa[2], wa[3]);
#pragma unroll
        for (int e = 0; e < 4; ++e) { const float a = ya[e]; ya[e] = a * __builtin_amdgcn_rcpf(1.0f + __expf(-a)); }
        const f32x4 yb = conv_m<M>(ab, n, wb[0], wb[1], wb[2], wb[3]);
        const f32x4 r = ya * yb;
        u32x2 w; w.x = cvt_pk_bf16(r[0], r[1]); w.y = cvt_pk_bf16(r[2], r[3]);
        const bool is_edge = (M == 0 && fr == 0) || (M == 3 && fr == 15);
        if (!is_edge) *(u32x2*)(act + (size_t)(blk * 64 + M * 16 + fr) * 2816 + jn) = w;
        if (M == 0) { if (fr < 2) { float* p = edge + ((size_t)(blk * 4 + fr) * 5632 + jn); *(f32x4*)p = aa[0][n]; *(f32x4*)(p + 2816) = ab[0][n]; } }
        if (M == 3) { if (fr >= 14) { float* p = edge + ((size_t)(blk * 4 + fr - 12) * 5632 + jn); *(f32x4*)p = aa[3][n]; *(f32x4*)(p + 2816) = ab[3][n]; } }
        asm volatile("" ::: "memory");
    }
    __device__ __forceinline__ void operator()(const f32x4 (&acc)[2][2][4][2], const Unit& u, int wr, int wc, int fr, int fq) const {
        const int j0 = u.pn * 128 + wc * 32 + 8 * fq;
#pragma unroll
        for (int n = 0; n < 2; ++n) {
            const int jn = j0 + 4 * n;
            f32x4 wa[4], wb[4];
#pragma unroll
            for (int i = 0; i < 3; ++i) { wa[i] = *(const f32x4*)(cw + i * 5632 + jn); wb[i] = *(const f32x4*)(cw + i * 5632 + 2816 + jn); }
            wa[3] = *(const f32x4*)(cb + jn); wb[3] = *(const f32x4*)(cb + 2816 + jn);
#pragma unroll
            for (int ai = 0; ai < 2; ++ai) {
                const int blk = u.pm * 4 + ai * 2 + wr;
                row_m<0>(acc[ai][0], acc[ai][1], n, wa, wb, blk, fr, jn);
                row_m<1>(acc[ai][0], acc[ai][1], n, wa, wb, blk, fr, jn);
                row_m<2>(acc[ai][0], acc[ai][1], n, wa, wb, blk, fr, jn);
                row_m<3>(acc[ai][0], acc[ai][1], n, wa, wb, blk, fr, jn);
            }
        }
    }
};
struct EpiProj1 {
    static constexpr bool PERM = true, AFTER_DRAIN = false;
    unsigned char* ws;
    __device__ __forceinline__ void operator()(const f32x4 (&acc)[2][2][4][2], const Unit& u, int wr, int wc, int fr, int fq) const {
#pragma unroll
        for (int ai = 0; ai < 2; ++ai)
#pragma unroll
            for (int m = 0; m < 4; ++m) {
                const int row = u.pm * BM + ai * HALF + wr * 64 + m * 16 + fr; const bool lat = u.pm < 64;
                const int s = row & 4095, pos = (wc >> 1) == 0 ? (s >> 6) : (s & 63);
#pragma unroll
                for (int bj = 0; bj < 2; ++bj) {
                    const int C0 = u.pn * BM + bj * HALF;
                    f32x4 v0 = acc[ai][bj][m][0], v1 = acc[ai][bj][m][1];
                    if (C0 < 2048) {
                        const bool isq = C0 < 1024; if (isq && !lat) continue;
                        if (lat) {
                            const f32x2* rp = (const f32x2*)(ws + PJ1_ROPE) + pos * 32 + 16 * (wc & 1) + 4 * fq;
                            const f32x4 cs0 = *(const f32x4*)rp, cs1 = *(const f32x4*)(rp + 2);
                            const f32x4 c = {cs0[0], cs0[2], cs1[0], cs1[2]}, sn = {cs0[1], cs0[3], cs1[1], cs1[3]};
                            const f32x4 o1 = v0 * c - v1 * sn, o2 = v1 * c + v0 * sn; v0 = o1; v1 = o2;
                        }
                        if (!isq) { v0 = v0 * 0.08838834764831845f; v1 = v1 * 0.08838834764831845f; }
                        store8bf((bf16_t*)(ws + (isq ? PJ1_RQ : PJ1_RK)) + (size_t)row * 1024 + (C0 & 1023) + 32 * wc + 8 * fq, v0, v1);
                    } else if (C0 < 4096) {
                        store8bf((bf16_t*)(ws + PJ1_RV) + (size_t)row * 2048 + (C0 - 2048) + 32 * wc + 8 * fq, v0, v1);
                    } else {
                        if (lat) store8bf((bf16_t*)(ws + PJ1_RG) + (size_t)row * 2048 + (C0 - 4096) + 32 * wc + 8 * fq, v0, v1);
                    }
                }
            }
    }
};

template <class Epi, class Sched, bool ALIGN_EPI = false, bool SP2 = false>
__device__ __forceinline__ void gemm_phase(PG8_LAS unsigned char* lds, const Gemm g, const Sched& S, const Epi& E) {
    const int tid = threadIdx.x, wid = __builtin_amdgcn_readfirstlane(tid >> 6), lane = tid & 63, wr = wid >> 2, wc = wid & 3, fr = lane & 15, fq = lane >> 4;
    const int K = g.K, nt = K / BK;
    unsigned voffA[2], voffB[2];
#pragma unroll
    for (int i = 0; i < 2; ++i) { int R, C; stage_rc(tid * 16 + i * 8192, R, C); const int Rb = Epi::PERM ? ((R & ~31) + perm32(R & 31)) : R;
        voffA[i] = (unsigned)(R * K + C) * 2u; voffB[i] = (unsigned)(Rb * K + C) * 2u; }
    const size_t kstep = (size_t)(BK * 2);
    const size_t hstep = (size_t)HALF * K * 2;
    const size_t tstep = 2 * hstep;
    const unsigned ldsw = (unsigned)wid * 1024u;
    const int aoff = lds_byte(wr * 64 + fr, fq * 8), boff = lds_byte(wc * 32 + fr, fq * 8);
#define PG8_SA(b, h) (((b) * 2 + (h)) * HTB)
#define PG8_SB(b, h) ((4 + (b) * 2 + (h)) * HTB)
#define PG8_STAGE(bufoff, gbase, voff) do { _Pragma("unroll") for (int _i = 0; _i < 2; ++_i) \
        __builtin_amdgcn_global_load_lds((const unsigned*)((const char*)(gbase) + (voff)[_i]), (PG8_LAS unsigned*)(lds + (bufoff) + ldsw + _i * 8192), 16, 0, 0); } while (0)
#define PG8_LDA(dst, b, h) do { _Pragma("unroll") for (int m = 0; m < 4; ++m) _Pragma("unroll") for (int k = 0; k < 2; ++k) dst[m][k] = *(const PG8_LAS bf16x8*)(lds + PG8_SA(b, h) + aoff + m * 2048 + k * 1024); } while (0)
#define PG8_LDB(dst, b, h) do { _Pragma("unroll") for (int n = 0; n < 2; ++n) _Pragma("unroll") for (int k = 0; k < 2; ++k) dst[n][k] = *(const PG8_LAS bf16x8*)(lds + PG8_SB(b, h) + boff + n * 2048 + k * 1024); } while (0)
#define PG8_MMA(ai, bj, At, Bt) do { __builtin_amdgcn_s_setprio(1); _Pragma("unroll") for (int m = 0; m < 4; ++m) _Pragma("unroll") for (int n = 0; n < 2; ++n) _Pragma("unroll") for (int k = 0; k < 2; ++k) \
        acc[ai][bj][m][n] = __builtin_amdgcn_mfma_f32_16x16x32_bf16(Bt[n][k], At[m][k], acc[ai][bj][m][n], 0, 0, 0); __builtin_amdgcn_s_setprio(0); } while (0)
#define PG8_WAIT_V(n) asm volatile("s_waitcnt vmcnt(" #n ")" ::: "memory")
#define PG8_WAIT_L(n) asm volatile("s_waitcnt lgkmcnt(" #n ")" ::: "memory")
#define PG8_BAR __builtin_amdgcn_s_barrier()
#define PG8_SCHED __builtin_amdgcn_sched_barrier(0)
    Unit cur, nxt; int ui = 0;
    if (!S.next(0, cur)) return;
    f32x4 acc[2][2][4][2];
#pragma unroll
    for (int a = 0; a < 2; ++a)
#pragma unroll
        for (int b = 0; b < 2; ++b)
#pragma unroll
            for (int m = 0; m < 4; ++m)
#pragma unroll
                for (int n = 0; n < 2; ++n) acc[a][b][m][n] = (f32x4){0.f, 0.f, 0.f, 0.f};
    bf16x8 At[4][2], B0[2][2], B1[2][2];
    const char* cA = (const char*)g.A + (size_t)cur.pm * tstep; const char* cB = (const char*)g.Bt + (size_t)cur.pn * tstep;
    S.a_ready(cur);
    if constexpr (SP2) {
        PG8_STAGE(PG8_SB(0, 0), cB, voffB); PG8_STAGE(PG8_SB(0, 1), cB + hstep, voffB); PG8_STAGE(PG8_SA(0, 0), cA, voffA); PG8_STAGE(PG8_SA(0, 1), cA + hstep, voffA);
        if (wr == 1) PG8_BAR;
        PG8_WAIT_V(2); PG8_BAR;
        PG8_STAGE(PG8_SB(1, 0), cB + kstep, voffB); PG8_STAGE(PG8_SA(1, 0), cA + kstep, voffA); PG8_STAGE(PG8_SB(1, 1), cB + hstep + kstep, voffB);
        PG8_WAIT_V(6); PG8_BAR;
    } else {
        PG8_STAGE(PG8_SB(0, 0), cB, voffB); PG8_STAGE(PG8_SA(0, 0), cA, voffA); PG8_STAGE(PG8_SB(0, 1), cB + hstep, voffB); PG8_STAGE(PG8_SA(0, 1), cA + hstep, voffA);
        if (wr == 1) PG8_BAR;
        PG8_WAIT_V(4); PG8_BAR;
        PG8_STAGE(PG8_SB(1, 0), cB + kstep, voffB); PG8_STAGE(PG8_SA(1, 0), cA + kstep, voffA); PG8_STAGE(PG8_SB(1, 1), cB + hstep + kstep, voffB);
        PG8_WAIT_V(6); PG8_BAR;
    }
    for (;;) {
        const bool has_next = S.next(ui + 1, nxt);
        const char* nA = has_next ? (const char*)g.A + (size_t)nxt.pm * tstep : cA; const char* nB = has_next ? (const char*)g.Bt + (size_t)nxt.pn * tstep : cB;
        for (int t = 0; t < nt; t += 2) {
            const bool last = (t == nt - 2);
            const char* a1 = cA + (size_t)(t + 1) * kstep;
            const char* a2 = last ? nA : cA + (size_t)(t + 2) * kstep; const char* b2 = last ? nB : cB + (size_t)(t + 2) * kstep;
            const char* a3 = a2 + kstep; const char* b3 = b2 + kstep;
            if (last && has_next) S.a_ready(nxt);
            if constexpr (SP2) {
            PG8_LDB(B0, 0, 0); PG8_LDB(B1, 0, 1); PG8_SCHED; PG8_LDA(At, 0, 0); PG8_STAGE(PG8_SA(1, 1), a1 + hstep, voffA);
            PG8_WAIT_V(8); PG8_WAIT_L(0); PG8_BAR; PG8_MMA(0, 0, At, B0); PG8_MMA(0, 1, At, B1); PG8_BAR; PG8_SCHED;
            PG8_LDA(At, 0, 1); PG8_STAGE(PG8_SB(0, 0), b2, voffB); PG8_STAGE(PG8_SB(0, 1), b2 + hstep, voffB); PG8_STAGE(PG8_SA(0, 0), a2, voffA);
            PG8_WAIT_V(8); PG8_WAIT_L(0); PG8_BAR; PG8_MMA(1, 0, At, B0); PG8_MMA(1, 1, At, B1); PG8_BAR; PG8_SCHED;
            PG8_LDB(B0, 1, 0); PG8_LDB(B1, 1, 1); PG8_SCHED; PG8_LDA(At, 1, 0); PG8_STAGE(PG8_SA(0, 1), a2 + hstep, voffA);
            PG8_WAIT_V(8); PG8_WAIT_L(0); PG8_BAR; PG8_MMA(0, 0, At, B0); PG8_MMA(0, 1, At, B1); PG8_BAR; PG8_SCHED;
            PG8_LDA(At, 1, 1); PG8_STAGE(PG8_SB(1, 0), b3, voffB); PG8_STAGE(PG8_SB(1, 1), b3 + hstep, voffB); PG8_STAGE(PG8_SA(1, 0), a3, voffA);
            PG8_WAIT_V(8); PG8_WAIT_L(0); PG8_BAR; PG8_MMA(1, 0, At, B0); PG8_MMA(1, 1, At, B1); PG8_BAR; PG8_SCHED;
            } else {
            PG8_LDB(B0, 0, 0); PG8_SCHED; PG8_LDA(At, 0, 0); PG8_STAGE(PG8_SA(1, 1), a1 + hstep, voffA);
            PG8_WAIT_L(8); PG8_BAR; PG8_WAIT_L(0); PG8_MMA(0, 0, At, B0); PG8_BAR; PG8_SCHED;
            PG8_LDB(B1, 0, 1); PG8_STAGE(PG8_SB(0, 0), b2, voffB);
            PG8_BAR; PG8_WAIT_L(0); PG8_MMA(0, 1, At, B1); PG8_BAR;
            PG8_LDA(At, 0, 1); PG8_STAGE(PG8_SA(0, 0), a2, voffA);
            PG8_BAR; PG8_WAIT_L(0); PG8_MMA(1, 0, At, B0); PG8_BAR; PG8_SCHED;
            PG8_STAGE(PG8_SB(0, 1), b2 + hstep, voffB);
            PG8_WAIT_V(6); PG8_BAR; PG8_MMA(1, 1, At, B1); PG8_BAR;
            PG8_LDB(B0, 1, 0); PG8_SCHED; PG8_LDA(At, 1, 0); PG8_STAGE(PG8_SA(0, 1), a2 + hstep, voffA);
            PG8_WAIT_L(8); PG8_BAR; PG8_WAIT_L(0); PG8_MMA(0, 0, At, B0); PG8_BAR; PG8_SCHED;
            PG8_LDB(B1, 1, 1); PG8_STAGE(PG8_SB(1, 0), b3, voffB);
            PG8_BAR; PG8_WAIT_L(0); PG8_MMA(0, 1, At, B1); PG8_BAR;
            PG8_LDA(At, 1, 1); PG8_STAGE(PG8_SA(1, 0), a3, voffA);
            PG8_BAR; PG8_WAIT_L(0); PG8_MMA(1, 0, At, B0); PG8_BAR; PG8_SCHED;
            PG8_STAGE(PG8_SB(1, 1), b3 + hstep, voffB);
            PG8_WAIT_V(6); PG8_BAR; PG8_MMA(1, 1, At, B1); PG8_BAR;
            }
        }
        if constexpr (ALIGN_EPI) { if (wr == 0) PG8_BAR; }
        if constexpr (!Epi::AFTER_DRAIN) { E(acc, cur, wr, wc, fr, fq); S.done(cur); }
        if (!has_next) break;
#pragma unroll
        for (int a = 0; a < 2; ++a)
#pragma unroll
            for (int b = 0; b < 2; ++b)
#pragma unroll
                for (int m = 0; m < 4; ++m)
#pragma unroll
                    for (int n = 0; n < 2; ++n) acc[a][b][m][n] = (f32x4){0.f, 0.f, 0.f, 0.f};
        cur = nxt; cA = nA; cB = nB; ++ui;
        if constexpr (ALIGN_EPI) { if (wr == 1) PG8_BAR; }
    }
    PG8_WAIT_V(0);
    if constexpr (!ALIGN_EPI) { if (wr == 0) PG8_BAR; }
    PG8_BAR;
    if constexpr (Epi::AFTER_DRAIN) { E.fused(acc, cur, wr, wc, fr, fq, lds, wid, lane); S.done(cur); }
#undef PG8_SA
#undef PG8_SB
#undef PG8_STAGE
#undef PG8_LDA
#undef PG8_LDB
#undef PG8_MMA
#undef PG8_WAIT_V
#undef PG8_WAIT_L
#undef PG8_BAR
#undef PG8_SCHED
}
}
#define GAS __attribute__((address_space(1)))
#define LAS __attribute__((address_space(3)))
typedef unsigned short bf16;
typedef unsigned v4u __attribute__((ext_vector_type(4)));
typedef float f32x4 __attribute__((ext_vector_type(4)));
typedef short bf16x8 __attribute__((ext_vector_type(8)));
typedef GAS unsigned gu32;
typedef GAS unsigned long long gu64;
#define RLX_AGENT __ATOMIC_RELAXED, __HIP_MEMORY_SCOPE_AGENT
#define LDS_WAIT() asm volatile("s_waitcnt lgkmcnt(0)" ::: "memory")
#define VM_WAIT() asm volatile("s_waitcnt vmcnt(0)" ::: "memory")
__device__ __forceinline__ unsigned long long rt() { return __builtin_amdgcn_s_memrealtime(); }
__device__ __forceinline__ unsigned f2bf(float f) { unsigned u = __builtin_bit_cast(unsigned, f); return (u + 0x7fffu + ((u >> 16) & 1u)) >> 16; }
__device__ __forceinline__ unsigned pk2(float lo, float hi) { return f2bf(lo) | (f2bf(hi) << 16); }
typedef float f32x2v __attribute__((ext_vector_type(2)));

#define XB_TMO      128
#define XB_XCNT(j)  (256  + 64 * (j))
#define XB_XSUB(j)  (1280 + 64 * (j))
#define XB_XGEN(j)  (2304 + 64 * (j))
#define XB_TOP      3328
#define XB_TOPGEN   3392
#define XCD_BAR_WORDS 3456
#define XB_SPIN_CAP (1u << 24)

__device__ __forceinline__ unsigned xb_ld(unsigned* p)              { return __hip_atomic_load(p, __ATOMIC_RELAXED, __HIP_MEMORY_SCOPE_AGENT); }
__device__ __forceinline__ unsigned xb_add(unsigned* p, unsigned v) { return __hip_atomic_fetch_add(p, v, __ATOMIC_RELAXED, __HIP_MEMORY_SCOPE_AGENT); }
__device__ __forceinline__ unsigned xb_xcc_id() { return (unsigned)__builtin_amdgcn_s_getreg((3 << 11) | 20) & 0xFu; }
#define XB_SPIN(cond, bar) do { unsigned _sp = 0; while (cond) { __builtin_amdgcn_s_sleep(1); \
    if ((++_sp & 255u) == 0u) { if (xb_ld(&(bar)[XB_TMO])) break; if (_sp > XB_SPIN_CAP) { atomicAdd(&(bar)[XB_TMO], 1u); break; } } } } while (0)

struct XcdBarrier {
    unsigned* bar; unsigned x;
    volatile LAS unsigned* st;
};

__device__ __forceinline__ XcdBarrier xcd_barrier_post(unsigned* bar, volatile LAS unsigned* st) {
    XcdBarrier b; b.bar = bar; b.x = xb_xcc_id(); b.st = st;
    if (threadIdx.x == 0) (void)xb_add(&bar[XB_XCNT(b.x)], 1u);
    return b;
}
__device__ __forceinline__ void xcd_barrier_complete(unsigned* bar, unsigned x, unsigned& nloc, unsigned& nx) {
    const unsigned G = gridDim.x * gridDim.y * gridDim.z;
    unsigned sum, cnt, mine, sp = 0u;
    for (;;) {
        sum = 0u; cnt = 0u; mine = 0u;
#pragma unroll
        for (unsigned j = 0; j < 16; ++j) { const unsigned c = xb_ld(&bar[XB_XCNT(j)]); sum += c; cnt += (c > 0u) ? 1u : 0u; mine = (j == x) ? c : mine; }
        if (sum == G) break;
        __builtin_amdgcn_s_sleep(1);
        if ((++sp & 255u) == 0u) { if (xb_ld(&bar[XB_TMO])) break; if (sp > XB_SPIN_CAP) { atomicAdd(&bar[XB_TMO], 1u); break; } }
    }
    nloc = mine > 0u ? mine : 1u; nx = cnt > 0u ? cnt : 1u;
}

__device__ __forceinline__ void xcd_barrier(const XcdBarrier& b) {
    asm volatile("s_waitcnt vmcnt(0)" ::: "memory");
    __syncthreads();
    if (threadIdx.x == 0) {
        unsigned* bar = b.bar;
        __builtin_amdgcn_s_waitcnt(0);
        unsigned nloc = b.st[0], nx = b.st[1];
        if (nloc == 0u) { xcd_barrier_complete(bar, b.x, nloc, nx); b.st[0] = nloc; b.st[1] = nx; }
        const unsigned old = xb_add(&bar[XB_XSUB(b.x)], 1u);
        const unsigned gen = old / nloc;
        if (old + 1u == (gen + 1u) * nloc) {
            __builtin_amdgcn_fence(__ATOMIC_RELEASE, "agent");
            asm volatile("s_waitcnt vmcnt(0)" ::: "memory");
            const unsigned og = xb_add(&bar[XB_TOP], 1u);
            const unsigned tg = og / nx;
            if (og + 1u == (tg + 1u) * nx) xb_add(&bar[XB_TOPGEN], 1u);
            else XB_SPIN(xb_ld(&bar[XB_TOPGEN]) == tg, bar);
            __builtin_amdgcn_fence(__ATOMIC_ACQUIRE, "agent");
            xb_add(&bar[XB_XGEN(b.x)], 1u);
            asm volatile("s_waitcnt vmcnt(0)" ::: "memory");
        } else {
            XB_SPIN(xb_ld(&bar[XB_XGEN(b.x)]) == gen, bar);
            __builtin_amdgcn_fence(__ATOMIC_ACQUIRE, "agent");
            asm volatile("s_waitcnt vmcnt(0)" ::: "memory");
        }
    }
    __syncthreads();
}

constexpr int NWAVES = 8;
constexpr int NB = 4, SEQ = 4096, CTXL = 256, DM = 1024, ML = NB * SEQ, MC = NB * CTXL, MT = ML + MC;
constexpr int DFF = 2816, NUP = 2 * DFF, N0P = 3328, N1 = 6144;
constexpr float EPS = 1e-6f;
constexpr size_t MiB = 1u << 20;
constexpr size_t WS_CTL = 0, CTL_ZERO_BYTES = 64 * 1024;
constexpr size_t WS_MOD = 1 * MiB;
constexpr size_t WS_ROPE = 1 * MiB + 512 * 1024;
constexpr size_t WS_XC = 2 * MiB;
constexpr size_t WS_WIN1T = 8 * MiB;
constexpr size_t WS_H = 20 * MiB;
constexpr size_t WS_WIN0T = 54 * MiB, WS_WO0T = WS_WIN0T + 6656 * 1024, WS_WUPT0 = WS_WO0T + 2 * MiB, WS_WDNT0 = WS_WUPT0 + 11 * MiB;
constexpr size_t WS_NAQ = 79 * MiB, WS_NAK = 96 * MiB, WS_NAV = 113 * MiB;
constexpr size_t WS_GQ = 130 * MiB, WS_GK = WS_GQ + 8704 * 1024, WS_GV = 147 * MiB, WS_GR = 164 * MiB, WS_GA = 181 * MiB;
constexpr size_t WS_CAT = 184 * MiB;
constexpr size_t WS_X218 = 218 * MiB;
constexpr size_t WS_ACT0 = 80 * MiB, WS_EDGE0 = 174 * MiB;
constexpr size_t WS_WO1T = 252 * MiB;
constexpr size_t WS_RQ = 54 * MiB, WS_RK = 86 * MiB, WS_RV = 120 * MiB, WS_RG = 188 * MiB;
constexpr size_t WS_WUPT1 = 54 * MiB, WS_WDNT1 = 65 * MiB, WS_ACT1 = 72 * MiB, WS_EDGE1 = 160 * MiB;
constexpr size_t WS_END = 256 * MiB;
static_assert(WS_NAQ == pg8::PJ0_NAQ && WS_NAK == pg8::PJ0_NAK && WS_NAV == pg8::PJ0_NAV && WS_GQ == pg8::PJ0_GQ && WS_GK == pg8::PJ0_GK && WS_GV == pg8::PJ0_GV && WS_GR == pg8::PJ0_GR && WS_GA == pg8::PJ0_GA, "proj0 map");
static_assert(WS_RQ == pg8::PJ1_RQ && WS_RK == pg8::PJ1_RK && WS_RV == pg8::PJ1_RV && WS_RG == pg8::PJ1_RG && WS_ROPE == pg8::PJ1_ROPE, "proj1 map");
constexpr int CW_BAR = 4096;
constexpr int RING_OFF = 0, RING_BYTES = 131072, LDSCTL_OFF = RING_BYTES, MISC_OFF = LDSCTL_OFF + 320, LDS_BYTES = 147456;

struct Args { const float* in[26]; float* out; unsigned char* ws; int ph_lo, ph_hi; };
struct Frame {
    LAS unsigned char* lds; int tid, lane, wave, G, bid;
    const Args* a; float* out; unsigned char* ws;
};
#define IN_X 0
#define IN_C 1
#define IN_CTX 2
#define IN_CCTX 3
#define IN_WMOD 4
#define IN_BMOD 5
#define IN_N1G 6
#define IN_N2G 7
#define IN_WIN0 8
#define IN_WO0 9
#define IN_RPB 10
#define IN_WAF 11
#define IN_BAF 12
#define IN_WAB 13
#define IN_BAB 14
#define IN_GNG 15
#define IN_WIN1 16
#define IN_WO1 17
#define IN_DECF 18
#define IN_DECB 19
#define IN_RNG 20
#define IN_WUP 21
#define IN_CW 22
#define IN_CB 23
#define IN_WDN 24
#define IN_FNG 25

__device__ __forceinline__ float wave_sum(float v) {
#pragma unroll
    for (int o = 1; o < 64; o <<= 1) v += __shfl_xor(v, o);
    return v;
}
__device__ __forceinline__ float wave_max(float v) {
#pragma unroll
    for (int o = 1; o < 64; o <<= 1) v = fmaxf(v, __shfl_xor(v, o));
    return v;
}
__device__ __forceinline__ float bf2f(bf16 b) { return __builtin_bit_cast(float, (unsigned)b << 16); }
__device__ __forceinline__ float silu_f(float a) { return a / (1.0f + __expf(-a)); }
__device__ __forceinline__ float logsig_f(float z) { return fminf(z, 0.f) - log1pf(__expf(-fabsf(z))); }

struct MapId { int nsrc; __device__ __forceinline__ int operator()(int n) const { return n < nsrc ? n : -1; } };
struct MapUp { __device__ __forceinline__ int operator()(int n) const { return ((n >> 7) & 1) * DFF + (n >> 8) * 128 + (n & 127); } };
struct MapIn1 { __device__ __forceinline__ int operator()(int n) const {
    if (n >= 2048) return n;
    const int p = n & 127, wc = p >> 5, fq = (p >> 3) & 3, nn = (p >> 2) & 1, e = p & 3;
    return (n & ~127) + (wc >> 1) * 64 + nn * 32 + (wc & 1) * 16 + 4 * fq + e; } };
template <class MAP> __device__ __forceinline__ void transpose_item(const float* W, int K, int Nsrc, int Ndst, bf16* WT, LAS float* scr, int item, int lane, const MAP& map) {
    const int nblk = Ndst / 32, kb = item / nblk, nb = item % nblk, k0 = 64 * kb, n0 = 32 * nb;
    const int sc = map(n0 + (lane & 31));
#pragma unroll 8
    for (int i = 0; i < 32; ++i) { const int kk = 2 * i + (lane >> 5); scr[kk * 33 + (lane & 31)] = sc >= 0 ? W[(size_t)(k0 + kk) * Nsrc + sc] : 0.f; }
    LDS_WAIT(); asm volatile("" ::: "memory");
    const int c = lane & 7;
#pragma unroll
    for (int j = 0; j < 4; ++j) { const int n = (lane >> 3) + 8 * j; const LAS float* s = scr + (8 * c) * 33 + n;
        v4u o; o.x = pk2(s[0 * 33], s[1 * 33]); o.y = pk2(s[2 * 33], s[3 * 33]); o.z = pk2(s[4 * 33], s[5 * 33]); o.w = pk2(s[6 * 33], s[7 * 33]);
        *(GAS v4u*)(WT + (size_t)(n0 + n) * K + k0 + 8 * c) = o; }
    LDS_WAIT(); asm volatile("" ::: "memory");
}
template <class MAP> __device__ __forceinline__ void transpose_all(Frame& F, const float* W, int K, int Nsrc, int Ndst, bf16* WT, const MAP& map) {
    LAS float* scr = (LAS float*)(F.lds + RING_OFF + F.wave * 16384);
    const int gw = F.wave * F.G + F.bid, NGW = F.G * NWAVES, nitems = (K / 64) * (Ndst / 32);
    for (int it = gw; it < nitems; it += NGW) transpose_item(W, K, Nsrc, Ndst, WT, scr, it, F.lane, map);
}

__device__ __forceinline__ void phase_prep(Frame& F) {
    unsigned char* ws = F.ws;
    transpose_all(F, F.a->in[IN_WIN0], 1024, 3104, N0P, (bf16*)(ws + WS_WIN0T), MapId{3104});
    transpose_all(F, F.a->in[IN_WO0], 1024, 1024, 1024, (bf16*)(ws + WS_WO0T), MapId{1024});
    transpose_all(F, F.a->in[IN_WUP], 1024, NUP, NUP, (bf16*)(ws + WS_WUPT0), MapUp{});
    transpose_all(F, F.a->in[IN_WDN], DFF, 1024, 1024, (bf16*)(ws + WS_WDNT0), MapId{1024});
    transpose_all(F, F.a->in[IN_WIN1], 1024, N1, N1, (bf16*)(ws + WS_WIN1T), MapIn1{});
    transpose_all(F, F.a->in[IN_WO1], 2048, 1024, 1024, (bf16*)(ws + WS_WO1T), MapId{1024});
    __syncthreads();
    LAS float* sv = (LAS float*)(F.lds);
    LAS float* red = (LAS float*)(F.lds + 32768);
    for (int i = F.tid; i < 5 * 1024; i += 512) { const int bi = i >> 10, k = i & 1023; const float v = bi < 4 ? F.a->in[IN_C][bi * 1024 + k] : F.a->in[IN_CCTX][k]; sv[i] = silu_f(v); }
    __syncthreads();
    float* mod = (float*)(ws + WS_MOD);
    for (int it = F.bid; it < 2 * 96; it += F.G) {
        const int l = it / 96, n = (it % 96) * 64 + (F.tid & 63), kp = F.tid >> 6;
        const float* w = F.a->in[IN_WMOD] + (size_t)l * 1024 * 6144 + n;
        float a0 = 0.f, a1 = 0.f, a2 = 0.f, a3 = 0.f, a4 = 0.f;
#pragma unroll 8
        for (int kk = 0; kk < 128; ++kk) { const int k = kp * 128 + kk; const float wv = w[(size_t)k * 6144];
            a0 += sv[k] * wv; a1 += sv[1024 + k] * wv; a2 += sv[2048 + k] * wv; a3 += sv[3072 + k] * wv; a4 += sv[4096 + k] * wv; }
        const int c = F.tid & 63;
        red[(kp * 5 + 0) * 64 + c] = a0; red[(kp * 5 + 1) * 64 + c] = a1; red[(kp * 5 + 2) * 64 + c] = a2; red[(kp * 5 + 3) * 64 + c] = a3; red[(kp * 5 + 4) * 64 + c] = a4;
        __syncthreads();
        if (F.tid < 320) { const int bi = F.tid >> 6, cc = F.tid & 63; float s = 0.f;
#pragma unroll
            for (int p = 0; p < 8; ++p) s += red[(p * 5 + bi) * 64 + cc];
            const int nn = (it % 96) * 64 + cc;
            mod[((size_t)l * 5 + bi) * 6144 + nn] = s + F.a->in[IN_BMOD][l * 6144 + nn]; }
        __syncthreads();
    }
    if (F.bid == 0) { f32x2v* rope = (f32x2v*)(ws + WS_ROPE);
        for (int i = F.tid; i < 64 * 32; i += 512) { const int pos = i >> 5, f = i & 31; const float inv = powf(10000.f, -(float)(2 * f) / 64.f), ang = (float)pos * inv; rope[i] = (f32x2v){cosf(ang), sinf(ang)}; } }
}

__device__ __forceinline__ void phase_modnorm(Frame& F, const float* xl, const float* xc, int nrows, const float* g, const float* modl  , int shoff) {
    bf16* H = (bf16*)(F.ws + WS_H);
    const int gw = F.wave * F.G + F.bid, NGW = F.G * NWAVES;
    for (int m = gw; m < nrows; m += NGW) {
        const float* src = m < ML ? xl + (size_t)m * DM : xc + (size_t)(m - ML) * DM; const int bi = m < ML ? (m >> 12) : 4;
        const float* sh = modl + bi * 6144 + shoff; const float* sc = sh + 1024;
        f32x4 v[4]; float ss = 0.f;
#pragma unroll
        for (int j = 0; j < 4; ++j) { v[j] = *(const f32x4*)(src + 256 * j + 4 * F.lane); ss += (v[j].x * v[j].x + v[j].y * v[j].y) + (v[j].z * v[j].z + v[j].w * v[j].w); }
        const float rstd = 1.0f / sqrtf(wave_sum(ss) * (1.f / DM) + EPS);
#pragma unroll
        for (int j = 0; j < 4; ++j) { const int k = 256 * j + 4 * F.lane; const f32x4 gg = *(const f32x4*)(g + k), s1 = *(const f32x4*)(sc + k), s0 = *(const f32x4*)(sh + k);
            const f32x4 h = v[j] * rstd * gg * (s1 + 1.0f) + s0;
            *(unsigned long long*)(H + (size_t)m * DM + k) = (unsigned long long)pk2(h.x, h.y) | ((unsigned long long)pk2(h.z, h.w) << 32); }
    }
}
__device__ __forceinline__ void phase_final(Frame& F) {
    const float* g = F.a->in[IN_FNG]; const int gw = F.wave * F.G + F.bid, NGW = F.G * NWAVES;
    for (int m = gw; m < ML; m += NGW) { float* p = F.out + (size_t)m * DM; f32x4 v[4]; float ss = 0.f;
#pragma unroll
        for (int j = 0; j < 4; ++j) { v[j] = *(const f32x4*)(p + 256 * j + 4 * F.lane); ss += (v[j].x * v[j].x + v[j].y * v[j].y) + (v[j].z * v[j].z + v[j].w * v[j].w); }
        const float rstd = 1.0f / sqrtf(wave_sum(ss) * (1.f / DM) + EPS);
#pragma unroll
        for (int j = 0; j < 4; ++j) { const int k = 256 * j + 4 * F.lane; *(f32x4*)(p + k) = v[j] * rstd * *(const f32x4*)(g + k); } }
}
__device__ __forceinline__ void phase_fixup(Frame& F, const float* edge, bf16* act, int nblk, const float* cw, const float* cb) {
    const int total = nblk * 2 * (DFF / 4);
    for (int i = F.bid * 512 + F.tid; i < total; i += F.G * 512) {
        const int j = (i % (DFF / 4)) * 4, e = (i / (DFF / 4)) & 1, blk = i / (DFF / 2);
        const int row = blk * 64 + (e ? 63 : 0);
        bool has_prev = true, has_next = true;
        if (e == 0) { has_prev = row < ML ? (row & 4095) != 0 : ((row - ML) & 255) != 0; } else { has_next = row < ML ? (row & 4095) != 4095 : ((row - ML) & 255) != 255; }
        const float* pp = e == 0 ? edge + (size_t)((blk - 1) * 4 + 3) * NUP : edge + (size_t)(blk * 4 + 2) * NUP;
        const float* pc = edge + (size_t)(blk * 4 + (e ? 3 : 0)) * NUP;
        const float* pn = e == 0 ? edge + (size_t)(blk * 4 + 1) * NUP : edge + (size_t)((blk + 1) * 4 + 0) * NUP;
        f32x4 y[2];
#pragma unroll
        for (int h = 0; h < 2; ++h) { const int c = h * DFF + j; const f32x4 z = {0.f, 0.f, 0.f, 0.f};
            const f32x4 xp = has_prev ? *(const f32x4*)(pp + c) : z, xc = *(const f32x4*)(pc + c), xn = has_next ? *(const f32x4*)(pn + c) : z;
            y[h] = *(const f32x4*)(cw + c) * xp + *(const f32x4*)(cw + NUP + c) * xc + *(const f32x4*)(cw + 2 * NUP + c) * xn + *(const f32x4*)(cb + c); }
        f32x4 r;
#pragma unroll
        for (int q = 0; q < 4; ++q) r[q] = silu_f(y[0][q]) * y[1][q];
        *(unsigned long long*)(act + (size_t)row * DFF + j) = (unsigned long long)pk2(r.x, r.y) | ((unsigned long long)pk2(r.z, r.w) << 32);
    }
}
__device__ __forceinline__ void phase_na_simple(Frame& F) {
    const bf16* naq = (const bf16*)(F.ws + WS_NAQ); const bf16* nak = (const bf16*)(F.ws + WS_NAK); const bf16* nav = (const bf16*)(F.ws + WS_NAV);
    bf16* cat = (bf16*)(F.ws + WS_CAT); const float* rpb = F.a->in[IN_RPB];
    const int gw = F.wave * F.G + F.bid, NGW = F.G * NWAVES, ntask = NB * 8 * 4352, lane = F.lane;
    for (int t = gw; t < ntask; t += NGW) {
        const int qi = t % 4352, bh = t / 4352, h = bh & 7, b = bh >> 3; const bool lat = qi < 4096;
        const size_t hb = (size_t)bh * 4352;
        float q[64];
        { const v4u* qp = (const v4u*)(naq + (hb + qi) * 64);
#pragma unroll
          for (int j = 0; j < 8; ++j) { const v4u w = qp[j];
#pragma unroll
              for (int e = 0; e < 4; ++e) { q[8 * j + 2 * e] = __builtin_bit_cast(float, w[e] << 16); q[8 * j + 2 * e + 1] = __builtin_bit_cast(float, w[e] & 0xffff0000u); } } }
        const int qr = qi >> 6, qc = qi & 63, r0 = min(max(qr - 4, 0), 56), c0 = min(max(qc - 8, 0), 48);
        float sc[6]; float mx = -1e30f;
#pragma unroll
        for (int i = 0; i < 6; ++i) {
            const int kidx = lane + 64 * i; int tok; float bias = 0.f; bool valid = true;
            if (i < 2) { const int ki = r0 + (kidx >> 4), kj = c0 + (kidx & 15); tok = ki * 64 + kj; valid = lat; if (lat) bias = rpb[(h * 15 + (ki - qr + 7)) * 31 + (kj - qc + 15)]; }
            else tok = 4096 + kidx - 128;
            float d = 0.f;
            if (valid) { const v4u* kp = (const v4u*)(nak + (hb + tok) * 64);
#pragma unroll
                for (int j = 0; j < 8; ++j) { const v4u w = kp[j];
#pragma unroll
                    for (int e = 0; e < 4; ++e) { d += q[8 * j + 2 * e] * __builtin_bit_cast(float, w[e] << 16); d += q[8 * j + 2 * e + 1] * __builtin_bit_cast(float, w[e] & 0xffff0000u); } } }
            sc[i] = valid ? d + bias : -1e30f; mx = fmaxf(mx, sc[i]);
        }
        mx = wave_max(mx); float l = 0.f;
#pragma unroll
        for (int i = 0; i < 6; ++i) { sc[i] = sc[i] > -1e29f ? __expf(sc[i] - mx) : 0.f; l += sc[i]; }
        l = wave_sum(l);
        float o = 0.f;
#pragma unroll
        for (int i = 0; i < 6; ++i) {
            if (i < 2 && !lat) continue;
            for (int j = 0; j < 64; ++j) { const int kidx = j + 64 * i; int tok;
                if (i < 2) tok = (r0 + (kidx >> 4)) * 64 + c0 + (kidx & 15); else tok = 4096 + kidx - 128;
                o += __shfl(sc[i], j) * bf2f(nav[(hb + tok) * 64 + lane]); }
        }
        const int row = lat ? b * 4096 + qi : ML + b * 256 + (qi - 4096);
        cat[(size_t)row * 1024 + h * 64 + lane] = (bf16)f2bf(o / l);
    }
}
__device__ __forceinline__ void phase_gla_gates_simple(Frame& F) {
    const float* ga = (const float*)(F.ws + WS_GA); float* E = (float*)(F.ws + WS_H);
    const int total = 2 * MT * 256;
    for (int idx = F.bid * 512 + F.tid; idx < total; idx += F.G * 512) {
        const int c = idx & 255, m = (idx >> 8) % MT, dir = idx / (MT * 256);
        const float* w = (dir ? F.a->in[IN_WAB] : F.a->in[IN_WAF]); const float* g = ga + (size_t)m * 32 + dir * 16; float z = (dir ? F.a->in[IN_BAB] : F.a->in[IN_BAF])[c];
#pragma unroll
        for (int r = 0; r < 16; ++r) z += g[r] * w[r * 256 + c];
        E[idx] = __expf(logsig_f(z) * (1.f / 16.f));
    }
}
__device__ __forceinline__ int seq_row(int b, int p, int dir) {
    if (p < CTXL) return ML + b * CTXL + (dir ? CTXL - 1 - p : p);
    const int s = p - CTXL; return b * SEQ + (dir ? SEQ - 1 - s : s);
}
__device__ __forceinline__ void phase_gla_rec_simple(Frame& F) {
    const bf16* gq = (const bf16*)(F.ws + WS_GQ); const bf16* gk = (const bf16*)(F.ws + WS_GK); const bf16* gv = (const bf16*)(F.ws + WS_GV);
    const float* E = (const float*)(F.ws + WS_H);
    const int gw = F.wave * F.G + F.bid, NGW = F.G * NWAVES, lane = F.lane;
    for (int t = gw; t < 64; t += NGW) {
        const int dvg = t & 1, dir = (t >> 1) & 1, h = (t >> 2) & 3, b = t >> 4;
        float* O = (float*)(F.ws + (dir ? WS_NAQ : WS_X218));
        float S[64];
#pragma unroll
        for (int i = 0; i < 64; ++i) S[i] = 0.f;
        for (int p = 0; p < CTXL + SEQ; ++p) {
            const int m = __builtin_amdgcn_readfirstlane(seq_row(b, p, dir));
            const float v = bf2f(gv[(size_t)m * 512 + h * 128 + dvg * 64 + lane]);
            const float* e = E + ((size_t)dir * MT + m) * 256 + h * 64; const bf16* kp = gk + (size_t)m * 256 + h * 64; const bf16* qp = gq + (size_t)m * 256 + h * 64;
            float o = 0.f;
#pragma unroll
            for (int i = 0; i < 64; ++i) { S[i] = e[i] * S[i] + bf2f(kp[i]) * v; o += bf2f(qp[i]) * S[i]; }
            O[(size_t)m * 512 + h * 128 + dvg * 64 + lane] = o;
        }
    }
}
__device__ __forceinline__ void phase_gla_out_simple(Frame& F) {
    const float* Of = (const float*)(F.ws + WS_X218); const float* Ob = (const float*)(F.ws + WS_NAQ); const bf16* gr = (const bf16*)(F.ws + WS_GR); bf16* cat = (bf16*)(F.ws + WS_CAT);
    const float* gng = F.a->in[IN_GNG]; const int gw = F.wave * F.G + F.bid, NGW = F.G * NWAVES, lane = F.lane;
    for (int t = gw; t < MT * 4; t += NGW) { const int h = t & 3, m = t >> 2; const size_t o0 = (size_t)m * 512 + h * 128;
        const float a = Of[o0 + lane] + Ob[o0 + lane], c = Of[o0 + 64 + lane] + Ob[o0 + 64 + lane];
        const float rs = 1.0f / sqrtf(wave_sum(a * a + c * c) * (1.f / 128.f) + EPS);
        cat[(size_t)m * 1024 + 512 + h * 128 + lane] = (bf16)f2bf(a * rs * gng[lane] * silu_f(bf2f(gr[o0 + lane])));
        cat[(size_t)m * 1024 + 512 + h * 128 + 64 + lane] = (bf16)f2bf(c * rs * gng[64 + lane] * silu_f(bf2f(gr[o0 + 64 + lane]))); }
}
__device__ __forceinline__ void phase_ret_rec_simple(Frame& F, int hg) {
    const bf16* rq = (const bf16*)(F.ws + WS_RQ); const bf16* rk = (const bf16*)(F.ws + WS_RK); const bf16* rv = (const bf16*)(F.ws + WS_RV); bf16* O = (bf16*)(F.ws + WS_H);
    const int gw = F.wave * F.G + F.bid, NGW = F.G * NWAVES, lane = F.lane;
    for (int t = gw; t < 64; t += NGW) {
        const int dvg = t & 3, h4 = (t >> 2) & 3, b = t >> 4, h = hg * 4 + h4;
        for (int dir = 0; dir < 2; ++dir) {
            const float dec = (dir ? F.a->in[IN_DECB] : F.a->in[IN_DECF])[h]; const float gam = 1.0f / (1.0f + __expf(-dec));
            float S[128];
#pragma unroll
            for (int i = 0; i < 128; ++i) S[i] = 0.f;
            for (int p = 0; p < CTXL + SEQ; ++p) {
                const int m = __builtin_amdgcn_readfirstlane(seq_row(b, p, dir));
                const float v = bf2f(rv[(size_t)m * 2048 + h * 256 + dvg * 64 + lane]);
                const bf16* kp = rk + (size_t)m * 1024 + h * 128;
#pragma unroll
                for (int i = 0; i < 128; ++i) S[i] = gam * S[i] + bf2f(kp[i]) * v;
                if (m < ML) { const bf16* qp = rq + (size_t)m * 1024 + h * 128; float o = 0.f;
#pragma unroll
                    for (int i = 0; i < 128; ++i) o += bf2f(qp[i]) * S[i];
                    bf16* op = O + (size_t)m * 1024 + h4 * 256 + dvg * 64 + lane;
                    if (dir) o += bf2f(*op);
                    *op = (bf16)f2bf(o); }
            }
            asm volatile("s_waitcnt vmcnt(0)" ::: "memory");
        }
    }
}
__device__ __forceinline__ void phase_ret_out_simple(Frame& F, int hg) {
    const bf16* O = (const bf16*)(F.ws + WS_H); bf16* rg = (bf16*)(F.ws + WS_RG); const float* rng = F.a->in[IN_RNG];
    const int gw = F.wave * F.G + F.bid, NGW = F.G * NWAVES, lane = F.lane;
    for (int t = gw; t < ML * 4; t += NGW) { const int h4 = t & 3, m = t >> 2, h = hg * 4 + h4;
        float o[4]; float s = 0.f;
#pragma unroll
        for (int j = 0; j < 4; ++j) { o[j] = bf2f(O[(size_t)m * 1024 + h4 * 256 + 64 * j + lane]); s += o[j]; }
        const float mu = wave_sum(s) * (1.f / 256.f); float q = 0.f;
#pragma unroll
        for (int j = 0; j < 4; ++j) { o[j] -= mu; q += o[j] * o[j]; }
        const float rs = 1.0f / sqrtf(wave_sum(q) * (1.f / 256.f) + EPS);
#pragma unroll
        for (int j = 0; j < 4; ++j) { bf16* gp = rg + (size_t)m * 2048 + h * 256 + 64 * j + lane; *gp = (bf16)f2bf(o[j] * rs * rng[h * 256 + 64 * j + lane] * silu_f(bf2f(*gp))); } }
}

typedef short s16x4 __attribute__((ext_vector_type(4)));
typedef float f32x16 __attribute__((ext_vector_type(16)));
constexpr size_t WS_CK = 20 * MiB;
__device__ __forceinline__ bf16x8 tr_read8(LAS const unsigned char* p0, LAS const unsigned char* p1) {
    const s16x4 a = __builtin_amdgcn_ds_read_tr16_b64_v4i16((LAS s16x4*)p0), b = __builtin_amdgcn_ds_read_tr16_b64_v4i16((LAS s16x4*)p1);
    return __builtin_shufflevector(a, b, 0, 1, 2, 3, 4, 5, 6, 7);
}
__device__ __forceinline__ v4u scale8(v4u w, float s) {
    v4u o;
#pragma unroll
    for (int e = 0; e < 4; ++e) o[e] = pg8::cvt_pk_bf16(__builtin_bit_cast(float, w[e] << 16) * s, __builtin_bit_cast(float, w[e] & 0xffff0000u) * s);
    return o;
}
__device__ __forceinline__ int chunk_row(int b, int n, int dir) {
    if (n < 4) return ML + b * CTXL + 64 * (dir ? 3 - n : n);
    const int c = n - 4; return b * SEQ + 64 * (dir ? 63 - c : c);
}
__device__ __forceinline__ float log2_sigmoid(float d) { return -log2f(1.0f + __expf(-d)); }
__device__ __forceinline__ void phase_ret_scan(Frame& F) {
    const bf16* rk = (const bf16*)(F.ws + WS_RK); const bf16* rv = (const bf16*)(F.ws + WS_RV); bf16* ck = (bf16*)(F.ws + WS_CK);
    const int tid = F.tid, lane = F.lane, w = F.wave, srow = tid >> 3, sc8 = tid & 7;
    const int dvt = w >> 2, dkt = w & 3, r = lane & 31, hh = lane >> 5, gsub = (lane >> 4) & 1, i16 = lane & 15;
    constexpr int KS = 320, VS = 192, BUF = 64 * KS + 64 * VS;
    const int aoffV = (8 * hh + (i16 >> 2)) * VS + (32 * dvt + 16 * gsub + 4 * (i16 & 3)) * 2;
    const int aoffK = (8 * hh + (i16 >> 2)) * KS + (32 * dkt + 16 * gsub + 4 * (i16 & 3)) * 2;
    for (int unit = F.bid; unit < 256; unit += F.G) {
        const int dvs = unit & 3, dir = (unit >> 2) & 1, h = (unit >> 3) & 7, b = unit >> 6;
        const float lg2 = log2_sigmoid((dir ? F.a->in[IN_DECB] : F.a->in[IN_DECF])[h]);
        const float g64 = exp2f(64.f * lg2), wrow = exp2f(lg2 * (float)(dir ? srow : 63 - srow));
        f32x16 acc;
#pragma unroll
        for (int i = 0; i < 16; ++i) acc[i] = 0.f;
        v4u kr0, kr1, vr;
        { const int mb = chunk_row(b, 0, dir); const v4u* kp = (const v4u*)(rk + (size_t)(mb + srow) * 1024 + h * 128 + sc8 * 16); kr0 = kp[0]; kr1 = kp[1];
          vr = *(const v4u*)(rv + (size_t)(mb + srow) * 2048 + h * 256 + dvs * 64 + sc8 * 8); }
        for (int n = 0; n < 68; ++n) {
            LAS unsigned char* KL = F.lds + (n & 1) * BUF; LAS unsigned char* VL = KL + 64 * KS;
            *(LAS v4u*)(KL + srow * KS + sc8 * 32) = kr0; *(LAS v4u*)(KL + srow * KS + sc8 * 32 + 16) = kr1;
            *(LAS v4u*)(VL + srow * VS + sc8 * 16) = scale8(vr, wrow);
            if (n + 1 < 68) { const int mb = chunk_row(b, n + 1, dir); const v4u* kp = (const v4u*)(rk + (size_t)(mb + srow) * 1024 + h * 128 + sc8 * 16); kr0 = kp[0]; kr1 = kp[1];
                vr = *(const v4u*)(rv + (size_t)(mb + srow) * 2048 + h * 256 + dvs * 64 + sc8 * 8); }
            LDS_WAIT(); __builtin_amdgcn_s_barrier(); asm volatile("" ::: "memory");
            if (n >= 4 && ((n - 4) & 7) == 0) {
                const int i = (n - 4) >> 3, sc = dir ? 7 - i : i;
                bf16* cp = ck + ((size_t)(((b * 8 + h) * 2 + dir) * 8 + sc) * 256 + dvs * 64 + 32 * dvt + 4 * hh) * 128 + 32 * dkt + r;
#pragma unroll
                for (int e = 0; e < 16; ++e) cp[(size_t)((e & 3) + 8 * (e >> 2)) * 128] = (bf16)f2bf(acc[e]);
            }
#pragma unroll
            for (int e = 0; e < 16; ++e) acc[e] *= g64;
#pragma unroll
            for (int ks = 0; ks < 4; ++ks) {
                const bf16x8 A = tr_read8(VL + aoffV + 16 * ks * VS, VL + aoffV + (16 * ks + 4) * VS);
                const bf16x8 B = tr_read8(KL + aoffK + 16 * ks * KS, KL + aoffK + (16 * ks + 4) * KS);
                acc = __builtin_amdgcn_mfma_f32_32x32x16_bf16(A, B, acc, 0, 0, 0);
            }
        }
        __syncthreads();
    }
}
__device__ __forceinline__ void phase_ret_out(Frame& F) {
    const bf16* rq = (const bf16*)(F.ws + WS_RQ); const bf16* rk = (const bf16*)(F.ws + WS_RK); const bf16* rv = (const bf16*)(F.ws + WS_RV); const bf16* ck = (const bf16*)(F.ws + WS_CK);
    bf16* rg = (bf16*)(F.ws + WS_RG); const float* rng = F.a->in[IN_RNG];
    const int tid = F.tid, lane = F.lane, w = F.wave, srow = tid >> 3, sc8 = tid & 7, q16 = lane & 15, g = lane >> 4;
    constexpr int KS = 288, VS = 544, KB = 64 * KS, VB = 64 * VS, VOFF = 2 * KB, OS = 528;
    for (int unit = F.bid; unit < 1024; unit += F.G) {
        const int qb = unit & 31, h = (unit >> 5) & 7, b = unit >> 8, sc = qb >> 2, iq = qb & 3;
        const int tok0 = b * SEQ + 512 * sc;
        const int qrow = tok0 + 128 * iq + 16 * w + q16;
        const int qpos = 128 * iq + 16 * w + q16;
        bf16x8 Qraw[4];
#pragma unroll
        for (int ks = 0; ks < 4; ++ks) Qraw[ks] = *(const bf16x8*)(rq + (size_t)qrow * 1024 + h * 128 + 32 * ks + 8 * g);
        f32x4 o[16];
#pragma unroll
        for (int dt = 0; dt < 16; ++dt) o[dt] = (f32x4){0.f, 0.f, 0.f, 0.f};
#pragma unroll 1
        for (int dir = 0; dir < 2; ++dir) {
            const float lg2 = log2_sigmoid((dir ? F.a->in[IN_DECB] : F.a->in[IN_DECF])[h]);
            const float sq = exp2f(lg2 * (float)(dir ? 127 - (16 * w + q16) : 16 * w + q16));
            const float wk = exp2f(lg2 * (float)(dir ? srow : -srow));
            bf16x8 Qs[4];
#pragma unroll
            for (int ks = 0; ks < 4; ++ks) Qs[ks] = __builtin_bit_cast(bf16x8, scale8(__builtin_bit_cast(v4u, Qraw[ks]), sq));
            const int kb0 = dir ? 2 * iq : 0, nsteps = dir ? 8 - 2 * iq : 2 * iq + 2;
            v4u kr0, kr1, vr[4];
#define RO_LOAD(kb_) do { const int mrow = tok0 + 64 * (kb_) + srow; const v4u* kp = (const v4u*)(rk + (size_t)mrow * 1024 + h * 128 + sc8 * 16); kr0 = kp[0]; kr1 = kp[1]; \
                const v4u* vp = (const v4u*)(rv + (size_t)mrow * 2048 + h * 256 + sc8 * 32); vr[0] = vp[0]; vr[1] = vp[1]; vr[2] = vp[2]; vr[3] = vp[3]; } while (0)
#define RO_WRITE(buf_) do { LAS unsigned char* kl = F.lds + (buf_) * KB + srow * KS + sc8 * 32; *(LAS v4u*)kl = scale8(kr0, wk); *(LAS v4u*)(kl + 16) = scale8(kr1, wk); \
                LAS unsigned char* vl = F.lds + VOFF + (buf_) * VB + srow * VS + sc8 * 64; *(LAS v4u*)vl = vr[0]; *(LAS v4u*)(vl + 16) = vr[1]; *(LAS v4u*)(vl + 32) = vr[2]; *(LAS v4u*)(vl + 48) = vr[3]; } while (0)
            RO_LOAD(kb0); RO_WRITE(0);
            if (nsteps > 1) RO_LOAD(kb0 + 1);
            LDS_WAIT(); __builtin_amdgcn_s_barrier(); asm volatile("" ::: "memory");
            for (int i = 0; i < nsteps; ++i) {
                const int kb = kb0 + i, k0 = 64 * kb, buf = i & 1;
                const int wq0 = 128 * iq + 16 * w;
                const bool active = dir ? (k0 + 63 >= wq0) : (k0 <= wq0 + 15);
                if (active) {
                    LAS const unsigned char* KL = F.lds + buf * KB; LAS const unsigned char* VL = F.lds + VOFF + buf * VB;
                    const float fac = exp2f(lg2 * (float)(dir ? k0 - (128 * iq + 127) : 128 * iq - k0));
                    f32x4 p[4];
#pragma unroll
                    for (int kt = 0; kt < 4; ++kt) { p[kt] = (f32x4){0.f, 0.f, 0.f, 0.f};
#pragma unroll
                        for (int ks = 0; ks < 4; ++ks) { const bf16x8 A = *(LAS const bf16x8*)(KL + (16 * kt + q16) * KS + (32 * ks + 8 * g) * 2);
                            p[kt] = __builtin_amdgcn_mfma_f32_16x16x32_bf16(A, Qs[ks], p[kt], 0, 0, 0); } }
                    bf16x8 Pb[2];
#pragma unroll
                    for (int kk = 0; kk < 2; ++kk) { v4u pw;
#pragma unroll
                        for (int t2 = 0; t2 < 2; ++t2) { const int kt = 2 * kk + t2; float v[4];
#pragma unroll
                            for (int e = 0; e < 4; ++e) { const int kj = k0 + 16 * kt + 4 * g + e; const bool keep = dir ? (kj >= qpos) : (kj <= qpos); v[e] = keep ? p[kt][e] * fac : 0.f; }
                            pw[2 * t2] = pg8::cvt_pk_bf16(v[0], v[1]); pw[2 * t2 + 1] = pg8::cvt_pk_bf16(v[2], v[3]); }
                        Pb[kk] = __builtin_bit_cast(bf16x8, pw); }
#pragma unroll
                    for (int dt = 0; dt < 16; ++dt)
#pragma unroll
                        for (int kk = 0; kk < 2; ++kk) { LAS const unsigned char* vp = VL + (32 * kk + 4 * g + (q16 >> 2)) * VS + (16 * dt + 4 * (q16 & 3)) * 2;
                            o[dt] = __builtin_amdgcn_mfma_f32_16x16x32_bf16(tr_read8(vp, vp + 16 * VS), Pb[kk], o[dt], 0, 0, 0); }
                }
                if (i + 1 < nsteps) { RO_WRITE(buf ^ 1); if (i + 2 < nsteps) RO_LOAD(kb + 2); }
                LDS_WAIT(); __builtin_amdgcn_s_barrier(); asm volatile("" ::: "memory");
            }
            { const bf16* cp = ck + ((size_t)(((b * 8 + h) * 2 + dir) * 8 + sc) * 256 + (tid >> 1)) * 128 + (tid & 1) * 64; LAS unsigned char* cl = F.lds + (tid >> 1) * KS + (tid & 1) * 128;
              v4u t8[8];
#pragma unroll
              for (int j = 0; j < 8; ++j) t8[j] = ((const v4u*)cp)[j];
#pragma unroll
              for (int j = 0; j < 8; ++j) *(LAS v4u*)(cl + 16 * j) = t8[j]; }
            const float fi = exp2f(lg2 * (float)(dir ? 512 - (128 * iq + 127) : 128 * iq + 1));
            bf16x8 Qi[4];
#pragma unroll
            for (int ks = 0; ks < 4; ++ks) Qi[ks] = __builtin_bit_cast(bf16x8, scale8(__builtin_bit_cast(v4u, Qraw[ks]), sq * fi));
            LDS_WAIT(); __builtin_amdgcn_s_barrier(); asm volatile("" ::: "memory");
#pragma unroll
            for (int dt = 0; dt < 16; ++dt)
#pragma unroll
                for (int ks = 0; ks < 4; ++ks) { const bf16x8 A = *(LAS const bf16x8*)(F.lds + (16 * dt + q16) * KS + (32 * ks + 8 * g) * 2);
                    o[dt] = __builtin_amdgcn_mfma_f32_16x16x32_bf16(A, Qi[ks], o[dt], 0, 0, 0); }
            LDS_WAIT(); __builtin_amdgcn_s_barrier(); asm volatile("" ::: "memory");
        }
#undef RO_LOAD
#undef RO_WRITE
        float s = 0.f;
#pragma unroll
        for (int dt = 0; dt < 16; ++dt) s += (o[dt][0] + o[dt][1]) + (o[dt][2] + o[dt][3]);
        s += __shfl_xor(s, 16); s += __shfl_xor(s, 32);
        const float mu = s * (1.f / 256.f); float qv = 0.f;
#pragma unroll
        for (int dt = 0; dt < 16; ++dt) { o[dt] = o[dt] - mu; qv += (o[dt][0] * o[dt][0] + o[dt][1] * o[dt][1]) + (o[dt][2] * o[dt][2] + o[dt][3] * o[dt][3]); }
        qv += __shfl_xor(qv, 16); qv += __shfl_xor(qv, 32);
        const float rs = 1.0f / sqrtf(qv * (1.f / 256.f) + EPS);
        LAS unsigned char* ol = F.lds + w * (16 * OS);
#pragma unroll
        for (int dt = 0; dt < 16; ++dt) { const f32x4 gg = *(const f32x4*)(rng + h * 256 + 16 * dt + 4 * g); const f32x4 y = o[dt] * rs * gg;
            *(LAS unsigned long long*)(ol + q16 * OS + (16 * dt + 4 * g) * 2) = (unsigned long long)pg8::cvt_pk_bf16(y[0], y[1]) | ((unsigned long long)pg8::cvt_pk_bf16(y[2], y[3]) << 32); }
        LDS_WAIT(); asm volatile("" ::: "memory");
        { const int rr = lane >> 2, c4 = lane & 3; bf16* gp = rg + (size_t)(tok0 + 128 * iq + 16 * w + rr) * 2048 + h * 256;
#pragma unroll
          for (int j = 0; j < 8; ++j) { const int ch = 4 * j + c4; const v4u yv = *(LAS const v4u*)(ol + rr * OS + ch * 16); const v4u gv = *(const v4u*)(gp + ch * 8); v4u ov;
#pragma unroll
              for (int e = 0; e < 4; ++e) { const float y0 = __builtin_bit_cast(float, yv[e] << 16), y1 = __builtin_bit_cast(float, yv[e] & 0xffff0000u), g0 = __builtin_bit_cast(float, gv[e] << 16), g1 = __builtin_bit_cast(float, gv[e] & 0xffff0000u);
                  ov[e] = pg8::cvt_pk_bf16(y0 * silu_f(g0), y1 * silu_f(g1)); }
              *(v4u*)(gp + ch * 8) = ov; } }
        __syncthreads();
    }
}

constexpr size_t WS_QINB = 218 * MiB, WS_KINB = WS_QINB + 8704 * 1024, WS_GDEC = 236 * MiB;
constexpr size_t WS_SST = 20 * MiB;
__device__ __forceinline__ int gla_chunk_row(int b, int cm) { return cm < 4 ? ML + b * CTXL + 64 * cm : b * SEQ + 64 * (cm - 4); }
__device__ __forceinline__ void phase_gla_prep(Frame& F) {
    bf16* gq = (bf16*)(F.ws + WS_GQ); bf16* gk = (bf16*)(F.ws + WS_GK); bf16* qb = (bf16*)(F.ws + WS_QINB); bf16* kb = (bf16*)(F.ws + WS_KINB);
    const float* ga = (const float*)(F.ws + WS_GA); float* gdec = (float*)(F.ws + WS_GDEC);
    LAS float* gal = (LAS float*)F.lds;
    LAS float* tot = (LAS float*)(F.lds + 8192);
    const int tid = F.tid, c = tid & 63, jg = tid >> 6;
    for (int unit = F.bid; unit < 16 * 68; unit += F.G) {
        const int cm = unit % 68, bh = unit / 68, h = bh & 3, b = bh >> 2, mb = gla_chunk_row(b, cm);
        *(LAS v4u*)(F.lds + tid * 16) = *(const v4u*)(ga + (size_t)mb * 32 + tid * 4);
        float wf[16], wb[16];
#pragma unroll
        for (int r = 0; r < 16; ++r) { wf[r] = F.a->in[IN_WAF][r * 256 + h * 64 + c]; wb[r] = F.a->in[IN_WAB][r * 256 + h * 64 + c]; }
        const float bf_ = F.a->in[IN_BAF][h * 64 + c], bb_ = F.a->in[IN_BAB][h * 64 + c];
        float q[8], k[8];
#pragma unroll
        for (int i = 0; i < 8; ++i) { const size_t o = (size_t)(mb + 8 * jg + i) * 256 + h * 64 + c; q[i] = bf2f(gq[o]); k[i] = bf2f(gk[o]); }
        __syncthreads();
        float lf[8], lb[8];
#pragma unroll
        for (int i = 0; i < 8; ++i) { const LAS float* gr_ = gal + (8 * jg + i) * 32; float zf = bf_, zb = bb_;
#pragma unroll
            for (int r = 0; r < 16; ++r) { zf += gr_[r] * wf[r]; zb += gr_[16 + r] * wb[r]; }
            lf[i] = logsig_f(zf) * (1.f / 16.f); lb[i] = logsig_f(zb) * (1.f / 16.f); }
#pragma unroll
        for (int i = 1; i < 8; ++i) lf[i] += lf[i - 1];
#pragma unroll
        for (int i = 6; i >= 0; --i) lb[i] += lb[i + 1];
        tot[jg * 64 + c] = lf[7]; tot[512 + jg * 64 + c] = lb[0];
        __syncthreads();
        float offf = 0.f, offb = 0.f, totf = 0.f, totb = 0.f;
#pragma unroll
        for (int g2 = 0; g2 < 8; ++g2) { const float tf = tot[g2 * 64 + c], tb = tot[512 + g2 * 64 + c]; totf += tf; totb += tb; if (g2 < jg) offf += tf; if (g2 > jg) offb += tb; }
#pragma unroll
        for (int i = 0; i < 8; ++i) { const size_t o = (size_t)(mb + 8 * jg + i) * 256 + h * 64 + c; const float bfv = lf[i] + offf, bbv = lb[i] + offb;
            gq[o] = (bf16)f2bf(q[i] * __expf(bfv)); gk[o] = (bf16)f2bf(k[i] * __expf(-bfv)); qb[o] = (bf16)f2bf(q[i] * __expf(bbv)); kb[o] = (bf16)f2bf(k[i] * __expf(-bbv)); }
        if (jg == 0) { gdec[((size_t)(0 * 16 + bh) * 68 + cm) * 64 + c] = __expf(totf); gdec[((size_t)(1 * 16 + bh) * 68 + cm) * 64 + c] = __expf(totb); }
        __syncthreads();
    }
}
__device__ __forceinline__ void phase_gla_scan(Frame& F) {
    const bf16* gv = (const bf16*)(F.ws + WS_GV); bf16* sst = (bf16*)(F.ws + WS_SST); const float* gdec = (const float*)(F.ws + WS_GDEC);
    const int tid = F.tid, lane = F.lane, w = F.wave, srow = tid >> 3, sc8 = tid & 7;
    const int dvt = w >> 1, dkt = w & 1, r = lane & 31, hh = lane >> 5, gsub = (lane >> 4) & 1, i16 = lane & 15;
    constexpr int KS = 192, VS = 320, BUF = 64 * KS + 64 * VS;
    const int aoffV = (8 * hh + (i16 >> 2)) * VS + (32 * dvt + 16 * gsub + 4 * (i16 & 3)) * 2;
    const int aoffK = (8 * hh + (i16 >> 2)) * KS + (32 * dkt + 16 * gsub + 4 * (i16 & 3)) * 2;
    for (int unit = F.bid; unit < 32; unit += F.G) {
        const int dir = unit & 1, bh = unit >> 1, h = bh & 3, b = bh >> 2;
        const bf16* kin = (const bf16*)(F.ws + (dir ? WS_KINB : WS_GK));
        f32x16 acc;
#pragma unroll
        for (int i = 0; i < 16; ++i) acc[i] = 0.f;
        v4u kr, vr0, vr1; float dc;
#define GS_CM(n_) ((n_) < 4 ? (dir ? 3 - (n_) : (n_)) : 4 + (dir ? 63 - ((n_) - 4) : (n_) - 4))
#define GS_LOAD(n_) do { const int cm_ = GS_CM(n_), mb_ = gla_chunk_row(b, cm_); kr = *(const v4u*)(kin + (size_t)(mb_ + srow) * 256 + h * 64 + sc8 * 8); \
            const v4u* vp_ = (const v4u*)(gv + (size_t)(mb_ + srow) * 512 + h * 128 + sc8 * 16); vr0 = vp_[0]; vr1 = vp_[1]; dc = gdec[((size_t)(dir * 16 + bh) * 68 + cm_) * 64 + 32 * dkt + r]; } while (0)
        GS_LOAD(0);
        for (int n = 0; n < 68; ++n) {
            LAS unsigned char* KL = F.lds + (n & 1) * BUF; LAS unsigned char* VL = KL + 64 * KS;
            *(LAS v4u*)(KL + srow * KS + sc8 * 16) = kr; *(LAS v4u*)(VL + srow * VS + sc8 * 32) = vr0; *(LAS v4u*)(VL + srow * VS + sc8 * 32 + 16) = vr1;
            const float dcur = dc; const int cm = GS_CM(n);
            if (n + 1 < 68) GS_LOAD(n + 1);
            LDS_WAIT(); __builtin_amdgcn_s_barrier(); asm volatile("" ::: "memory");
            { bf16* cp = sst + ((size_t)((bh * 2 + dir) * 68 + cm) * 128 + 32 * dvt + 4 * hh) * 64 + 32 * dkt + r;
#pragma unroll
              for (int e = 0; e < 16; ++e) cp[(size_t)((e & 3) + 8 * (e >> 2)) * 64] = (bf16)f2bf(acc[e]); }
#pragma unroll
            for (int ks = 0; ks < 4; ++ks) {
                const bf16x8 A = tr_read8(VL + aoffV + 16 * ks * VS, VL + aoffV + (16 * ks + 4) * VS);
                const bf16x8 B = tr_read8(KL + aoffK + 16 * ks * KS, KL + aoffK + (16 * ks + 4) * KS);
                acc = __builtin_amdgcn_mfma_f32_32x32x16_bf16(A, B, acc, 0, 0, 0);
            }
#pragma unroll
            for (int e = 0; e < 16; ++e) acc[e] *= dcur;
        }
#undef GS_LOAD
#undef GS_CM
        __syncthreads();
    }
}
__device__ __forceinline__ void phase_gla_out(Frame& F) {
    const bf16* gv = (const bf16*)(F.ws + WS_GV); const bf16* gr = (const bf16*)(F.ws + WS_GR); const bf16* sst = (const bf16*)(F.ws + WS_SST); bf16* cat = (bf16*)(F.ws + WS_CAT);
    const float* gng = F.a->in[IN_GNG];
    const int tid = F.tid, lane = F.lane, w = F.wave, q16 = lane & 15, g = lane >> 4, wc = w >> 2;
    constexpr int KS = 160, VS = 288, SS = 160, OS = 272;
    constexpr int KOFF = 0, VOFF = 4 * 64 * KS  , SOFF = VOFF + 2 * 64 * VS  ;
    for (int unit = F.bid; unit < 16 * 34; unit += F.G) {
        const int c2 = unit % 34, bh = unit / 34, h = bh & 3, b = bh >> 2;
        const int cm0 = 2 * c2, mb = gla_chunk_row(b, cm0);
        { const int row = tid >> 2, c4 = tid & 3;
#pragma unroll
          for (int d = 0; d < 2; ++d) { const bf16* kin = (const bf16*)(F.ws + (d ? WS_KINB : WS_GK)) + (size_t)(mb + row) * 256 + h * 64 + c4 * 16; const v4u a0 = ((const v4u*)kin)[0], a1 = ((const v4u*)kin)[1];
              LAS unsigned char* kl = F.lds + KOFF + (d * 128 + row) * KS + c4 * 32; *(LAS v4u*)kl = a0; *(LAS v4u*)(kl + 16) = a1; }
          const v4u* vp = (const v4u*)(gv + (size_t)(mb + row) * 512 + h * 128 + c4 * 32); LAS unsigned char* vl = F.lds + VOFF + row * VS + c4 * 64;
#pragma unroll
          for (int j = 0; j < 4; ++j) *(LAS v4u*)(vl + 16 * j) = vp[j]; }
        const int qrow = mb + 16 * w + q16, qj = 16 * (w & 3) + q16;
        f32x4 o[8];
#pragma unroll
        for (int dt = 0; dt < 8; ++dt) o[dt] = (f32x4){0.f, 0.f, 0.f, 0.f};
#pragma unroll 1
        for (int dir = 0; dir < 2; ++dir) {
            { const int row = tid >> 1, hf = tid & 1;
              const bf16* sp = sst + ((size_t)((bh * 2 + dir) * 68 + cm0) * 128 + row) * 64 + hf * 32; LAS unsigned char* sl = F.lds + SOFF + row * SS + hf * 64;
              v4u t4[4];
#pragma unroll
              for (int j = 0; j < 4; ++j) t4[j] = ((const v4u*)sp)[j];
#pragma unroll
              for (int j = 0; j < 4; ++j) *(LAS v4u*)(sl + 16 * j) = t4[j]; }
            const bf16* qin = (const bf16*)(F.ws + (dir ? WS_QINB : WS_GQ)) + (size_t)qrow * 256 + h * 64 + 8 * g;
            bf16x8 Q[2]; Q[0] = *(const bf16x8*)qin; Q[1] = *(const bf16x8*)(qin + 32);
            LDS_WAIT(); __builtin_amdgcn_s_barrier(); asm volatile("" ::: "memory");
            LAS const unsigned char* KL = F.lds + KOFF + (dir * 128 + wc * 64) * KS; LAS const unsigned char* VL = F.lds + VOFF + wc * 64 * VS; LAS const unsigned char* SL = F.lds + SOFF + wc * 128 * SS;
            const int wq0 = 16 * (w & 3);
            f32x4 p[4];
#pragma unroll
            for (int kt = 0; kt < 4; ++kt) { p[kt] = (f32x4){0.f, 0.f, 0.f, 0.f};
                const bool act = dir ? (16 * kt + 15 >= wq0) : (16 * kt <= wq0 + 15);
                if (act) {
#pragma unroll
                    for (int ks = 0; ks < 2; ++ks) { const bf16x8 A = *(LAS const bf16x8*)(KL + (16 * kt + q16) * KS + (32 * ks + 8 * g) * 2);
                        p[kt] = __builtin_amdgcn_mfma_f32_16x16x32_bf16(A, Q[ks], p[kt], 0, 0, 0); } } }
            bf16x8 Pb[2];
#pragma unroll
            for (int kk = 0; kk < 2; ++kk) { v4u pw;
#pragma unroll
                for (int t2 = 0; t2 < 2; ++t2) { const int kt = 2 * kk + t2; float v[4];
#pragma unroll
                    for (int e = 0; e < 4; ++e) { const int kj = 16 * kt + 4 * g + e; const bool keep = dir ? (kj >= qj) : (kj <= qj); v[e] = keep ? p[kt][e] : 0.f; }
                    pw[2 * t2] = pg8::cvt_pk_bf16(v[0], v[1]); pw[2 * t2 + 1] = pg8::cvt_pk_bf16(v[2], v[3]); }
                Pb[kk] = __builtin_bit_cast(bf16x8, pw); }
#pragma unroll
            for (int dt = 0; dt < 8; ++dt) {
#pragma unroll
                for (int kk = 0; kk < 2; ++kk) { LAS const unsigned char* vp = VL + (32 * kk + 4 * g + (q16 >> 2)) * VS + (16 * dt + 4 * (q16 & 3)) * 2;
                    o[dt] = __builtin_amdgcn_mfma_f32_16x16x32_bf16(tr_read8(vp, vp + 16 * VS), Pb[kk], o[dt], 0, 0, 0); }
#pragma unroll
                for (int ks = 0; ks < 2; ++ks) { const bf16x8 A = *(LAS const bf16x8*)(SL + (16 * dt + q16) * SS + (32 * ks + 8 * g) * 2);
                    o[dt] = __builtin_amdgcn_mfma_f32_16x16x32_bf16(A, Q[ks], o[dt], 0, 0, 0); }
            }
            LDS_WAIT(); __builtin_amdgcn_s_barrier(); asm volatile("" ::: "memory");
        }
        float s = 0.f;
#pragma unroll
        for (int dt = 0; dt < 8; ++dt) s += (o[dt][0] * o[dt][0] + o[dt][1] * o[dt][1]) + (o[dt][2] * o[dt][2] + o[dt][3] * o[dt][3]);
        s += __shfl_xor(s, 16); s += __shfl_xor(s, 32);
        const float rs = 1.0f / sqrtf(s * (1.f / 128.f) + EPS);
        LAS unsigned char* ol = F.lds + w * (16 * OS);
#pragma unroll
        for (int dt = 0; dt < 8; ++dt) { const f32x4 gg = *(const f32x4*)(gng + 16 * dt + 4 * g); const f32x4 y = o[dt] * rs * gg;
            *(LAS unsigned long long*)(ol + q16 * OS + (16 * dt + 4 * g) * 2) = (unsigned long long)pg8::cvt_pk_bf16(y[0], y[1]) | ((unsigned long long)pg8::cvt_pk_bf16(y[2], y[3]) << 32); }
        LDS_WAIT(); asm volatile("" ::: "memory");
        { const int rr = lane >> 2, c4 = lane & 3; const size_t row = (size_t)(mb + 16 * w + rr);
#pragma unroll
          for (int j = 0; j < 4; ++j) { const int ch = 4 * j + c4; const v4u yv = *(LAS const v4u*)(ol + rr * OS + ch * 16); const v4u gv_ = *(const v4u*)(gr + row * 512 + h * 128 + ch * 8); v4u ov;
#pragma unroll
              for (int e = 0; e < 4; ++e) { const float y0 = __builtin_bit_cast(float, yv[e] << 16), y1 = __builtin_bit_cast(float, yv[e] & 0xffff0000u), g0 = __builtin_bit_cast(float, gv_[e] << 16), g1 = __builtin_bit_cast(float, gv_[e] & 0xffff0000u);
                  ov[e] = pg8::cvt_pk_bf16(y0 * silu_f(g0), y1 * silu_f(g1)); }
              *(v4u*)(cat + row * 1024 + 512 + h * 128 + ch * 8) = ov; } }
        __syncthreads();
    }
}

__device__ __forceinline__ void phase_na(Frame& F, int vbid, int vG) {
    const bf16* naq = (const bf16*)(F.ws + WS_NAQ); const bf16* nak = (const bf16*)(F.ws + WS_NAK); const bf16* nav = (const bf16*)(F.ws + WS_NAV); bf16* cat = (bf16*)(F.ws + WS_CAT);
    const int lane = F.lane, h = F.wave, r = lane & 31, hh = lane >> 5, gsub = (lane >> 4) & 1, i16 = lane & 15;
    constexpr int VSTR = 192; constexpr float LOG2E = 1.4426950408889634f;
    LAS unsigned char* VL = F.lds + h * 8192; LAS float* RB = (LAS float*)(F.lds + h * 8192 + 6144);
    for (int i = lane; i < 465; i += 64) RB[16 + i] = F.a->in[IN_RPB][h * 465 + i] * LOG2E;
    const int voff = (4 * hh + (i16 >> 2)) * VSTR + (16 * gsub + 4 * (i16 & 3)) * 2;
    for (int unit = vbid; unit < 272; unit += vG) {
        const bool lat = unit < 256; int b, R = 0, C = 0, qt = 0;
        if (lat) { b = unit >> 6; R = ((unit >> 2) & 15) * 4; C = (unit & 3) * 16; } else { b = (unit - 256) >> 2; qt = (unit - 256) & 3; }
        const size_t hb = (size_t)(b * 8 + h) * 4352;
        int qtok[2], qr[2], qc[2];
#pragma unroll
        for (int ct = 0; ct < 2; ++ct) { const int i = 32 * ct + r; qr[ct] = R + (i >> 4); qc[ct] = C + (i & 15); qtok[ct] = lat ? qr[ct] * 64 + qc[ct] : 4096 + 64 * qt + i; }
        bf16x8 Q[2][4];
#pragma unroll
        for (int ct = 0; ct < 2; ++ct)
#pragma unroll
            for (int ks = 0; ks < 4; ++ks) Q[ct][ks] = *(const bf16x8*)(naq + (hb + qtok[ct]) * 64 + 16 * ks + 8 * hh);
        const int rlo = min(max(R - 4, 0), 56), rhi = min(max(R - 1, 0), 56) + 7, cstart = min(max(C - 8, 0), 32);
        const int nblk = lat ? 8 + (rhi - rlo + 1) : 8;
        int r0q[2], klo[2];
#pragma unroll
        for (int ct = 0; ct < 2; ++ct) { r0q[ct] = min(max(qr[ct] - 4, 0), 56); klo[ct] = min(max(qc[ct] - 8, 0), 48) - cstart; }
        f32x16 ot[2][2];
#pragma unroll
        for (int a = 0; a < 2; ++a)
#pragma unroll
            for (int c = 0; c < 2; ++c)
#pragma unroll
                for (int e = 0; e < 16; ++e) ot[a][c][e] = 0.f;
        float mrun[2] = {-1e30f, -1e30f}, lrun[2] = {0.f, 0.f};
        bf16x8 Kf[4]; v4u Vr[4];
#define NA_KTOK(i_) ((i_) < 8 ? 4096 + 32 * (i_) : (rlo + (i_) - 8) * 64 + cstart)
#define NA_LOAD(i_) do { const int kt_ = NA_KTOK(i_); const bf16* kp_ = nak + (hb + kt_ + r) * 64 + 8 * hh; \
            Kf[0] = *(const bf16x8*)kp_; Kf[1] = *(const bf16x8*)(kp_ + 16); Kf[2] = *(const bf16x8*)(kp_ + 32); Kf[3] = *(const bf16x8*)(kp_ + 48); \
            const v4u* vp_ = (const v4u*)(nav + (hb + kt_) * 64) + lane; Vr[0] = vp_[0]; Vr[1] = vp_[64]; Vr[2] = vp_[128]; Vr[3] = vp_[192]; } while (0)
        NA_LOAD(0);
        for (int i = 0; i < nblk; ++i) {
#pragma unroll
            for (int j = 0; j < 4; ++j) { const int idx = lane + 64 * j; *(LAS v4u*)(VL + (idx >> 3) * VSTR + (idx & 7) * 16) = Vr[j]; }
            f32x16 st[2];
#pragma unroll
            for (int ct = 0; ct < 2; ++ct) {
#pragma unroll
                for (int e = 0; e < 16; ++e) st[ct][e] = 0.f;
#pragma unroll
                for (int ks = 0; ks < 4; ++ks) st[ct] = __builtin_amdgcn_mfma_f32_32x32x16_bf16(Kf[ks], Q[ct][ks], st[ct], 0, 0, 0);
            }
            const int kr = rlo + i - 8;
            if (i + 1 < nblk) NA_LOAD(i + 1);
            bf16x8 Pb[2][2];
#pragma unroll
            for (int ct = 0; ct < 2; ++ct) {
                float mx = -1e30f;
                if (i < 8) {
#pragma unroll
                    for (int e = 0; e < 16; ++e) { st[ct][e] *= LOG2E; mx = fmaxf(mx, st[ct][e]); }
                } else {
                    const bool rowok = (kr >= r0q[ct]) && (kr <= r0q[ct] + 7);
                    const LAS float* bp = RB + 16 + (kr - qr[ct] + 7) * 31 + cstart - qc[ct] + 15 + 4 * hh;
#pragma unroll
                    for (int e = 0; e < 16; ++e) { const int kk = (e & 3) + 8 * (e >> 2); const bool ok = rowok && ((unsigned)(kk + 4 * hh - klo[ct]) < 16u);
                        const float v = st[ct][e] * LOG2E + bp[kk]; st[ct][e] = ok ? v : -1e30f; mx = fmaxf(mx, st[ct][e]); }
                }
                mx = fmaxf(mx, __shfl_xor(mx, 32));
                const float mnew = fmaxf(mrun[ct], mx), alpha = exp2f(mrun[ct] - mnew); mrun[ct] = mnew;
                float ls = 0.f;
#pragma unroll
                for (int e = 0; e < 16; ++e) { const float p = exp2f(st[ct][e] - mnew); st[ct][e] = p; ls += p; }
                lrun[ct] = lrun[ct] * alpha + ls;
#pragma unroll
                for (int dt = 0; dt < 2; ++dt)
#pragma unroll
                    for (int e = 0; e < 16; ++e) ot[dt][ct][e] *= alpha;
#pragma unroll
                for (int s = 0; s < 2; ++s) { v4u pw;
#pragma unroll
                    for (int j = 0; j < 4; ++j) pw[j] = pg8::cvt_pk_bf16(st[ct][8 * s + 2 * j], st[ct][8 * s + 2 * j + 1]);
                    Pb[ct][s] = __builtin_bit_cast(bf16x8, pw); }
            }
#pragma unroll
            for (int dt = 0; dt < 2; ++dt)
#pragma unroll
                for (int s = 0; s < 2; ++s) { LAS const unsigned char* vp = VL + voff + 16 * s * VSTR + 64 * dt;
                    const bf16x8 A = tr_read8(vp, vp + 8 * VSTR);
                    ot[dt][0] = __builtin_amdgcn_mfma_f32_32x32x16_bf16(A, Pb[0][s], ot[dt][0], 0, 0, 0);
                    ot[dt][1] = __builtin_amdgcn_mfma_f32_32x32x16_bf16(A, Pb[1][s], ot[dt][1], 0, 0, 0); }
        }
#undef NA_LOAD
#undef NA_KTOK
#pragma unroll
        for (int ct = 0; ct < 2; ++ct) {
            const float inv = 1.0f / (lrun[ct] + __shfl_xor(lrun[ct], 32));
            const int row = lat ? b * SEQ + qtok[ct] : ML + b * CTXL + (qtok[ct] - 4096);
#pragma unroll
            for (int dt = 0; dt < 2; ++dt)
#pragma unroll
                for (int q4 = 0; q4 < 4; ++q4) { const int d = 32 * dt + 8 * q4 + 4 * hh;
                    *(unsigned long long*)(cat + (size_t)row * 1024 + h * 64 + d) = (unsigned long long)pg8::cvt_pk_bf16(ot[dt][ct][4 * q4] * inv, ot[dt][ct][4 * q4 + 1] * inv)
                        | ((unsigned long long)pg8::cvt_pk_bf16(ot[dt][ct][4 * q4 + 2] * inv, ot[dt][ct][4 * q4 + 3] * inv) << 32); }
        }
    }
    __syncthreads();
}

constexpr int NPHASE = 23;
#ifndef NA_SIMPLE
#define NA_SIMPLE 0
#endif
#ifndef GLA_SIMPLE
#define GLA_SIMPLE 0
#endif
#ifndef RET_SIMPLE
#define RET_SIMPLE 0
#endif
__global__ void __launch_bounds__(NWAVES * 64, 2) mk_fwd(Args args) {
    extern __shared__ __attribute__((aligned(16))) unsigned char lds[];
    Frame F;
    F.lds = (LAS unsigned char*)lds; F.tid = threadIdx.x; F.lane = F.tid & 63; F.wave = __builtin_amdgcn_readfirstlane(F.tid >> 6); F.G = gridDim.x; F.bid = blockIdx.x;
    F.a = &args;
    F.out = args.out; F.ws = args.ws;
    unsigned char* ws = args.ws;
    for (int u = F.tid; u < (LDS_BYTES - LDSCTL_OFF) / 4; u += NWAVES * 64) ((LAS unsigned*)(F.lds + LDSCTL_OFF))[u] = 0u;
    __syncthreads();
    const int lo = args.ph_lo, hi = args.ph_hi;
    XcdBarrier bar; bar.bar = (unsigned*)(ws + WS_CTL) + CW_BAR; bar.x = 0; bar.st = nullptr;
    if (hi - lo > 1) bar = xcd_barrier_post((unsigned*)(ws + WS_CTL) + CW_BAR, (volatile LAS unsigned*)(F.lds + MISC_OFF) + 8);
    float* mod = (float*)(ws + WS_MOD); float* xc = (float*)(ws + WS_XC); bf16* H = (bf16*)(ws + WS_H);
#define IN(k) (lo <= (k) && (k) < hi)
#define SEAM(k) do { if ((k) + 1 < hi) xcd_barrier(bar); } while (0)
#define GEMM_RES(ph_, A_, Bt_, M_, K_, bL_, bC_, gate_) do { pg8::Gemm g{(const bf16*)(A_), (const bf16*)(Bt_), (M_), 1024, (K_)}; pg8::StaticOrder S; S.init((M_), 1024, F.G, F.bid); \
        pg8::EpiRes E{(bL_), (bC_), F.out, xc, (gate_)}; pg8::gemm_phase<pg8::EpiRes, pg8::StaticOrder, true, true>(F.lds + RING_OFF, g, S, E); } while (0)
#define GEMM_UP(l_, M_) do { pg8::Gemm g{H, (const bf16*)(ws + ((l_) ? WS_WUPT1 : WS_WUPT0)), (M_), NUP, 1024}; pg8::StaticOrder S; S.init((M_), NUP, F.G, F.bid); \
        pg8::EpiUp E{(bf16*)(ws + ((l_) ? WS_ACT1 : WS_ACT0)), (float*)(ws + ((l_) ? WS_EDGE1 : WS_EDGE0)), F.a->in[IN_CW] + (l_) * 3 * NUP, F.a->in[IN_CB] + (l_) * NUP}; \
        pg8::gemm_phase<pg8::EpiUp, pg8::StaticOrder, true, true>(F.lds + RING_OFF, g, S, E); } while (0)
    if (IN(0)) { phase_prep(F); SEAM(0); }
    if (IN(1)) { phase_modnorm(F, F.a->in[IN_X], F.a->in[IN_CTX], MT, F.a->in[IN_N1G], mod, 0); SEAM(1); }
    if (IN(2)) { pg8::Gemm g{H, (const bf16*)(ws + WS_WIN0T), MT, N0P, 1024}; pg8::StaticOrder S; S.init(MT, N0P, F.G, F.bid);
        pg8::EpiProj0 E{ws}; pg8::gemm_phase<pg8::EpiProj0, pg8::StaticOrder, true, true>(F.lds + RING_OFF, g, S, E); SEAM(2); }
#if GLA_SIMPLE
    if (IN(3)) { phase_na_simple(F); phase_gla_gates_simple(F); SEAM(3); }
    if (IN(4)) { phase_gla_rec_simple(F); SEAM(4); }
    if (IN(5)) { phase_gla_out_simple(F); SEAM(5); }
#else
#if NA_SIMPLE
    if (IN(3)) { phase_gla_prep(F); phase_na_simple(F); SEAM(3); }
    if (IN(4)) { phase_gla_scan(F); SEAM(4); }
#else
    if (IN(3)) { phase_gla_prep(F); SEAM(3); }
    if (IN(4)) { if (F.G >= 64) { if (F.bid < 32) phase_gla_scan(F); else phase_na(F, F.bid - 32, F.G - 32); } else { phase_gla_scan(F); phase_na(F, F.bid, F.G); } SEAM(4); }
#endif
    if (IN(5)) { phase_gla_out(F); SEAM(5); }
#endif
    if (IN(6)) { GEMM_RES(6, ws + WS_CAT, ws + WS_WO0T, MT, 1024, F.a->in[IN_X], F.a->in[IN_CTX], mod + 2048); SEAM(6); }
    if (IN(7)) { phase_modnorm(F, F.out, xc, MT, F.a->in[IN_N2G], mod, 3072); SEAM(7); }
    if (IN(8)) { GEMM_UP(0, MT); SEAM(8); }
    if (IN(9)) { phase_fixup(F, (const float*)(ws + WS_EDGE0), (bf16*)(ws + WS_ACT0), MT / 64, F.a->in[IN_CW], F.a->in[IN_CB]); SEAM(9); }
    if (IN(10)) { GEMM_RES(10, ws + WS_ACT0, ws + WS_WDNT0, MT, DFF, F.out, xc, mod + 5120); SEAM(10); }
    if (IN(11)) { phase_modnorm(F, F.out, xc, MT, F.a->in[IN_N1G] + 1024, mod + 5 * 6144, 0); SEAM(11); }
    if (IN(12)) { pg8::Gemm g{H, (const bf16*)(ws + WS_WIN1T), MT, N1, 1024}; pg8::StaticOrder S; S.init(MT, N1, F.G, F.bid);
        pg8::EpiProj1 E{ws}; pg8::gemm_phase<pg8::EpiProj1, pg8::StaticOrder, true, true>(F.lds + RING_OFF, g, S, E); SEAM(12); }
#if RET_SIMPLE
    if (IN(13)) { phase_ret_rec_simple(F, 0); SEAM(13); }
    if (IN(14)) { phase_ret_out_simple(F, 0); SEAM(14); }
    if (IN(15)) { phase_ret_rec_simple(F, 1); SEAM(15); }
    if (IN(16)) { phase_ret_out_simple(F, 1); SEAM(16); }
#else
    if (IN(13)) { phase_ret_scan(F); SEAM(13); }
    if (IN(14)) { phase_ret_out(F); SEAM(14); }
#endif
    if (IN(17)) {
        transpose_all(F, F.a->in[IN_WUP] + (size_t)1024 * NUP, 1024, NUP, NUP, (bf16*)(ws + WS_WUPT1), MapUp{});
        transpose_all(F, F.a->in[IN_WDN] + (size_t)DFF * 1024, DFF, 1024, 1024, (bf16*)(ws + WS_WDNT1), MapId{1024});
        __syncthreads();
        GEMM_RES(17, ws + WS_RG, ws + WS_WO1T, ML, 2048, F.out, xc, mod + 5 * 6144 + 2048); SEAM(17); }
    if (IN(18)) { phase_modnorm(F, F.out, xc, ML, F.a->in[IN_N2G] + 1024, mod + 5 * 6144, 3072); SEAM(18); }
    if (IN(19)) { GEMM_UP(1, ML); SEAM(19); }
    if (IN(20)) { phase_fixup(F, (const float*)(ws + WS_EDGE1), (bf16*)(ws + WS_ACT1), ML / 64, F.a->in[IN_CW] + 3 * NUP, F.a->in[IN_CB] + NUP); SEAM(20); }
    if (IN(21)) { GEMM_RES(21, ws + WS_ACT1, ws + WS_WDNT1, ML, DFF, F.out, xc, mod + 5 * 6144 + 5120); SEAM(21); }
    if (IN(22)) { phase_final(F); }
}

#ifndef MK_ONE_LAUNCH
#define MK_ONE_LAUNCH 1
#endif
extern "C" void kernel_launch(void* const* d_in, const int* in_sizes, int n_in, void* d_out, int out_size, void* d_ws, size_t ws_size, hipStream_t stream) {
    static int grid = 0;
    if (grid == 0) {
        if (n_in != 26 || out_size != ML * DM || ws_size < WS_END) { fprintf(stderr, "kernel_launch: unexpected shapes: n_in %d out %d ws %zu\n", n_in, out_size, ws_size); grid = -1; return; }
        int dev = 0, cus = 0, per_cu = 0;
        if (hipGetDevice(&dev) != hipSuccess || hipDeviceGetAttribute(&cus, hipDeviceAttributeMultiprocessorCount, dev) != hipSuccess) { grid = -1; return; }
        if (hipFuncSetAttribute((const void*)mk_fwd, hipFuncAttributeMaxDynamicSharedMemorySize, LDS_BYTES) != hipSuccess) { fprintf(stderr, "kernel_launch: hipFuncSetAttribute failed\n"); grid = -1; return; }
        if (hipOccupancyMaxActiveBlocksPerMultiprocessor(&per_cu, (const void*)mk_fwd, NWAVES * 64, LDS_BYTES) != hipSuccess || per_cu < 1) { fprintf(stderr, "kernel_launch: occupancy query says %d blocks per CU\n", per_cu); }
        (void)hipGetLastError();
        grid = cus;
    }
    if (grid < 0) return;
    (void)hipMemsetAsync((char*)d_ws + WS_CTL, 0, CTL_ZERO_BYTES, stream);
    Args a{};
    for (int i = 0; i < 26; ++i) a.in[i] = (const float*)d_in[i];
    a.out = (float*)d_out; a.ws = (unsigned char*)d_ws;
#if MK_ONE_LAUNCH
    a.ph_lo = 0; a.ph_hi = NPHASE;
    void* kargs[] = {&a};
    hipError_t e = hipLaunchCooperativeKernel((const void*)mk_fwd, dim3(grid), dim3(NWAVES * 64), kargs, LDS_BYTES, stream);
    if (e != hipSuccess) fprintf(stderr, "kernel_launch: cooperative launch failed: %s\n", hipGetErrorString(e));
#else
    for (int ph = 0; ph < NPHASE; ++ph) { a.ph_lo = ph; a.ph_hi = ph + 1; hipLaunchKernelGGL(mk_fwd, dim3(grid), dim3(NWAVES * 64), LDS_BYTES, stream, a); }
#endif
}
```

```cpp
#include <hip/hip_runtime.h>
#include <cstdio>
#include <cstdint>
namespace pg8 {
#define PG8_LAS __attribute__((address_space(3)))
typedef unsigned short bf16_t;
typedef short bf16x8 __attribute__((ext_vector_type(8)));
typedef float f32x4 __attribute__((ext_vector_type(4)));
typedef unsigned u32x4 __attribute__((ext_vector_type(4)));
constexpr int BM = 256, BK = 64, HALF = 128, HTB = HALF * BK * 2  , STAGE_BYTES = 8 * HTB, NXCD = 8, WGM = 8;

__host__ __device__ __forceinline__ int lds_byte(int r, int c) { const int st = (r >> 4) * 2 + (c >> 5), rr = r & 15, cc = c & 31, ob = rr * 64 + cc * 2; return st * 1024 + (ob ^ (((ob >> 9) & 1) << 5)); }
__host__ __device__ __forceinline__ void stage_rc(int b, int& R, int& C) { const int st = b / 1024, sb = b % 1024, swz = sb ^ (((sb >> 9) & 1) << 5); R = (st >> 1) * 16 + swz / 64; C = (st & 1) * 32 + (swz % 64) / 2; }
__host__ __device__ __forceinline__ int perm32(int rho) { const int n = rho >> 4, i = rho & 15; return 8 * (i >> 2) + 4 * n + (i & 3); }

struct Unit { int pm, pn; };
struct Gemm { const bf16_t* A; const bf16_t* Bt; int M, N, K; };

struct StaticOrder {
    int nM, nN, nwg, G, c;
    __host__ __device__ void init(int M, int N, int G_, int c_) { nM = M / BM; nN = N / BM; nwg = nM * nN; G = G_; c = c_; }
    __host__ __device__ bool next(int i, Unit& u) const {
        const long L = (long)i * G + c; if (L >= nwg) return false;
        int wgid = (int)L; { const int q = nwg / NXCD, r = nwg % NXCD, xcd = wgid % NXCD, off = wgid / NXCD; wgid = (xcd < r ? xcd * (q + 1) : r * (q + 1) + (xcd - r) * q) + off; }
        const int nig = WGM * nN, gid = wgid / nig, fm = gid * WGM, gsz = (nM - fm) < WGM ? (nM - fm) : WGM;
        u.pm = fm + ((wgid % nig) % gsz); u.pn = (wgid % nig) / gsz; return true;
    }
    __device__ __forceinline__ void a_ready(const Unit&) const {}
    __device__ __forceinline__ void done(const Unit&) const {}
};

__device__ __forceinline__ unsigned cvt_pk_bf16(float lo, float hi) { unsigned r; asm volatile("v_cvt_pk_bf16_f32 %0, %1, %2" : "=v"(r) : "v"(lo), "v"(hi)); return r; }

constexpr size_t PJ_MiB = 1u << 20;
constexpr size_t PJ0_NAQ = 79 * PJ_MiB, PJ0_NAK = 96 * PJ_MiB, PJ0_NAV = 113 * PJ_MiB, PJ0_GQ = 130 * PJ_MiB, PJ0_GK = PJ0_GQ + 8704 * 1024, PJ0_GV = 147 * PJ_MiB, PJ0_GR = 164 * PJ_MiB, PJ0_GA = 181 * PJ_MiB;
constexpr size_t PJ1_RQ = 54 * PJ_MiB, PJ1_RK = 86 * PJ_MiB, PJ1_RV = 120 * PJ_MiB, PJ1_RG = 188 * PJ_MiB, PJ1_ROPE = 1 * PJ_MiB + 512 * 1024;
typedef float f32x2 __attribute__((ext_vector_type(2)));
typedef unsigned u32x2 __attribute__((ext_vector_type(2)));
__device__ __forceinline__ void store8bf(bf16_t* p, f32x4 v0, f32x4 v1) {
    u32x4 w; w.x = cvt_pk_bf16(v0[0], v0[1]); w.y = cvt_pk_bf16(v0[2], v0[3]); w.z = cvt_pk_bf16(v1[0], v1[1]); w.w = cvt_pk_bf16(v1[2], v1[3]);
    *(u32x4*)p = w;
}
struct EpiProj0 {
    static constexpr bool PERM = true, AFTER_DRAIN = false;
    unsigned char* ws;
    __device__ __forceinline__ void operator()(const f32x4 (&acc)[2][2][4][2], const Unit& u, int wr, int wc, int fr, int fq) const {
#pragma unroll
        for (int ai = 0; ai < 2; ++ai)
#pragma unroll
            for (int m = 0; m < 4; ++m) {
                const int row = u.pm * BM + ai * HALF + wr * 64 + m * 16 + fr;
                int b, rin; if (row < 16384) { b = row >> 12; rin = row & 4095; } else { b = (row - 16384) >> 8; rin = 4096 + ((row - 16384) & 255); }
#pragma unroll
                for (int bj = 0; bj < 2; ++bj) {
                    const int C0 = u.pn * BM + bj * HALF;
                    const f32x4 v0 = acc[ai][bj][m][0], v1 = acc[ai][bj][m][1];
                    if (C0 < 1536) {
                        const int t = C0 >> 9, head = ((C0 & 511) >> 6) + (wc >> 1), d = 32 * (wc & 1) + 8 * fq;
                        bf16_t* base = (bf16_t*)(ws + (t == 0 ? PJ0_NAQ : (t == 1 ? PJ0_NAK : PJ0_NAV))); const float sc = t == 0 ? 0.125f : 1.0f;
                        store8bf(base + ((size_t)((b * 8 + head) * 4352 + rin) * 64 + d), v0 * sc, v1 * sc);
                    } else if (C0 < 2048) {
                        const bool isq = C0 < 1792; bf16_t* base = (bf16_t*)(ws + (isq ? PJ0_GQ : PJ0_GK)); const int cb = C0 - (isq ? 1536 : 1792); const float sc = isq ? 0.125f : 1.0f;
                        store8bf(base + (size_t)row * 256 + cb + 32 * wc + 8 * fq, v0 * sc, v1 * sc);
                    } else if (C0 < 3072) {
                        const bool isv = C0 < 2560; bf16_t* base = (bf16_t*)(ws + (isv ? PJ0_GV : PJ0_GR)); const int cb = C0 - (isv ? 2048 : 2560);
                        store8bf(base + (size_t)row * 512 + cb + 32 * wc + 8 * fq, v0, v1);
                    } else if (C0 == 3072) {
                        if (wc == 0) { float* p = (float*)(ws + PJ0_GA) + (size_t)row * 32 + 8 * fq; *(f32x4*)p = v0; *(f32x4*)(p + 4) = v1; }
                    }
                }
            }
    }
};
struct EpiRes {
    static constexpr bool PERM = false, AFTER_DRAIN = false;
    const float* baseL; const float* baseC; float* outL; float* outC; const float* gate;
    __device__ __forceinline__ void operator()(const f32x4 (&acc)[2][2][4][2], const Unit& u, int wr, int wc, int fr, int fq) const {
        const bool lat = u.pm < 64; const int tm = lat ? u.pm : u.pm - 64, bi = lat ? (u.pm >> 4) : 4;
        const float* base = (lat ? baseL : baseC) + (size_t)tm * BM * 1024; float* out = (lat ? outL : outC) + (size_t)tm * BM * 1024;
        const int col0 = u.pn * BM + wc * 32 + 4 * fq;
        f32x4 gv[2][2];
#pragma unroll
        for (int bj = 0; bj < 2; ++bj)
#pragma unroll
            for (int n = 0; n < 2; ++n) gv[bj][n] = *(const f32x4*)(gate + bi * 6144 + col0 + bj * HALF + n * 16);
#pragma unroll
        for (int ai = 0; ai < 2; ++ai)
#pragma unroll
            for (int m = 0; m < 4; ++m) { const size_t off = (size_t)(ai * HALF + wr * 64 + m * 16 + fr) * 1024 + col0;
#pragma unroll
                for (int bj = 0; bj < 2; ++bj)
#pragma unroll
                    for (int n = 0; n < 2; ++n) { const f32x4 bs = *(const f32x4*)(base + off + bj * HALF + n * 16); *(f32x4*)(out + off + bj * HALF + n * 16) = bs + gv[bj][n] * acc[ai][bj][m][n]; }
                if (m & 1) asm volatile("" ::: "memory"); }
    }
};
template <int CTRL> __device__ __forceinline__ float dpp_mov(float old, float src) {
    return __builtin_bit_cast(float, __builtin_amdgcn_update_dpp(__builtin_bit_cast(int, old), __builtin_bit_cast(int, src), CTRL, 0xf, 0xf, false));
}
struct EpiUp {
    static constexpr bool PERM = true, AFTER_DRAIN = false;
    bf16_t* act; float* edge; const float* cw; const float* cb;
    template <int M> __device__ __forceinline__ f32x4 conv_m(const f32x4 (&acc)[4][2], int n, const f32x4& w0, const f32x4& w1, const f32x4& w2, const f32x4& bs) const {
        f32x4 y;
#pragma unroll
        for (int e = 0; e < 4; ++e) {
            const float x = acc[M][n][e];
            const float tp = M > 0 ? dpp_mov<0x121>(0.f, acc[M > 0 ? M - 1 : 0][n][e]) : 0.f;
            const float pv = dpp_mov<0x111>(tp, x);
            const float tn = M < 3 ? dpp_mov<0x12F>(0.f, acc[M < 3 ? M + 1 : 3][n][e]) : 0.f;
            const float nx = dpp_mov<0x101>(tn, x);
            y[e] = w0[e] * pv + w1[e] * x + w2[e] * nx + bs[e];
        }
        return y;
    }
    template <int M> __device__ __forceinline__ void row_m(const f32x4 (&aa)[4][2], const f32x4 (&ab)[4][2], int n, const f32x4 (&wa)[4], const f32x4 (&wb)[4], int blk, int fr, int jn) const {
        f32x4 ya = conv_m<M>(aa, n, wa[0], wa[1], wa[2], wa[3]);
#pragma unroll
        for (int e = 0; e < 4; ++e) { const float a = ya[e]; ya[e] = a * __builtin_amdgcn_rcpf(1.0f + __expf(-a)); }
        const f32x4 yb = conv_m<M>(ab, n, wb[0], wb[1], wb[2], wb[3]);
        const f32x4 r = ya * yb;
        u32x2 w; w.x = cvt_pk_bf16(r[0], r[1]); w.y = cvt_pk_bf16(r[2], r[3]);
        const bool is_edge = (M == 0 && fr == 0) || (M == 3 && fr == 15);
        if (!is_edge) *(u32x2*)(act + (size_t)(blk * 64 + M * 16 + fr) * 2816 + jn) = w;
        if (M == 0) { if (fr < 2) { float* p = edge + ((size_t)(blk * 4 + fr) * 5632 + jn); *(f32x4*)p = aa[0][n]; *(f32x4*)(p + 2816) = ab[0][n]; } }
        if (M == 3) { if (fr >= 14) { float* p = edge + ((size_t)(blk * 4 + fr - 12) * 5632 + jn); *(f32x4*)p = aa[3][n]; *(f32x4*)(p + 2816) = ab[3][n]; } }
        asm volatile("" ::: "memory");
    }
    __device__ __forceinline__ void operator()(const f32x4 (&acc)[2][2][4][2], const Unit& u, int wr, int wc, int fr, int fq) const {
        const int j0 = u.pn * 128 + wc * 32 + 8 * fq;
#pragma unroll
        for (int n = 0; n < 2; ++n) {
            const int jn = j0 + 4 * n;
            f32x4 wa[4], wb[4];
#pragma unroll
            for (int i = 0; i < 3; ++i) { wa[i] = *(const f32x4*)(cw + i * 5632 + jn); wb[i] = *(const f32x4*)(cw + i * 5632 + 2816 + jn); }
            wa[3] = *(const f32x4*)(cb + jn); wb[3] = *(const f32x4*)(cb + 2816 + jn);
#pragma unroll
            for (int ai = 0; ai < 2; ++ai) {
                const int blk = u.pm * 4 + ai * 2 + wr;
                row_m<0>(acc[ai][0], acc[ai][1], n, wa, wb, blk, fr, jn);
                row_m<1>(acc[ai][0], acc[ai][1], n, wa, wb, blk, fr, jn);
                row_m<2>(acc[ai][0], acc[ai][1], n, wa, wb, blk, fr, jn);
                row_m<3>(acc[ai][0], acc[ai][1], n, wa, wb, blk, fr, jn);
            }
        }
    }
};
struct EpiProj1 {
    static constexpr bool PERM = true, AFTER_DRAIN = false;
    unsigned char* ws;
    __device__ __forceinline__ void operator()(const f32x4 (&acc)[2][2][4][2], const Unit& u, int wr, int wc, int fr, int fq) const {
#pragma unroll
        for (int ai = 0; ai < 2; ++ai)
#pragma unroll
            for (int m = 0; m < 4; ++m) {
                const int row = u.pm * BM + ai * HALF + wr * 64 + m * 16 + fr; const bool lat = u.pm < 64;
                const int s = row & 4095, pos = (wc >> 1) == 0 ? (s >> 6) : (s & 63);
#pragma unroll
                for (int bj = 0; bj < 2; ++bj) {
                    const int C0 = u.pn * BM + bj * HALF;
                    f32x4 v0 = acc[ai][bj][m][0], v1 = acc[ai][bj][m][1];
                    if (C0 < 2048) {
                        const bool isq = C0 < 1024; if (isq && !lat) continue;
                        if (lat) {
                            const f32x2* rp = (const f32x2*)(ws + PJ1_ROPE) + pos * 32 + 16 * (wc & 1) + 4 * fq;
                            const f32x4 cs0 = *(const f32x4*)rp, cs1 = *(const f32x4*)(rp + 2);
                            const f32x4 c = {cs0[0], cs0[2], cs1[0], cs1[2]}, sn = {cs0[1], cs0[3], cs1[1], cs1[3]};
                            const f32x4 o1 = v0 * c - v1 * sn, o2 = v1 * c + v0 * sn; v0 = o1; v1 = o2;
                        }
                        if (!isq) { v0 = v0 * 0.08838834764831845f; v1 = v1 * 0.08838834764831845f; }
                        store8bf((bf16_t*)(ws + (isq ? PJ1_RQ : PJ1_RK)) + (size_t)row * 1024 + (C0 & 1023) + 32 * wc + 8 * fq, v0, v1);
                    } else if (C0 < 4096) {
                        store8bf((bf16_t*)(ws + PJ1_RV) + (size_t)row * 2048 + (C0 - 2048) + 32 * wc + 8 * fq, v0, v1);
                    } else {
                        if (lat) store8bf((bf16_t*)(ws + PJ1_RG) + (size_t)row * 2048 + (C0 - 4096) + 32 * wc + 8 * fq, v0, v1);
                    }
                }
            }
    }
};

template <class Epi, class Sched, bool ALIGN_EPI = false, bool SP2 = false>
__device__ __forceinline__ void gemm_phase(PG8_LAS unsigned char* lds, const Gemm g, const Sched& S, const Epi& E) {
    const int tid = threadIdx.x, wid = __builtin_amdgcn_readfirstlane(tid >> 6), lane = tid & 63, wr = wid >> 2, wc = wid & 3, fr = lane & 15, fq = lane >> 4;
    const int K = g.K, nt = K / BK;
    unsigned voffA[2], voffB[2];
#pragma unroll
    for (int i = 0; i < 2; ++i) { int R, C; stage_rc(tid * 16 + i * 8192, R, C); const int Rb = Epi::PERM ? ((R & ~31) + perm32(R & 31)) : R;
        voffA[i] = (unsigned)(R * K + C) * 2u; voffB[i] = (unsigned)(Rb * K + C) * 2u; }
    const size_t kstep = (size_t)(BK * 2);
    const size_t hstep = (size_t)HALF * K * 2;
    const size_t tstep = 2 * hstep;
    const unsigned ldsw = (unsigned)wid * 1024u;
    const int aoff = lds_byte(wr * 64 + fr, fq * 8), boff = lds_byte(wc * 32 + fr, fq * 8);
#define PG8_SA(b, h) (((b) * 2 + (h)) * HTB)
#define PG8_SB(b, h) ((4 + (b) * 2 + (h)) * HTB)
#define PG8_STAGE(bufoff, gbase, voff) do { _Pragma("unroll") for (int _i = 0; _i < 2; ++_i) \
        __builtin_amdgcn_global_load_lds((const unsigned*)((const char*)(gbase) + (voff)[_i]), (PG8_LAS unsigned*)(lds + (bufoff) + ldsw + _i * 8192), 16, 0, 0); } while (0)
#define PG8_LDA(dst, b, h) do { _Pragma("unroll") for (int m = 0; m < 4; ++m) _Pragma("unroll") for (int k = 0; k < 2; ++k) dst[m][k] = *(const PG8_LAS bf16x8*)(lds + PG8_SA(b, h) + aoff + m * 2048 + k * 1024); } while (0)
#define PG8_LDB(dst, b, h) do { _Pragma("unroll") for (int n = 0; n < 2; ++n) _Pragma("unroll") for (int k = 0; k < 2; ++k) dst[n][k] = *(const PG8_LAS bf16x8*)(lds + PG8_SB(b, h) + boff + n * 2048 + k * 1024); } while (0)
#define PG8_MMA(ai, bj, At, Bt) do { __builtin_amdgcn_s_setprio(1); _Pragma("unroll") for (int m = 0; m < 4; ++m) _Pragma("unroll") for (int n = 0; n < 2; ++n) _Pragma("unroll") for (int k = 0; k < 2; ++k) \
        acc[ai][bj][m][n] = __builtin_amdgcn_mfma_f32_16x16x32_bf16(Bt[n][k], At[m][k], acc[ai][bj][m][n], 0, 0, 0); __builtin_amdgcn_s_setprio(0); } while (0)
#define PG8_WAIT_V(n) asm volatile("s_waitcnt vmcnt(" #n ")" ::: "memory")
#define PG8_WAIT_L(n) asm volatile("s_waitcnt lgkmcnt(" #n ")" ::: "memory")
#define PG8_BAR __builtin_amdgcn_s_barrier()
#define PG8_SCHED __builtin_amdgcn_sched_barrier(0)
    Unit cur, nxt; int ui = 0;
    if (!S.next(0, cur)) return;
    f32x4 acc[2][2][4][2];
#pragma unroll
    for (int a = 0; a < 2; ++a)
#pragma unroll
        for (int b = 0; b < 2; ++b)
#pragma unroll
            for (int m = 0; m < 4; ++m)
#pragma unroll
                for (int n = 0; n < 2; ++n) acc[a][b][m][n] = (f32x4){0.f, 0.f, 0.f, 0.f};
    bf16x8 At[4][2], B0[2][2], B1[2][2];
    const char* cA = (const char*)g.A + (size_t)cur.pm * tstep; const char* cB = (const char*)g.Bt + (size_t)cur.pn * tstep;
    S.a_ready(cur);
    if constexpr (SP2) {
        PG8_STAGE(PG8_SB(0, 0), cB, voffB); PG8_STAGE(PG8_SB(0, 1), cB + hstep, voffB); PG8_STAGE(PG8_SA(0, 0), cA, voffA); PG8_STAGE(PG8_SA(0, 1), cA + hstep, voffA);
        if (wr == 1) PG8_BAR;
        PG8_WAIT_V(2); PG8_BAR;
        PG8_STAGE(PG8_SB(1, 0), cB + kstep, voffB); PG8_STAGE(PG8_SA(1, 0), cA + kstep, voffA); PG8_STAGE(PG8_SB(1, 1), cB + hstep + kstep, voffB);
        PG8_WAIT_V(6); PG8_BAR;
    } else {
        PG8_STAGE(PG8_SB(0, 0), cB, voffB); PG8_STAGE(PG8_SA(0, 0), cA, voffA); PG8_STAGE(PG8_SB(0, 1), cB + hstep, voffB); PG8_STAGE(PG8_SA(0, 1), cA + hstep, voffA);
        if (wr == 1) PG8_BAR;
        PG8_WAIT_V(4); PG8_BAR;
        PG8_STAGE(PG8_SB(1, 0), cB + kstep, voffB); PG8_STAGE(PG8_SA(1, 0), cA + kstep, voffA); PG8_STAGE(PG8_SB(1, 1), cB + hstep + kstep, voffB);
        PG8_WAIT_V(6); PG8_BAR;
    }
    for (;;) {
        const bool has_next = S.next(ui + 1, nxt);
        const char* nA = has_next ? (const char*)g.A + (size_t)nxt.pm * tstep : cA; const char* nB = has_next ? (const char*)g.Bt + (size_t)nxt.pn * tstep : cB;
        for (int t = 0; t < nt; t += 2) {
            const bool last = (t == nt - 2);
            const char* a1 = cA + (size_t)(t + 1) * kstep;
            const char* a2 = last ? nA : cA + (size_t)(t + 2) * kstep; const char* b2 = last ? nB : cB + (size_t)(t + 2) * kstep;
            const char* a3 = a2 + kstep; const char* b3 = b2 + kstep;
            if (last && has_next) S.a_ready(nxt);
            if constexpr (SP2) {
            PG8_LDB(B0, 0, 0); PG8_LDB(B1, 0, 1); PG8_SCHED; PG8_LDA(At, 0, 0); PG8_STAGE(PG8_SA(1, 1), a1 + hstep, voffA);
            PG8_WAIT_V(8); PG8_WAIT_L(0); PG8_BAR; PG8_MMA(0, 0, At, B0); PG8_MMA(0, 1, At, B1); PG8_BAR; PG8_SCHED;
            PG8_LDA(At, 0, 1); PG8_STAGE(PG8_SB(0, 0), b2, voffB); PG8_STAGE(PG8_SB(0, 1), b2 + hstep, voffB); PG8_STAGE(PG8_SA(0, 0), a2, voffA);
            PG8_WAIT_V(8); PG8_WAIT_L(0); PG8_BAR; PG8_MMA(1, 0, At, B0); PG8_MMA(1, 1, At, B1); PG8_BAR; PG8_SCHED;
            PG8_LDB(B0, 1, 0); PG8_LDB(B1, 1, 1); PG8_SCHED; PG8_LDA(At, 1, 0); PG8_STAGE(PG8_SA(0, 1), a2 + hstep, voffA);
            PG8_WAIT_V(8); PG8_WAIT_L(0); PG8_BAR; PG8_MMA(0, 0, At, B0); PG8_MMA(0, 1, At, B1); PG8_BAR; PG8_SCHED;
            PG8_LDA(At, 1, 1); PG8_STAGE(PG8_SB(1, 0), b3, voffB); PG8_STAGE(PG8_SB(1, 1), b3 + hstep, voffB); PG8_STAGE(PG8_SA(1, 0), a3, voffA);
            PG8_WAIT_V(8); PG8_WAIT_L(0); PG8_BAR; PG8_MMA(1, 0, At, B0); PG8_MMA(1, 1, At, B1); PG8_BAR; PG8_SCHED;
            } else {
            PG8_LDB(B0, 0, 0); PG8_SCHED; PG8_LDA(At, 0, 0); PG8_STAGE(PG8_SA(1, 1), a1 + hstep, voffA);
            PG8_WAIT_L(8); PG8_BAR; PG8_WAIT_L(0); PG8_MMA(0, 0, At, B0); PG8_BAR; PG8_SCHED;
            PG8_LDB(B1, 0, 1); PG8_STAGE(PG8_SB(0, 0), b2, voffB);
            PG8_BAR; PG8_WAIT_L(0); PG8_MMA(0, 1, At, B1); PG8_BAR;
            PG8_LDA(At, 0, 1); PG8_STAGE(PG8_SA(0, 0), a2, voffA);
            PG8_BAR; PG8_WAIT_L(0); PG8_MMA(1, 0, At, B0); PG8_BAR; PG8_SCHED;
            PG8_STAGE(PG8_SB(0, 1), b2 + hstep, voffB);
            PG8_WAIT_V(6); PG8_BAR; PG8_MMA(1, 1, At, B1); PG8_BAR;
            PG8_LDB(B0, 1, 0); PG8_SCHED; PG8_LDA(At, 1, 0); PG8_STAGE(PG8_SA(0, 1), a2 + hstep, voffA);
            PG8_WAIT_L(8); PG8_BAR; PG8_WAIT_L(0); PG8_MMA(0, 0, At, B0); PG8_BAR; PG8_SCHED;
            PG8_LDB(B1, 1, 1); PG8_STAGE(PG8_SB(1, 0), b3, voffB);
            PG8_BAR; PG8_WAIT_L(0); PG8_MMA(0, 1, At, B1); PG8_BAR;
            PG8_LDA(At, 1, 1); PG8_STAGE(PG8_SA(1, 0), a3, voffA);
            PG8_BAR; PG8_WAIT_L(0); PG8_MMA(1, 0, At, B0); PG8_BAR; PG8_SCHED;
            PG8_STAGE(PG8_SB(1, 1), b3 + hstep, voffB);
            PG8_WAIT_V(6); PG8_BAR; PG8_MMA(1, 1, At, B1); PG8_BAR;
            }
        }
        if constexpr (ALIGN_EPI) { if (wr == 0) PG8_BAR; }
        if constexpr (!Epi::AFTER_DRAIN) { E(acc, cur, wr, wc, fr, fq); S.done(cur); }
        if (!has_next) break;
#pragma unroll
        for (int a = 0; a < 2; ++a)
#pragma unroll
            for (int b = 0; b < 2; ++b)
#pragma unroll
                for (int m = 0; m < 4; ++m)
#pragma unroll
                    for (int n = 0; n < 2; ++n) acc[a][b][m][n] = (f32x4){0.f, 0.f, 0.f, 0.f};
        cur = nxt; cA = nA; cB = nB; ++ui;
        if constexpr (ALIGN_EPI) { if (wr == 1) PG8_BAR; }
    }
    PG8_WAIT_V(0);
    if constexpr (!ALIGN_EPI) { if (wr == 0) PG8_BAR; }
    PG8_BAR;
    if constexpr (Epi::AFTER_DRAIN) { E.fused(acc, cur, wr, wc, fr, fq, lds, wid, lane); S.done(cur); }
#undef PG8_SA
#undef PG8_SB
#undef PG8_STAGE
#undef PG8_LDA
#undef PG8_LDB
#undef PG8_MMA
#undef PG8_WAIT_V
#undef PG8_WAIT_L
#undef PG8_BAR
#undef PG8_SCHED
}
}
#define GAS __attribute__((address_space(1)))
#define LAS __attribute__((address_space(3)))
typedef unsigned short bf16;
typedef unsigned v4u __attribute__((ext_vector_type(4)));
typedef float f32x4 __attribute__((ext_vector_type(4)));
typedef short bf16x8 __attribute__((ext_vector_type(8)));
typedef GAS unsigned gu32;
typedef GAS unsigned long long gu64;
#define RLX_AGENT __ATOMIC_RELAXED, __HIP_MEMORY_SCOPE_AGENT
#define LDS_WAIT() asm volatile("s_waitcnt lgkmcnt(0)" ::: "memory")
#define VM_WAIT() asm volatile("s_waitcnt vmcnt(0)" ::: "memory")
__device__ __forceinline__ unsigned long long rt() { return __builtin_amdgcn_s_memrealtime(); }
__device__ __forceinline__ unsigned f2bf(float f) { unsigned u = __builtin_bit_cast(unsigned, f); return (u + 0x7fffu + ((u >> 16) & 1u)) >> 16; }
__device__ __forceinline__ unsigned pk2(float lo, float hi) { return f2bf(lo) | (f2bf(hi) << 16); }
typedef float f32x2v __attribute__((ext_vector_type(2)));

#define XB_TMO      128
#define XB_XCNT(j)  (256  + 64 * (j))
#define XB_XSUB(j)  (1280 + 64 * (j))
#define XB_XGEN(j)  (2304 + 64 * (j))
#define XB_TOP      3328
#define XB_TOPGEN   3392
#define XCD_BAR_WORDS 3456
#define XB_SPIN_CAP (1u << 24)

__device__ __forceinline__ unsigned xb_ld(unsigned* p)              { return __hip_atomic_load(p, __ATOMIC_RELAXED, __HIP_MEMORY_SCOPE_AGENT); }
__device__ __forceinline__ unsigned xb_add(unsigned* p, unsigned v) { return __hip_atomic_fetch_add(p, v, __ATOMIC_RELAXED, __HIP_MEMORY_SCOPE_AGENT); }
__device__ __forceinline__ unsigned xb_xcc_id() { return (unsigned)__builtin_amdgcn_s_getreg((3 << 11) | 20) & 0xFu; }
#define XB_SPIN(cond, bar) do { unsigned _sp = 0; while (cond) { __builtin_amdgcn_s_sleep(1); \
    if ((++_sp & 255u) == 0u) { if (xb_ld(&(bar)[XB_TMO])) break; if (_sp > XB_SPIN_CAP) { atomicAdd(&(bar)[XB_TMO], 1u); break; } } } } while (0)

struct XcdBarrier {
    unsigned* bar; unsigned x;
    volatile LAS unsigned* st;
};

__device__ __forceinline__ XcdBarrier xcd_barrier_post(unsigned* bar, volatile LAS unsigned* st) {
    XcdBarrier b; b.bar = bar; b.x = xb_xcc_id(); b.st = st;
    if (threadIdx.x == 0) (void)xb_add(&bar[XB_XCNT(b.x)], 1u);
    return b;
}
__device__ __forceinline__ void xcd_barrier_complete(unsigned* bar, unsigned x, unsigned& nloc, unsigned& nx) {
    const unsigned G = gridDim.x * gridDim.y * gridDim.z;
    unsigned sum, cnt, mine, sp = 0u;
    for (;;) {
        sum = 0u; cnt = 0u; mine = 0u;
#pragma unroll
        for (unsigned j = 0; j < 16; ++j) { const unsigned c = xb_ld(&bar[XB_XCNT(j)]); sum += c; cnt += (c > 0u) ? 1u : 0u; mine = (j == x) ? c : mine; }
        if (sum == G) break;
        __builtin_amdgcn_s_sleep(1);
        if ((++sp & 255u) == 0u) { if (xb_ld(&bar[XB_TMO])) break; if (sp > XB_SPIN_CAP) { atomicAdd(&bar[XB_TMO], 1u); break; } }
    }
    nloc = mine > 0u ? mine : 1u; nx = cnt > 0u ? cnt : 1u;
}

__device__ __forceinline__ void xcd_barrier(const XcdBarrier& b) {
    asm volatile("s_waitcnt vmcnt(0)" ::: "memory");
    __syncthreads();
    if (threadIdx.x == 0) {
        unsigned* bar = b.bar;
        __builtin_amdgcn_s_waitcnt(0);
        unsigned nloc = b.st[0], nx = b.st[1];
        if (nloc == 0u) { xcd_barrier_complete(bar, b.x, nloc, nx); b.st[0] = nloc; b.st[1] = nx; }
        const unsigned old = xb_add(&bar[XB_XSUB(b.x)], 1u);
        const unsigned gen = old / nloc;
        if (old + 1u == (gen + 1u) * nloc) {
            __builtin_amdgcn_fence(__ATOMIC_RELEASE, "agent");
            asm volatile("s_waitcnt vmcnt(0)" ::: "memory");
            const unsigned og = xb_add(&bar[XB_TOP], 1u);
            const unsigned tg = og / nx;
            if (og + 1u == (tg + 1u) * nx) xb_add(&bar[XB_TOPGEN], 1u);
            else XB_SPIN(xb_ld(&bar[XB_TOPGEN]) == tg, bar);
            __builtin_amdgcn_fence(__ATOMIC_ACQUIRE, "agent");
            xb_add(&bar[XB_XGEN(b.x)], 1u);
            asm volatile("s_waitcnt vmcnt(0)" ::: "memory");
        } else {
            XB_SPIN(xb_ld(&bar[XB_XGEN(b.x)]) == gen, bar);
            __builtin_amdgcn_fence(__ATOMIC_ACQUIRE, "agent");
            asm volatile("s_waitcnt vmcnt(0)" ::: "memory");
        }
    }
    __syncthreads();
}

constexpr int NWAVES = 8;
constexpr int NB = 4, SEQ = 4096, CTXL = 256, DM = 1024, ML = NB * SEQ, MC = NB * CTXL, MT = ML + MC;
constexpr int DFF = 2816, NUP = 2 * DFF, N0P = 3328, N1 = 6144;
constexpr float EPS = 1e-6f;
constexpr size_t MiB = 1u << 20;
constexpr size_t WS_CTL = 0, CTL_ZERO_BYTES = 64 * 1024;
constexpr size_t WS_MOD = 1 * MiB;
constexpr size_t WS_ROPE = 1 * MiB + 512 * 1024;
constexpr size_t WS_XC = 2 * MiB;
constexpr size_t WS_WIN1T = 8 * MiB;
constexpr size_t WS_H = 20 * MiB;
constexpr size_t WS_WIN0T = 54 * MiB, WS_WO0T = WS_WIN0T + 6656 * 1024, WS_WUPT0 = WS_WO0T + 2 * MiB, WS_WDNT0 = WS_WUPT0 + 11 * MiB;
constexpr size_t WS_NAQ = 79 * MiB, WS_NAK = 96 * MiB, WS_NAV = 113 * MiB;
constexpr size_t WS_GQ = 130 * MiB, WS_GK = WS_GQ + 8704 * 1024, WS_GV = 147 * MiB, WS_GR = 164 * MiB, WS_GA = 181 * MiB;
constexpr size_t WS_CAT = 184 * MiB;
constexpr size_t WS_X218 = 218 * MiB;
constexpr size_t WS_ACT0 = 80 * MiB, WS_EDGE0 = 174 * MiB;
constexpr size_t WS_WO1T = 252 * MiB;
constexpr size_t WS_RQ = 54 * MiB, WS_RK = 86 * MiB, WS_RV = 120 * MiB, WS_RG = 188 * MiB;
constexpr size_t WS_WUPT1 = 54 * MiB, WS_WDNT1 = 65 * MiB, WS_ACT1 = 72 * MiB, WS_EDGE1 = 160 * MiB;
constexpr size_t WS_END = 256 * MiB;
static_assert(WS_NAQ == pg8::PJ0_NAQ && WS_NAK == pg8::PJ0_NAK && WS_NAV == pg8::PJ0_NAV && WS_GQ == pg8::PJ0_GQ && WS_GK == pg8::PJ0_GK && WS_GV == pg8::PJ0_GV && WS_GR == pg8::PJ0_GR && WS_GA == pg8::PJ0_GA, "proj0 map");
static_assert(WS_RQ == pg8::PJ1_RQ && WS_RK == pg8::PJ1_RK && WS_RV == pg8::PJ1_RV && WS_RG == pg8::PJ1_RG && WS_ROPE == pg8::PJ1_ROPE, "proj1 map");
constexpr int CW_BAR = 4096;
constexpr int RING_OFF = 0, RING_BYTES = 131072, LDSCTL_OFF = RING_BYTES, MISC_OFF = LDSCTL_OFF + 320, LDS_BYTES = 147456;

struct Args { const float* in[26]; float* out; unsigned char* ws; int ph_lo, ph_hi; };
struct Frame {
    LAS unsigned char* lds; int tid, lane, wave, G, bid;
    const Args* a; float* out; unsigned char* ws;
};
#define IN_X 0
#define IN_C 1
#define IN_CTX 2
#define IN_CCTX 3
#define IN_WMOD 4
#define IN_BMOD 5
#define IN_N1G 6
#define IN_N2G 7
#define IN_WIN0 8
#define IN_WO0 9
#define IN_RPB 10
#define IN_WAF 11
#define IN_BAF 12
#define IN_WAB 13
#define IN_BAB 14
#define IN_GNG 15
#define IN_WIN1 16
#define IN_WO1 17
#define IN_DECF 18
#define IN_DECB 19
#define IN_RNG 20
#define IN_WUP 21
#define IN_CW 22
#define IN_CB 23
#define IN_WDN 24
#define IN_FNG 25

__device__ __forceinline__ int xcd_vcu(int bid, int G) { return (G % 8 == 0) ? (bid % 8) * (G / 8) + bid / 8 : bid; }
__device__ __forceinline__ float wave_sum(float v) {
#pragma unroll
    for (int o = 1; o < 64; o <<= 1) v += __shfl_xor(v, o);
    return v;
}
__device__ __forceinline__ float wave_max(float v) {
#pragma unroll
    for (int o = 1; o < 64; o <<= 1) v = fmaxf(v, __shfl_xor(v, o));
    return v;
}
__device__ __forceinline__ float bf2f(bf16 b) { return __builtin_bit_cast(float, (unsigned)b << 16); }
__device__ __forceinline__ float silu_f(float a) { return a / (1.0f + __expf(-a)); }
__device__ __forceinline__ float logsig_f(float z) { return fminf(z, 0.f) - log1pf(__expf(-fabsf(z))); }
__device__ __forceinline__ float logsig_fast(float z) { return fminf(z, 0.f) - __logf(1.0f + __expf(-fabsf(z))); }

struct MapId { int nsrc; __device__ __forceinline__ int operator()(int n) const { return n < nsrc ? n : -1; } };
struct MapUp { __device__ __forceinline__ int operator()(int n) const { return ((n >> 7) & 1) * DFF + (n >> 8) * 128 + (n & 127); } };
struct MapIn1 { __device__ __forceinline__ int operator()(int n) const {
    if (n >= 2048) return n;
    const int p = n & 127, wc = p >> 5, fq = (p >> 3) & 3, nn = (p >> 2) & 1, e = p & 3;
    return (n & ~127) + (wc >> 1) * 64 + nn * 32 + (wc & 1) * 16 + 4 * fq + e; } };
template <class MAP> __device__ __forceinline__ void transpose_item(const float* W, int K, int Nsrc, int Ndst, bf16* WT, LAS float* scr, int item, int lane, const MAP& map) {
    const int nblk = Ndst / 32, kb = item / nblk, nb = item % nblk, k0 = 64 * kb, n0 = 32 * nb;
    const int sc = map(n0 + (lane & 31));
#pragma unroll 8
    for (int i = 0; i < 32; ++i) { const int kk = 2 * i + (lane >> 5); scr[kk * 33 + (lane & 31)] = sc >= 0 ? W[(size_t)(k0 + kk) * Nsrc + sc] : 0.f; }
    LDS_WAIT(); asm volatile("" ::: "memory");
    const int c = lane & 7;
#pragma unroll
    for (int j = 0; j < 4; ++j) { const int n = (lane >> 3) + 8 * j; const LAS float* s = scr + (8 * c) * 33 + n;
        v4u o; o.x = pk2(s[0 * 33], s[1 * 33]); o.y = pk2(s[2 * 33], s[3 * 33]); o.z = pk2(s[4 * 33], s[5 * 33]); o.w = pk2(s[6 * 33], s[7 * 33]);
        *(GAS v4u*)(WT + (size_t)(n0 + n) * K + k0 + 8 * c) = o; }
    LDS_WAIT(); asm volatile("" ::: "memory");
}
template <class MAP> __device__ __forceinline__ void transpose_all(Frame& F, const float* W, int K, int Nsrc, int Ndst, bf16* WT, const MAP& map, int vbid = -1, int vG = 0) {
    LAS float* scr = (LAS float*)(F.lds + RING_OFF + F.wave * 16384);
    if (vbid < 0) { vbid = F.bid; vG = F.G; }
    const int gw = F.wave * vG + vbid, NGW = vG * NWAVES, nitems = (K / 64) * (Ndst / 32);
    for (int it = gw; it < nitems; it += NGW) transpose_item(W, K, Nsrc, Ndst, WT, scr, it, F.lane, map);
}

__device__ __forceinline__ void phase_prep(Frame& F) {
    unsigned char* ws = F.ws;
    transpose_all(F, F.a->in[IN_WIN0], 1024, 3104, N0P, (bf16*)(ws + WS_WIN0T), MapId{3104});
    transpose_all(F, F.a->in[IN_WO0], 1024, 1024, 1024, (bf16*)(ws + WS_WO0T), MapId{1024});
    __syncthreads();
    LAS float* sv = (LAS float*)(F.lds);
    LAS float* red = (LAS float*)(F.lds + 32768);
    for (int i = F.tid; i < 5 * 1024; i += 512) { const int bi = i >> 10, k = i & 1023; const float v = bi < 4 ? F.a->in[IN_C][bi * 1024 + k] : F.a->in[IN_CCTX][k]; sv[i] = silu_f(v); }
    __syncthreads();
    float* mod = (float*)(ws + WS_MOD);
    for (int it = F.bid; it < 2 * 192; it += F.G) {
        const int l = it / 192, n0 = (it % 192) * 32, c = F.tid & 31, kp = F.tid >> 5;
        const float* w = F.a->in[IN_WMOD] + (size_t)l * 1024 * 6144 + (size_t)(kp * 64) * 6144 + n0 + c;
        float a0 = 0.f, a1 = 0.f, a2 = 0.f, a3 = 0.f, a4 = 0.f;
#pragma unroll 16
        for (int kk = 0; kk < 64; ++kk) { const int k = kp * 64 + kk; const float wv = w[(size_t)kk * 6144];
            a0 += sv[k] * wv; a1 += sv[1024 + k] * wv; a2 += sv[2048 + k] * wv; a3 += sv[3072 + k] * wv; a4 += sv[4096 + k] * wv; }
        red[(kp * 5 + 0) * 32 + c] = a0; red[(kp * 5 + 1) * 32 + c] = a1; red[(kp * 5 + 2) * 32 + c] = a2; red[(kp * 5 + 3) * 32 + c] = a3; red[(kp * 5 + 4) * 32 + c] = a4;
        __syncthreads();
        if (F.tid < 160) { const int bi = F.tid >> 5, cc = F.tid & 31; float s = 0.f;
#pragma unroll
            for (int p = 0; p < 16; ++p) s += red[(p * 5 + bi) * 32 + cc];
            mod[((size_t)l * 5 + bi) * 6144 + n0 + cc] = s + F.a->in[IN_BMOD][l * 6144 + n0 + cc]; }
        __syncthreads();
    }
    if (F.bid == 0) { f32x2v* rope = (f32x2v*)(ws + WS_ROPE);
        for (int i = F.tid; i < 64 * 32; i += 512) { const int pos = i >> 5, f = i & 31; const float inv = powf(10000.f, -(float)(2 * f) / 64.f), ang = (float)pos * inv; rope[i] = (f32x2v){cosf(ang), sinf(ang)}; } }
}

__device__ __forceinline__ void phase_prep_late(Frame& F, int vbid, int vG) {
    unsigned char* ws = F.ws;
    __syncthreads();
    transpose_all(F, F.a->in[IN_WUP], 1024, NUP, NUP, (bf16*)(ws + WS_WUPT0), MapUp{}, vbid, vG);
    transpose_all(F, F.a->in[IN_WDN], DFF, 1024, 1024, (bf16*)(ws + WS_WDNT0), MapId{1024}, vbid, vG);
    transpose_all(F, F.a->in[IN_WIN1], 1024, N1, N1, (bf16*)(ws + WS_WIN1T), MapIn1{}, vbid, vG);
    transpose_all(F, F.a->in[IN_WO1], 2048, 1024, 1024, (bf16*)(ws + WS_WO1T), MapId{1024}, vbid, vG);
    __syncthreads();
}
__device__ __forceinline__ void phase_modnorm(Frame& F, const float* xl, const float* xc, int nrows, const float* g, const float* modl  , int shoff) {
    bf16* H = (bf16*)(F.ws + WS_H);
    const int gw = F.wave * F.G + F.bid, NGW = F.G * NWAVES;
    for (int m = gw; m < nrows; m += NGW) {
        const float* src = m < ML ? xl + (size_t)m * DM : xc + (size_t)(m - ML) * DM; const int bi = m < ML ? (m >> 12) : 4;
        const float* sh = modl + bi * 6144 + shoff; const float* sc = sh + 1024;
        f32x4 v[4]; float ss = 0.f;
#pragma unroll
        for (int j = 0; j < 4; ++j) { v[j] = *(const f32x4*)(src + 256 * j + 4 * F.lane); ss += (v[j].x * v[j].x + v[j].y * v[j].y) + (v[j].z * v[j].z + v[j].w * v[j].w); }
        const float rstd = 1.0f / sqrtf(wave_sum(ss) * (1.f / DM) + EPS);
#pragma unroll
        for (int j = 0; j < 4; ++j) { const int k = 256 * j + 4 * F.lane; const f32x4 gg = *(const f32x4*)(g + k), s1 = *(const f32x4*)(sc + k), s0 = *(const f32x4*)(sh + k);
            const f32x4 h = v[j] * rstd * gg * (s1 + 1.0f) + s0;
            *(unsigned long long*)(H + (size_t)m * DM + k) = (unsigned long long)pk2(h.x, h.y) | ((unsigned long long)pk2(h.z, h.w) << 32); }
    }
}
__device__ __forceinline__ void phase_final(Frame& F) {
    const float* g = F.a->in[IN_FNG]; const int gw = F.wave * F.G + F.bid, NGW = F.G * NWAVES;
    for (int m = gw; m < ML; m += NGW) { float* p = F.out + (size_t)m * DM; f32x4 v[4]; float ss = 0.f;
#pragma unroll
        for (int j = 0; j < 4; ++j) { v[j] = *(const f32x4*)(p + 256 * j + 4 * F.lane); ss += (v[j].x * v[j].x + v[j].y * v[j].y) + (v[j].z * v[j].z + v[j].w * v[j].w); }
        const float rstd = 1.0f / sqrtf(wave_sum(ss) * (1.f / DM) + EPS);
#pragma unroll
        for (int j = 0; j < 4; ++j) { const int k = 256 * j + 4 * F.lane; *(f32x4*)(p + k) = v[j] * rstd * *(const f32x4*)(g + k); } }
}
__device__ __forceinline__ void phase_fixup(Frame& F, const float* edge, bf16* act, int nblk, const float* cw, const float* cb) {
    const int total = nblk * 2 * (DFF / 4);
    for (int i = F.bid * 512 + F.tid; i < total; i += F.G * 512) {
        const int j = (i % (DFF / 4)) * 4, e = (i / (DFF / 4)) & 1, blk = i / (DFF / 2);
        const int row = blk * 64 + (e ? 63 : 0);
        bool has_prev = true, has_next = true;
        if (e == 0) { has_prev = row < ML ? (row & 4095) != 0 : ((row - ML) & 255) != 0; } else { has_next = row < ML ? (row & 4095) != 4095 : ((row - ML) & 255) != 255; }
        const float* pp = e == 0 ? edge + (size_t)((blk - 1) * 4 + 3) * NUP : edge + (size_t)(blk * 4 + 2) * NUP;
        const float* pc = edge + (size_t)(blk * 4 + (e ? 3 : 0)) * NUP;
        const float* pn = e == 0 ? edge + (size_t)(blk * 4 + 1) * NUP : edge + (size_t)((blk + 1) * 4 + 0) * NUP;
        f32x4 y[2];
#pragma unroll
        for (int h = 0; h < 2; ++h) { const int c = h * DFF + j; const f32x4 z = {0.f, 0.f, 0.f, 0.f};
            const f32x4 xp = has_prev ? *(const f32x4*)(pp + c) : z, xc = *(const f32x4*)(pc + c), xn = has_next ? *(const f32x4*)(pn + c) : z;
            y[h] = *(const f32x4*)(cw + c) * xp + *(const f32x4*)(cw + NUP + c) * xc + *(const f32x4*)(cw + 2 * NUP + c) * xn + *(const f32x4*)(cb + c); }
        f32x4 r;
#pragma unroll
        for (int q = 0; q < 4; ++q) r[q] = silu_f(y[0][q]) * y[1][q];
        *(unsigned long long*)(act + (size_t)row * DFF + j) = (unsigned long long)pk2(r.x, r.y) | ((unsigned long long)pk2(r.z, r.w) << 32);
    }
}
template <int K> __device__ __forceinline__ void ctx_gemm_res(Frame& F, const bf16* A, const bf16* Bt, const float* base, float* out, const float* gate) {
    const int lane = F.lane, w = F.wave, r16 = lane & 15, g = lane >> 4;
    constexpr int NS = K / 256;
    LAS f32x4* red = (LAS f32x4*)F.lds;
    for (int t = F.bid; t < 256; t += F.G) {
        const int tm = t >> 4, tn = t & 15;
        f32x4 acc[4][4];
#pragma unroll
        for (int m = 0; m < 4; ++m)
#pragma unroll
            for (int n = 0; n < 4; ++n) acc[m][n] = (f32x4){0.f, 0.f, 0.f, 0.f};
        const bf16* ap = A + (size_t)(64 * tm + r16) * K + w * (K / 8) + 8 * g;
        const bf16* bp = Bt + (size_t)(64 * tn + r16) * K + w * (K / 8) + 8 * g;
        constexpr int PD = 4;
        bf16x8 af[PD][4], bfr[PD][4];
#pragma unroll
        for (int p = 0; p < PD - 1; ++p)
            if (p < NS) {
#pragma unroll
                for (int m = 0; m < 4; ++m) { af[p][m] = *(const bf16x8*)(ap + (size_t)(16 * m) * K + 32 * p); bfr[p][m] = *(const bf16x8*)(bp + (size_t)(16 * m) * K + 32 * p); } }
#pragma unroll
        for (int s = 0; s < NS; ++s) {
            if (s + PD - 1 < NS) {
#pragma unroll
                for (int m = 0; m < 4; ++m) { af[(s + PD - 1) % PD][m] = *(const bf16x8*)(ap + (size_t)(16 * m) * K + 32 * (s + PD - 1)); bfr[(s + PD - 1) % PD][m] = *(const bf16x8*)(bp + (size_t)(16 * m) * K + 32 * (s + PD - 1)); } }
#pragma unroll
            for (int m = 0; m < 4; ++m)
#pragma unroll
                for (int n = 0; n < 4; ++n) acc[m][n] = __builtin_amdgcn_mfma_f32_16x16x32_bf16(af[s % PD][m], bfr[s % PD][n], acc[m][n], 0, 0, 0);
        }
        if (w > 0) {
#pragma unroll
            for (int m = 0; m < 4; ++m)
#pragma unroll
                for (int n = 0; n < 4; ++n) red[((w - 1) * 16 + m * 4 + n) * 64 + lane] = acc[m][n];
        }
        __syncthreads();
#pragma unroll
        for (int j = 0; j < 2; ++j) { const int tt = 2 * w + j, m = tt >> 2, n = tt & 3;
            f32x4 v = (f32x4){0.f, 0.f, 0.f, 0.f};
#pragma unroll
            for (int q = 0; q < 7; ++q) v = v + red[(q * 16 + tt) * 64 + lane];
            red[(7 * 16 + tt) * 64 + lane] = v; }
        __syncthreads();
        if (w == 0) {
#pragma unroll
            for (int m = 0; m < 4; ++m)
#pragma unroll
                for (int n = 0; n < 4; ++n) {
                    const f32x4 v = acc[m][n] + red[(7 * 16 + m * 4 + n) * 64 + lane];
                    const int col = 64 * tn + 16 * n + r16; const float gt = gate[col];
#pragma unroll
                    for (int e = 0; e < 4; ++e) { const size_t o = (size_t)(64 * tm + 16 * m + 4 * g + e) * 1024 + col; out[o] = base[o] + gt * v[e]; }
                }
        }
        __syncthreads();
    }
}
__device__ __forceinline__ void phase_na_simple(Frame& F) {
    const bf16* naq = (const bf16*)(F.ws + WS_NAQ); const bf16* nak = (const bf16*)(F.ws + WS_NAK); const bf16* nav = (const bf16*)(F.ws + WS_NAV);
    bf16* cat = (bf16*)(F.ws + WS_CAT); const float* rpb = F.a->in[IN_RPB];
    const int gw = F.wave * F.G + F.bid, NGW = F.G * NWAVES, ntask = NB * 8 * 4352, lane = F.lane;
    for (int t = gw; t < ntask; t += NGW) {
        const int qi = t % 4352, bh = t / 4352, h = bh & 7, b = bh >> 3; const bool lat = qi < 4096;
        const size_t hb = (size_t)bh * 4352;
        float q[64];
        { const v4u* qp = (const v4u*)(naq + (hb + qi) * 64);
#pragma unroll
          for (int j = 0; j < 8; ++j) { const v4u w = qp[j];
#pragma unroll
              for (int e = 0; e < 4; ++e) { q[8 * j + 2 * e] = __builtin_bit_cast(float, w[e] << 16); q[8 * j + 2 * e + 1] = __builtin_bit_cast(float, w[e] & 0xffff0000u); } } }
        const int qr = qi >> 6, qc = qi & 63, r0 = min(max(qr - 4, 0), 56), c0 = min(max(qc - 8, 0), 48);
        float sc[6]; float mx = -1e30f;
#pragma unroll
        for (int i = 0; i < 6; ++i) {
            const int kidx = lane + 64 * i; int tok; float bias = 0.f; bool valid = true;
            if (i < 2) { const int ki = r0 + (kidx >> 4), kj = c0 + (kidx & 15); tok = ki * 64 + kj; valid = lat; if (lat) bias = rpb[(h * 15 + (ki - qr + 7)) * 31 + (kj - qc + 15)]; }
            else tok = 4096 + kidx - 128;
            float d = 0.f;
            if (valid) { const v4u* kp = (const v4u*)(nak + (hb + tok) * 64);
#pragma unroll
                for (int j = 0; j < 8; ++j) { const v4u w = kp[j];
#pragma unroll
                    for (int e = 0; e < 4; ++e) { d += q[8 * j + 2 * e] * __builtin_bit_cast(float, w[e] << 16); d += q[8 * j + 2 * e + 1] * __builtin_bit_cast(float, w[e] & 0xffff0000u); } } }
            sc[i] = valid ? d + bias : -1e30f; mx = fmaxf(mx, sc[i]);
        }
        mx = wave_max(mx); float l = 0.f;
#pragma unroll
        for (int i = 0; i < 6; ++i) { sc[i] = sc[i] > -1e29f ? __expf(sc[i] - mx) : 0.f; l += sc[i]; }
        l = wave_sum(l);
        float o = 0.f;
#pragma unroll
        for (int i = 0; i < 6; ++i) {
            if (i < 2 && !lat) continue;
            for (int j = 0; j < 64; ++j) { const int kidx = j + 64 * i; int tok;
                if (i < 2) tok = (r0 + (kidx >> 4)) * 64 + c0 + (kidx & 15); else tok = 4096 + kidx - 128;
                o += __shfl(sc[i], j) * bf2f(nav[(hb + tok) * 64 + lane]); }
        }
        const int row = lat ? b * 4096 + qi : ML + b * 256 + (qi - 4096);
        cat[(size_t)row * 1024 + h * 64 + lane] = (bf16)f2bf(o / l);
    }
}
__device__ __forceinline__ void phase_gla_gates_simple(Frame& F) {
    const float* ga = (const float*)(F.ws + WS_GA); float* E = (float*)(F.ws + WS_H);
    const int total = 2 * MT * 256;
    for (int idx = F.bid * 512 + F.tid; idx < total; idx += F.G * 512) {
        const int c = idx & 255, m = (idx >> 8) % MT, dir = idx / (MT * 256);
        const float* w = (dir ? F.a->in[IN_WAB] : F.a->in[IN_WAF]); const float* g = ga + (size_t)m * 32 + dir * 16; float z = (dir ? F.a->in[IN_BAB] : F.a->in[IN_BAF])[c];
#pragma unroll
        for (int r = 0; r < 16; ++r) z += g[r] * w[r * 256 + c];
        E[idx] = __expf(logsig_f(z) * (1.f / 16.f));
    }
}
__device__ __forceinline__ int seq_row(int b, int p, int dir) {
    if (p < CTXL) return ML + b * CTXL + (dir ? CTXL - 1 - p : p);
    const int s = p - CTXL; return b * SEQ + (dir ? SEQ - 1 - s : s);
}
__device__ __forceinline__ void phase_gla_rec_simple(Frame& F) {
    const bf16* gq = (const bf16*)(F.ws + WS_GQ); const bf16* gk = (const bf16*)(F.ws + WS_GK); const bf16* gv = (const bf16*)(F.ws + WS_GV);
    const float* E = (const float*)(F.ws + WS_H);
    const int gw = F.wave * F.G + F.bid, NGW = F.G * NWAVES, lane = F.lane;
    for (int t = gw; t < 64; t += NGW) {
        const int dvg = t & 1, dir = (t >> 1) & 1, h = (t >> 2) & 3, b = t >> 4;
        float* O = (float*)(F.ws + (dir ? WS_NAQ : WS_X218));
        float S[64];
#pragma unroll
        for (int i = 0; i < 64; ++i) S[i] = 0.f;
        for (int p = 0; p < CTXL + SEQ; ++p) {
            const int m = __builtin_amdgcn_readfirstlane(seq_row(b, p, dir));
            const float v = bf2f(gv[(size_t)m * 512 + h * 128 + dvg * 64 + lane]);
            const float* e = E + ((size_t)dir * MT + m) * 256 + h * 64; const bf16* kp = gk + (size_t)m * 256 + h * 64; const bf16* qp = gq + (size_t)m * 256 + h * 64;
            float o = 0.f;
#pragma unroll
            for (int i = 0; i < 64; ++i) { S[i] = e[i] * S[i] + bf2f(kp[i]) * v; o += bf2f(qp[i]) * S[i]; }
            O[(size_t)m * 512 + h * 128 + dvg * 64 + lane] = o;
        }
    }
}
__device__ __forceinline__ void phase_gla_out_simple(Frame& F) {
    const float* Of = (const float*)(F.ws + WS_X218); const float* Ob = (const float*)(F.ws + WS_NAQ); const bf16* gr = (const bf16*)(F.ws + WS_GR); bf16* cat = (bf16*)(F.ws + WS_CAT);
    const float* gng = F.a->in[IN_GNG]; const int gw = F.wave * F.G + F.bid, NGW = F.G * NWAVES, lane = F.lane;
    for (int t = gw; t < MT * 4; t += NGW) { const int h = t & 3, m = t >> 2; const size_t o0 = (size_t)m * 512 + h * 128;
        const float a = Of[o0 + lane] + Ob[o0 + lane], c = Of[o0 + 64 + lane] + Ob[o0 + 64 + lane];
        const float rs = 1.0f / sqrtf(wave_sum(a * a + c * c) * (1.f / 128.f) + EPS);
        cat[(size_t)m * 1024 + 512 + h * 128 + lane] = (bf16)f2bf(a * rs * gng[lane] * silu_f(bf2f(gr[o0 + lane])));
        cat[(size_t)m * 1024 + 512 + h * 128 + 64 + lane] = (bf16)f2bf(c * rs * gng[64 + lane] * silu_f(bf2f(gr[o0 + 64 + lane]))); }
}
__device__ __forceinline__ void phase_ret_rec_simple(Frame& F, int hg) {
    const bf16* rq = (const bf16*)(F.ws + WS_RQ); const bf16* rk = (const bf16*)(F.ws + WS_RK); const bf16* rv = (const bf16*)(F.ws + WS_RV); bf16* O = (bf16*)(F.ws + WS_H);
    const int gw = F.wave * F.G + F.bid, NGW = F.G * NWAVES, lane = F.lane;
    for (int t = gw; t < 64; t += NGW) {
        const int dvg = t & 3, h4 = (t >> 2) & 3, b = t >> 4, h = hg * 4 + h4;
        for (int dir = 0; dir < 2; ++dir) {
            const float dec = (dir ? F.a->in[IN_DECB] : F.a->in[IN_DECF])[h]; const float gam = 1.0f / (1.0f + __expf(-dec));
            float S[128];
#pragma unroll
            for (int i = 0; i < 128; ++i) S[i] = 0.f;
            for (int p = 0; p < CTXL + SEQ; ++p) {
                const int m = __builtin_amdgcn_readfirstlane(seq_row(b, p, dir));
                const float v = bf2f(rv[(size_t)m * 2048 + h * 256 + dvg * 64 + lane]);
                const bf16* kp = rk + (size_t)m * 1024 + h * 128;
#pragma unroll
                for (int i = 0; i < 128; ++i) S[i] = gam * S[i] + bf2f(kp[i]) * v;
                if (m < ML) { const bf16* qp = rq + (size_t)m * 1024 + h * 128; float o = 0.f;
#pragma unroll
                    for (int i = 0; i < 128; ++i) o += bf2f(qp[i]) * S[i];
                    bf16* op = O + (size_t)m * 1024 + h4 * 256 + dvg * 64 + lane;
                    if (dir) o += bf2f(*op);
                    *op = (bf16)f2bf(o); }
            }
            asm volatile("s_waitcnt vmcnt(0)" ::: "memory");
        }
    }
}
__device__ __forceinline__ void phase_ret_out_simple(Frame& F, int hg) {
    const bf16* O = (const bf16*)(F.ws + WS_H); bf16* rg = (bf16*)(F.ws + WS_RG); const float* rng = F.a->in[IN_RNG];
    const int gw = F.wave * F.G + F.bid, NGW = F.G * NWAVES, lane = F.lane;
    for (int t = gw; t < ML * 4; t += NGW) { const int h4 = t & 3, m = t >> 2, h = hg * 4 + h4;
        float o[4]; float s = 0.f;
#pragma unroll
        for (int j = 0; j < 4; ++j) { o[j] = bf2f(O[(size_t)m * 1024 + h4 * 256 + 64 * j + lane]); s += o[j]; }
        const float mu = wave_sum(s) * (1.f / 256.f); float q = 0.f;
#pragma unroll
        for (int j = 0; j < 4; ++j) { o[j] -= mu; q += o[j] * o[j]; }
        const float rs = 1.0f / sqrtf(wave_sum(q) * (1.f / 256.f) + EPS);
#pragma unroll
        for (int j = 0; j < 4; ++j) { bf16* gp = rg + (size_t)m * 2048 + h * 256 + 64 * j + lane; *gp = (bf16)f2bf(o[j] * rs * rng[h * 256 + 64 * j + lane] * silu_f(bf2f(*gp))); } }
}

typedef short s16x4 __attribute__((ext_vector_type(4)));
typedef float f32x16 __attribute__((ext_vector_type(16)));
constexpr size_t WS_CK = 20 * MiB;
__device__ __forceinline__ bf16x8 tr_read8(LAS const unsigned char* p0, LAS const unsigned char* p1) {
    const s16x4 a = __builtin_amdgcn_ds_read_tr16_b64_v4i16((LAS s16x4*)p0), b = __builtin_amdgcn_ds_read_tr16_b64_v4i16((LAS s16x4*)p1);
    return __builtin_shufflevector(a, b, 0, 1, 2, 3, 4, 5, 6, 7);
}
__device__ __forceinline__ v4u scale8(v4u w, float s) {
    v4u o;
#pragma unroll
    for (int e = 0; e < 4; ++e) o[e] = pg8::cvt_pk_bf16(__builtin_bit_cast(float, w[e] << 16) * s, __builtin_bit_cast(float, w[e] & 0xffff0000u) * s);
    return o;
}
__device__ __forceinline__ int chunk_row(int b, int n, int dir) {
    if (n < 4) return ML + b * CTXL + 64 * (dir ? 3 - n : n);
    const int c = n - 4; return b * SEQ + 64 * (dir ? 63 - c : c);
}
__device__ __forceinline__ float log2_sigmoid(float d) { return -log2f(1.0f + __expf(-d)); }
__device__ __forceinline__ void phase_ret_scan(Frame& F) {
    const bf16* rk = (const bf16*)(F.ws + WS_RK); const bf16* rv = (const bf16*)(F.ws + WS_RV); bf16* ck = (bf16*)(F.ws + WS_CK);
    const int tid = F.tid, lane = F.lane, w = F.wave, srow = tid >> 3, sc8 = tid & 7;
    const int dvt = w >> 2, dkt = w & 3, r = lane & 31, hh = lane >> 5, gsub = (lane >> 4) & 1, i16 = lane & 15;
    constexpr int KS = 320, VS = 192, BUF = 64 * KS + 64 * VS;
    const int aoffV = (8 * hh + (i16 >> 2)) * VS + (32 * dvt + 16 * gsub + 4 * (i16 & 3)) * 2;
    const int aoffK = (8 * hh + (i16 >> 2)) * KS + (32 * dkt + 16 * gsub + 4 * (i16 & 3)) * 2;
    for (int unit = F.bid; unit < 256; unit += F.G) {
        const int dvs = unit & 3, dir = (unit >> 2) & 1, h = (unit >> 3) & 7, b = unit >> 6;
        const float lg2 = log2_sigmoid((dir ? F.a->in[IN_DECB] : F.a->in[IN_DECF])[h]);
        const float g64 = exp2f(64.f * lg2), wrow = exp2f(lg2 * (float)(dir ? srow : 63 - srow));
        f32x16 acc;
#pragma unroll
        for (int i = 0; i < 16; ++i) acc[i] = 0.f;
        v4u kr0, kr1, vr;
        { const int mb = chunk_row(b, 0, dir); const v4u* kp = (const v4u*)(rk + (size_t)(mb + srow) * 1024 + h * 128 + sc8 * 16); kr0 = kp[0]; kr1 = kp[1];
          vr = *(const v4u*)(rv + (size_t)(mb + srow) * 2048 + h * 256 + dvs * 64 + sc8 * 8); }
        for (int n = 0; n < 68; ++n) {
            LAS unsigned char* KL = F.lds + (n & 1) * BUF; LAS unsigned char* VL = KL + 64 * KS;
            *(LAS v4u*)(KL + srow * KS + sc8 * 32) = kr0; *(LAS v4u*)(KL + srow * KS + sc8 * 32 + 16) = kr1;
            *(LAS v4u*)(VL + srow * VS + sc8 * 16) = scale8(vr, wrow);
            if (n + 1 < 68) { const int mb = chunk_row(b, n + 1, dir); const v4u* kp = (const v4u*)(rk + (size_t)(mb + srow) * 1024 + h * 128 + sc8 * 16); kr0 = kp[0]; kr1 = kp[1];
                vr = *(const v4u*)(rv + (size_t)(mb + srow) * 2048 + h * 256 + dvs * 64 + sc8 * 8); }
            LDS_WAIT(); __builtin_amdgcn_s_barrier(); asm volatile("" ::: "memory");
            if (n >= 4 && ((n - 4) & 7) == 0) {
                const int i = (n - 4) >> 3, sc = dir ? 7 - i : i;
                bf16* cp = ck + ((size_t)(((b * 8 + h) * 2 + dir) * 8 + sc) * 256 + dvs * 64 + 32 * dvt + 4 * hh) * 128 + 32 * dkt + r;
#pragma unroll
                for (int e = 0; e < 16; ++e) cp[(size_t)((e & 3) + 8 * (e >> 2)) * 128] = (bf16)f2bf(acc[e]);
            }
#pragma unroll
            for (int e = 0; e < 16; ++e) acc[e] *= g64;
#pragma unroll
            for (int ks = 0; ks < 4; ++ks) {
                const bf16x8 A = tr_read8(VL + aoffV + 16 * ks * VS, VL + aoffV + (16 * ks + 4) * VS);
                const bf16x8 B = tr_read8(KL + aoffK + 16 * ks * KS, KL + aoffK + (16 * ks + 4) * KS);
                acc = __builtin_amdgcn_mfma_f32_32x32x16_bf16(A, B, acc, 0, 0, 0);
            }
        }
        __syncthreads();
    }
}
template <bool STORE = true> __device__ __forceinline__ void phase_ret_out(Frame& F) {
    const bf16* rq = (const bf16*)(F.ws + WS_RQ); const bf16* rk = (const bf16*)(F.ws + WS_RK); const bf16* rv = (const bf16*)(F.ws + WS_RV); const bf16* ck = (const bf16*)(F.ws + WS_CK);
    bf16* rg = (bf16*)(F.ws + WS_RG); const float* rng = F.a->in[IN_RNG];
    const int tid = F.tid, lane = F.lane, w = F.wave, srow = tid >> 3, sc8 = tid & 7, q16 = lane & 15, g = lane >> 4;
    constexpr int KS = 288, VS = 544, KB = 64 * KS, VB = 64 * VS, VOFF = 2 * KB, OS = 528;
    for (int unit = F.bid; unit < 1024; unit += F.G) {
        const int qb = unit & 31, h = (unit >> 5) & 7, b = unit >> 8, sc = qb >> 2, iq = qb & 3;
        const int tok0 = b * SEQ + 512 * sc;
        const int qrow = tok0 + 128 * iq + 16 * w + q16;
        const int qpos = 128 * iq + 16 * w + q16;
        bf16x8 Qraw[4];
#pragma unroll
        for (int ks = 0; ks < 4; ++ks) Qraw[ks] = *(const bf16x8*)(rq + (size_t)qrow * 1024 + h * 128 + 32 * ks + 8 * g);
        f32x4 o[16];
#pragma unroll
        for (int dt = 0; dt < 16; ++dt) o[dt] = (f32x4){0.f, 0.f, 0.f, 0.f};
#pragma unroll 1
        for (int dir = 0; dir < 2; ++dir) {
            const float lg2 = log2_sigmoid((dir ? F.a->in[IN_DECB] : F.a->in[IN_DECF])[h]);
            const float sq = exp2f(lg2 * (float)(dir ? 127 - (16 * w + q16) : 16 * w + q16));
            const float wk = exp2f(lg2 * (float)(dir ? srow : -srow));
            bf16x8 Qs[4];
#pragma unroll
            for (int ks = 0; ks < 4; ++ks) Qs[ks] = __builtin_bit_cast(bf16x8, scale8(__builtin_bit_cast(v4u, Qraw[ks]), sq));
            const int kb0 = dir ? 2 * iq : 0, nsteps = dir ? 8 - 2 * iq : 2 * iq + 2;
            v4u kr0, kr1, vr[4];
#define RO_LOAD(kb_) do { const int mrow = tok0 + 64 * (kb_) + srow; const v4u* kp = (const v4u*)(rk + (size_t)mrow * 1024 + h * 128 + sc8 * 16); kr0 = kp[0]; kr1 = kp[1]; \
                const v4u* vp = (const v4u*)(rv + (size_t)mrow * 2048 + h * 256 + sc8 * 32); vr[0] = vp[0]; vr[1] = vp[1]; vr[2] = vp[2]; vr[3] = vp[3]; } while (0)
#define RO_WRITE(buf_) do { LAS unsigned char* kl = F.lds + (buf_) * KB + srow * KS + sc8 * 32; *(LAS v4u*)kl = scale8(kr0, wk); *(LAS v4u*)(kl + 16) = scale8(kr1, wk); \
                LAS unsigned char* vl = F.lds + VOFF + (buf_) * VB + srow * VS + sc8 * 64; *(LAS v4u*)vl = vr[0]; *(LAS v4u*)(vl + 16) = vr[1]; *(LAS v4u*)(vl + 32) = vr[2]; *(LAS v4u*)(vl + 48) = vr[3]; } while (0)
            RO_LOAD(kb0); RO_WRITE(0);
            if (nsteps > 1) RO_LOAD(kb0 + 1);
            LDS_WAIT(); __builtin_amdgcn_s_barrier(); asm volatile("" ::: "memory");
            for (int i = 0; i < nsteps; ++i) {
                const int kb = kb0 + i, k0 = 64 * kb, buf = i & 1;
                const int wq0 = 128 * iq + 16 * w;
                const bool active = dir ? (k0 + 63 >= wq0) : (k0 <= wq0 + 15);
                if (active) {
                    LAS const unsigned char* KL = F.lds + buf * KB; LAS const unsigned char* VL = F.lds + VOFF + buf * VB;
                    const float fac = exp2f(lg2 * (float)(dir ? k0 - (128 * iq + 127) : 128 * iq - k0));
                    f32x4 p[4];
#pragma unroll
                    for (int kt = 0; kt < 4; ++kt) { p[kt] = (f32x4){0.f, 0.f, 0.f, 0.f};
#pragma unroll
                        for (int ks = 0; ks < 4; ++ks) { const bf16x8 A = *(LAS const bf16x8*)(KL + (16 * kt + q16) * KS + (32 * ks + 8 * g) * 2);
                            p[kt] = __builtin_amdgcn_mfma_f32_16x16x32_bf16(A, Qs[ks], p[kt], 0, 0, 0); } }
                    bf16x8 Pb[2];
#pragma unroll
                    for (int kk = 0; kk < 2; ++kk) { v4u pw;
#pragma unroll
                        for (int t2 = 0; t2 < 2; ++t2) { const int kt = 2 * kk + t2; float v[4];
#pragma unroll
                            for (int e = 0; e < 4; ++e) { const int kj = k0 + 16 * kt + 4 * g + e; const bool keep = dir ? (kj >= qpos) : (kj <= qpos); v[e] = keep ? p[kt][e] * fac : 0.f; }
                            pw[2 * t2] = pg8::cvt_pk_bf16(v[0], v[1]); pw[2 * t2 + 1] = pg8::cvt_pk_bf16(v[2], v[3]); }
                        Pb[kk] = __builtin_bit_cast(bf16x8, pw); }
#pragma unroll
                    for (int dt = 0; dt < 16; ++dt)
#pragma unroll
                        for (int kk = 0; kk < 2; ++kk) { LAS const unsigned char* vp = VL + (32 * kk + 4 * g + (q16 >> 2)) * VS + (16 * dt + 4 * (q16 & 3)) * 2;
                            o[dt] = __builtin_amdgcn_mfma_f32_16x16x32_bf16(tr_read8(vp, vp + 16 * VS), Pb[kk], o[dt], 0, 0, 0); }
                }
                if (i + 1 < nsteps) { RO_WRITE(buf ^ 1); if (i + 2 < nsteps) RO_LOAD(kb + 2); }
                LDS_WAIT(); __builtin_amdgcn_s_barrier(); asm volatile("" ::: "memory");
            }
            { const bf16* cp = ck + ((size_t)(((b * 8 + h) * 2 + dir) * 8 + sc) * 256 + (tid >> 1)) * 128 + (tid & 1) * 64; LAS unsigned char* cl = F.lds + (tid >> 1) * KS + (tid & 1) * 128;
              v4u t8[8];
#pragma unroll
              for (int j = 0; j < 8; ++j) t8[j] = ((const v4u*)cp)[j];
#pragma unroll
              for (int j = 0; j < 8; ++j) *(LAS v4u*)(cl + 16 * j) = t8[j]; }
            const float fi = exp2f(lg2 * (float)(dir ? 512 - (128 * iq + 127) : 128 * iq + 1));
            bf16x8 Qi[4];
#pragma unroll
            for (int ks = 0; ks < 4; ++ks) Qi[ks] = __builtin_bit_cast(bf16x8, scale8(__builtin_bit_cast(v4u, Qraw[ks]), sq * fi));
            LDS_WAIT(); __builtin_amdgcn_s_barrier(); asm volatile("" ::: "memory");
#pragma unroll
            for (int dt = 0; dt < 16; ++dt)
#pragma unroll
                for (int ks = 0; ks < 4; ++ks) { const bf16x8 A = *(LAS const bf16x8*)(F.lds + (16 * dt + q16) * KS + (32 * ks + 8 * g) * 2);
                    o[dt] = __builtin_amdgcn_mfma_f32_16x16x32_bf16(A, Qi[ks], o[dt], 0, 0, 0); }
            LDS_WAIT(); __builtin_amdgcn_s_barrier(); asm volatile("" ::: "memory");
        }
#undef RO_LOAD
#undef RO_WRITE
        float s = 0.f;
#pragma unroll
        for (int dt = 0; dt < 16; ++dt) s += (o[dt][0] + o[dt][1]) + (o[dt][2] + o[dt][3]);
        s += __shfl_xor(s, 16); s += __shfl_xor(s, 32);
        const float mu = s * (1.f / 256.f); float qv = 0.f;
#pragma unroll
        for (int dt = 0; dt < 16; ++dt) { o[dt] = o[dt] - mu; qv += (o[dt][0] * o[dt][0] + o[dt][1] * o[dt][1]) + (o[dt][2] * o[dt][2] + o[dt][3] * o[dt][3]); }
        qv += __shfl_xor(qv, 16); qv += __shfl_xor(qv, 32);
        const float rs = 1.0f / sqrtf(qv * (1.f / 256.f) + EPS);
        LAS unsigned char* ol = F.lds + w * (16 * OS);
#pragma unroll
        for (int dt = 0; dt < 16; ++dt) { const f32x4 gg = *(const f32x4*)(rng + h * 256 + 16 * dt + 4 * g); const f32x4 y = o[dt] * rs * gg;
            *(LAS unsigned long long*)(ol + q16 * OS + (16 * dt + 4 * g) * 2) = (unsigned long long)pg8::cvt_pk_bf16(y[0], y[1]) | ((unsigned long long)pg8::cvt_pk_bf16(y[2], y[3]) << 32); }
        LDS_WAIT(); asm volatile("" ::: "memory");
        { const int rr = lane >> 2, c4 = lane & 3; bf16* gp = rg + (size_t)(tok0 + 128 * iq + 16 * w + rr) * 2048 + h * 256;
#pragma unroll
          for (int j = 0; j < 8; ++j) { const int ch = 4 * j + c4; const v4u yv = *(LAS const v4u*)(ol + rr * OS + ch * 16); const v4u gv = *(const v4u*)(gp + ch * 8); v4u ov;
#pragma unroll
              for (int e = 0; e < 4; ++e) { const float y0 = __builtin_bit_cast(float, yv[e] << 16), y1 = __builtin_bit_cast(float, yv[e] & 0xffff0000u), g0 = __builtin_bit_cast(float, gv[e] << 16), g1 = __builtin_bit_cast(float, gv[e] & 0xffff0000u);
                  ov[e] = pg8::cvt_pk_bf16(y0 * silu_f(g0), y1 * silu_f(g1)); }
              if (STORE) *(v4u*)(gp + ch * 8) = ov; else asm volatile("" :: "v"(ov)); } }
        __syncthreads();
    }
}

template <bool STORE = true, int SKIP = 0> __device__ __forceinline__ void phase_ret_out2(Frame& F) {
    const bf16* rq = (const bf16*)(F.ws + WS_RQ); const bf16* rk = (const bf16*)(F.ws + WS_RK); const bf16* rv = (const bf16*)(F.ws + WS_RV); const bf16* ck = (const bf16*)(F.ws + WS_CK);
    bf16* rg = (bf16*)(F.ws + WS_RG); const float* rng = F.a->in[IN_RNG];
    const int tid = F.tid, lane = F.lane, w = F.wave, srow = tid >> 3, sc8 = tid & 7, r = lane & 31, hh = lane >> 5, gsub = (lane >> 4) & 1, i16 = lane & 15, qg = w & 3, dvh = w >> 2;
    constexpr int KS = 272, VS = 576, KB = 64 * KS, VB = 64 * VS, VOFF = 2 * KB, OS = 272, REDOFF = 110592;
    const int voff = (4 * hh + (i16 >> 2)) * VS + (128 * dvh + 16 * gsub + 4 * (i16 & 3)) * 2;
    for (int unit = xcd_vcu(F.bid, F.G); unit < 1024; unit += F.G) {
        const int qb = unit & 31, h = (unit >> 5) & 7, b = unit >> 8, sc = qb >> 2, iq = qb & 3;
        const int tok0 = b * SEQ + 512 * sc;
        const int wq0 = 128 * iq + 32 * qg, qpos = wq0 + r;
        const bf16* qp = rq + (size_t)(tok0 + qpos) * 1024 + h * 128 + 8 * hh;
        f32x16 o[4];
#pragma unroll
        for (int dt = 0; dt < 4; ++dt)
#pragma unroll
            for (int e = 0; e < 16; ++e) o[dt][e] = 0.f;
#pragma unroll 1
        for (int dir = 0; dir < 2; ++dir) {
            const float lg2 = log2_sigmoid((dir ? F.a->in[IN_DECB] : F.a->in[IN_DECF])[h]);
            const float sq = exp2f(lg2 * (float)(dir ? 127 - (32 * qg + r) : 32 * qg + r));
            const float wk = exp2f(lg2 * (float)(dir ? srow : -srow));
            bf16x8 Qs[8];
#pragma unroll
            for (int ks = 0; ks < 8; ++ks) Qs[ks] = __builtin_bit_cast(bf16x8, scale8(*(const v4u*)(qp + 16 * ks), sq));
            const int kb0 = dir ? 2 * iq : 0, nsteps = dir ? 8 - 2 * iq : 2 * iq + 2;
            v4u kr0, kr1, vr[4];
#define RO_LOAD(kb_) do { const int mrow = tok0 + 64 * (kb_) + srow; const v4u* kp = (const v4u*)(rk + (size_t)mrow * 1024 + h * 128 + sc8 * 16); kr0 = kp[0]; kr1 = kp[1]; \
                const v4u* vp = (const v4u*)(rv + (size_t)mrow * 2048 + h * 256 + sc8 * 32); vr[0] = vp[0]; vr[1] = vp[1]; vr[2] = vp[2]; vr[3] = vp[3]; } while (0)
#define RO_WRITE(buf_, kb_) do { const float wkf = wk * exp2f(lg2 * (float)(dir ? 64 * (kb_) - (128 * iq + 127) : 128 * iq - 64 * (kb_))); LAS unsigned char* kl = F.lds + (buf_) * KB + srow * KS + sc8 * 32; *(LAS v4u*)kl = scale8(kr0, wkf); *(LAS v4u*)(kl + 16) = scale8(kr1, wkf); \
                LAS unsigned char* vl = F.lds + VOFF + (buf_) * VB + srow * VS + sc8 * 64; *(LAS v4u*)vl = vr[0]; *(LAS v4u*)(vl + 16) = vr[1]; *(LAS v4u*)(vl + 32) = vr[2]; *(LAS v4u*)(vl + 48) = vr[3]; } while (0)
            RO_LOAD(kb0); RO_WRITE(0, kb0);
            if (nsteps > 1) RO_LOAD(kb0 + 1);
            LDS_WAIT(); __builtin_amdgcn_s_barrier(); asm volatile("" ::: "memory");
            for (int i = 0; i < nsteps; ++i) {
                const int kb = kb0 + i, k0 = 64 * kb, buf = i & 1;
                const bool active = dir ? (k0 + 63 >= wq0) : (k0 <= wq0 + 31);
                if (active && !(SKIP & 1)) {
                    LAS const unsigned char* KL = F.lds + buf * KB; LAS const unsigned char* VL = F.lds + VOFF + buf * VB;
#pragma unroll
                    for (int kt = 0; kt < 2; ++kt) {
                        const bool tact = dir ? (k0 + 32 * kt + 31 >= wq0) : (k0 + 32 * kt <= wq0 + 31);
                        if (tact) {
                            f32x16 p;
#pragma unroll
                            for (int e = 0; e < 16; ++e) p[e] = 0.f;
#pragma unroll
                            for (int ks = 0; ks < 8; ++ks) { const bf16x8 A = *(LAS const bf16x8*)(KL + (32 * kt + r) * KS + (16 * ks + 8 * hh) * 2);
                                p = __builtin_amdgcn_mfma_f32_32x32x16_bf16(A, Qs[ks], p, 0, 0, 0); }
                            const bool full = dir ? (k0 + 32 * kt >= wq0 + 31) : (k0 + 32 * kt + 31 <= wq0);
                            if (!full) { const int dd = qpos - k0 - 32 * kt - 4 * hh;
#pragma unroll
                                for (int e = 0; e < 16; ++e) { const int c = (e & 3) + 8 * (e >> 2); const bool keep = dir ? (c >= dd) : (c <= dd); p[e] = keep ? p[e] : 0.f; } }
#pragma unroll
                            for (int s2 = 0; s2 < 2; ++s2) { v4u pw;
#pragma unroll
                                for (int j = 0; j < 4; ++j) pw[j] = pg8::cvt_pk_bf16(p[8 * s2 + 2 * j], p[8 * s2 + 2 * j + 1]);
                                const bf16x8 Pb = __builtin_bit_cast(bf16x8, pw);
#pragma unroll
                                for (int dt = 0; dt < 4; ++dt) { LAS const unsigned char* vp = VL + voff + (32 * kt + 16 * s2) * VS + 64 * dt;
                                    o[dt] = __builtin_amdgcn_mfma_f32_32x32x16_bf16(tr_read8(vp, vp + 8 * VS), Pb, o[dt], 0, 0, 0); }
                            }
                        }
                    }
                }
                if (i + 1 < nsteps) { RO_WRITE(buf ^ 1, kb + 1); if (i + 2 < nsteps) RO_LOAD(kb + 2); }
                LDS_WAIT(); __builtin_amdgcn_s_barrier(); asm volatile("" ::: "memory");
            }
            { const bf16* cp = ck + ((size_t)(((b * 8 + h) * 2 + dir) * 8 + sc) * 256 + (tid >> 1)) * 128 + (tid & 1) * 64; LAS unsigned char* cl = F.lds + (tid >> 1) * KS + (tid & 1) * 128;
              v4u t8[8];
#pragma unroll
              for (int j = 0; j < 8; ++j) t8[j] = ((const v4u*)cp)[j];
#pragma unroll
              for (int j = 0; j < 8; ++j) *(LAS v4u*)(cl + 16 * j) = t8[j]; }
            const float fi = exp2f(lg2 * (float)(dir ? 512 - (128 * iq + 127) : 128 * iq + 1));
#pragma unroll
            for (int ks = 0; ks < 8; ++ks) Qs[ks] = __builtin_bit_cast(bf16x8, scale8(*(const v4u*)(qp + 16 * ks), sq * fi));
            LDS_WAIT(); __builtin_amdgcn_s_barrier(); asm volatile("" ::: "memory");
            if (!(SKIP & 2))
#pragma unroll
            for (int dt = 0; dt < 4; ++dt)
#pragma unroll
                for (int ks = 0; ks < 8; ++ks) { const bf16x8 A = *(LAS const bf16x8*)(F.lds + (128 * dvh + 32 * dt + r) * KS + (16 * ks + 8 * hh) * 2);
                    o[dt] = __builtin_amdgcn_mfma_f32_32x32x16_bf16(A, Qs[ks], o[dt], 0, 0, 0); }
            LDS_WAIT(); __builtin_amdgcn_s_barrier(); asm volatile("" ::: "memory");
        }
#undef RO_LOAD
#undef RO_WRITE
        float s1 = 0.f, s2v = 0.f;
#pragma unroll
        for (int dt = 0; dt < 4; ++dt)
#pragma unroll
            for (int e = 0; e < 16; ++e) { s1 += o[dt][e]; s2v += o[dt][e] * o[dt][e]; }
        s1 += __shfl_xor(s1, 32); s2v += __shfl_xor(s2v, 32);
        LAS f32x2v* red = (LAS f32x2v*)(F.lds + REDOFF);
        if (hh == 0) red[dvh * 128 + 32 * qg + r] = (f32x2v){s1, s2v};
        LDS_WAIT(); __builtin_amdgcn_s_barrier(); asm volatile("" ::: "memory");
        { const f32x2v ot2 = red[(dvh ^ 1) * 128 + 32 * qg + r]; s1 += ot2.x; s2v += ot2.y; }
        const float mu = s1 * (1.f / 256.f), rs = 1.0f / sqrtf(fmaxf(s2v * (1.f / 256.f) - mu * mu, 0.f) + EPS);
        LAS unsigned char* ol = F.lds + w * (32 * OS);
#pragma unroll
        for (int dt = 0; dt < 4; ++dt)
#pragma unroll
            for (int q4 = 0; q4 < 4; ++q4) { const int dv = 32 * dt + 8 * q4 + 4 * hh; const f32x4 gg = *(const f32x4*)(rng + h * 256 + 128 * dvh + dv);
                const float y0 = (o[dt][4 * q4] - mu) * rs * gg[0], y1 = (o[dt][4 * q4 + 1] - mu) * rs * gg[1], y2 = (o[dt][4 * q4 + 2] - mu) * rs * gg[2], y3 = (o[dt][4 * q4 + 3] - mu) * rs * gg[3];
                *(LAS unsigned long long*)(ol + r * OS + dv * 2) = (unsigned long long)pg8::cvt_pk_bf16(y0, y1) | ((unsigned long long)pg8::cvt_pk_bf16(y2, y3) << 32); }
        LDS_WAIT(); asm volatile("" ::: "memory");
        { const int rr = lane >> 1, c2 = lane & 1; bf16* gp = rg + (size_t)(tok0 + wq0 + rr) * 2048 + h * 256 + 128 * dvh;
#pragma unroll
          for (int j = 0; j < 8; ++j) { const int ch = 2 * j + c2; const v4u yv = *(LAS const v4u*)(ol + rr * OS + ch * 16); const v4u gv = *(const v4u*)(gp + ch * 8); v4u ov;
#pragma unroll
              for (int e = 0; e < 4; ++e) { const float y0 = __builtin_bit_cast(float, yv[e] << 16), y1 = __builtin_bit_cast(float, yv[e] & 0xffff0000u), g0 = __builtin_bit_cast(float, gv[e] << 16), g1 = __builtin_bit_cast(float, gv[e] & 0xffff0000u);
                  ov[e] = pg8::cvt_pk_bf16(y0 * silu_f(g0), y1 * silu_f(g1)); }
              if (STORE) *(v4u*)(gp + ch * 8) = ov; else asm volatile("" :: "v"(ov)); } }
        __syncthreads();
    }
}

constexpr size_t WS_QINB = 218 * MiB, WS_KINB = WS_QINB + 8704 * 1024, WS_GDEC = 236 * MiB;
constexpr size_t WS_SST = 20 * MiB;
__device__ __forceinline__ int gla_chunk_row(int b, int cm) { return cm < 4 ? ML + b * CTXL + 64 * cm : b * SEQ + 64 * (cm - 4); }
template <bool STORE = true> __device__ __forceinline__ void phase_gla_prep(Frame& F) {
    bf16* gq = (bf16*)(F.ws + WS_GQ); bf16* gk = (bf16*)(F.ws + WS_GK); bf16* qb = (bf16*)(F.ws + WS_QINB); bf16* kb = (bf16*)(F.ws + WS_KINB);
    const float* ga = (const float*)(F.ws + WS_GA); float* gdec = (float*)(F.ws + WS_GDEC);
    LAS float* gal = (LAS float*)F.lds;
    LAS float* tot = (LAS float*)(F.lds + 8192);
    const int tid = F.tid, c = tid & 63, jg = tid >> 6;
    for (int unit = F.bid; unit < 16 * 68; unit += F.G) {
        const int cm = unit % 68, bh = unit / 68, h = bh & 3, b = bh >> 2, mb = gla_chunk_row(b, cm);
        *(LAS v4u*)(F.lds + tid * 16) = *(const v4u*)(ga + (size_t)mb * 32 + tid * 4);
        float wf[16], wb[16];
#pragma unroll
        for (int r = 0; r < 16; ++r) { wf[r] = F.a->in[IN_WAF][r * 256 + h * 64 + c]; wb[r] = F.a->in[IN_WAB][r * 256 + h * 64 + c]; }
        const float bf_ = F.a->in[IN_BAF][h * 64 + c], bb_ = F.a->in[IN_BAB][h * 64 + c];
        float q[8], k[8];
#pragma unroll
        for (int i = 0; i < 8; ++i) { const size_t o = (size_t)(mb + 8 * jg + i) * 256 + h * 64 + c; q[i] = bf2f(gq[o]); k[i] = bf2f(gk[o]); }
        __syncthreads();
        float lf[8], lb[8];
#pragma unroll
        for (int i = 0; i < 8; ++i) { const LAS float* gr_ = gal + (8 * jg + i) * 32; float zf = bf_, zb = bb_;
#pragma unroll
            for (int r = 0; r < 16; ++r) { zf += gr_[r] * wf[r]; zb += gr_[16 + r] * wb[r]; }
            lf[i] = logsig_fast(zf) * (1.f / 16.f); lb[i] = logsig_fast(zb) * (1.f / 16.f); }
#pragma unroll
        for (int i = 1; i < 8; ++i) lf[i] += lf[i - 1];
#pragma unroll
        for (int i = 6; i >= 0; --i) lb[i] += lb[i + 1];
        tot[jg * 64 + c] = lf[7]; tot[512 + jg * 64 + c] = lb[0];
        __syncthreads();
        float offf = 0.f, offb = 0.f, totf = 0.f, totb = 0.f;
#pragma unroll
        for (int g2 = 0; g2 < 8; ++g2) { const float tf = tot[g2 * 64 + c], tb = tot[512 + g2 * 64 + c]; totf += tf; totb += tb; if (g2 < jg) offf += tf; if (g2 > jg) offb += tb; }
#pragma unroll
        for (int i = 0; i < 8; ++i) { const size_t o = (size_t)(mb + 8 * jg + i) * 256 + h * 64 + c; const float bfv = lf[i] + offf, bbv = lb[i] + offb;
            const unsigned a0 = f2bf(q[i] * __expf(bfv)), a1 = f2bf(k[i] * __expf(-bfv)), a2 = f2bf(q[i] * __expf(bbv)), a3 = f2bf(k[i] * __expf(-bbv));
            if (STORE) { gq[o] = (bf16)a0; gk[o] = (bf16)a1; qb[o] = (bf16)a2; kb[o] = (bf16)a3; } else asm volatile("" :: "v"(a0), "v"(a1), "v"(a2), "v"(a3)); }
        if (jg == 0) { gdec[((size_t)(0 * 16 + bh) * 68 + cm) * 64 + c] = __expf(totf); gdec[((size_t)(1 * 16 + bh) * 68 + cm) * 64 + c] = __expf(totb); }
        __syncthreads();
    }
}
__device__ __forceinline__ void phase_gla_scan(Frame& F) {
    const bf16* gv = (const bf16*)(F.ws + WS_GV); bf16* sst = (bf16*)(F.ws + WS_SST); const float* gdec = (const float*)(F.ws + WS_GDEC);
    const int tid = F.tid, lane = F.lane, w = F.wave, srow = tid >> 3, sc8 = tid & 7;
    const int dvt = w >> 1, dkt = w & 1, r = lane & 31, hh = lane >> 5, gsub = (lane >> 4) & 1, i16 = lane & 15;
    constexpr int KS = 192, VS = 320, BUF = 64 * KS + 64 * VS;
    const int aoffV = (8 * hh + (i16 >> 2)) * VS + (32 * dvt + 16 * gsub + 4 * (i16 & 3)) * 2;
    const int aoffK = (8 * hh + (i16 >> 2)) * KS + (32 * dkt + 16 * gsub + 4 * (i16 & 3)) * 2;
    for (int unit = F.bid; unit < 32; unit += F.G) {
        const int dir = unit & 1, bh = unit >> 1, h = bh & 3, b = bh >> 2;
        const bf16* kin = (const bf16*)(F.ws + (dir ? WS_KINB : WS_GK));
        f32x16 acc;
#pragma unroll
        for (int i = 0; i < 16; ++i) acc[i] = 0.f;
        v4u kr, vr0, vr1; f32x4 dc[4];
#define GS_CM(n_) ((n_) < 4 ? (dir ? 3 - (n_) : (n_)) : 4 + (dir ? 63 - ((n_) - 4) : (n_) - 4))
#define GS_LOAD(n_) do { const int cm_ = GS_CM(n_), mb_ = gla_chunk_row(b, cm_); kr = *(const v4u*)(kin + (size_t)(mb_ + srow) * 256 + h * 64 + sc8 * 8); \
            const v4u* vp_ = (const v4u*)(gv + (size_t)(mb_ + srow) * 512 + h * 128 + sc8 * 16); vr0 = vp_[0]; vr1 = vp_[1]; \
            const float* dp_ = gdec + ((size_t)(dir * 16 + bh) * 68 + cm_) * 64 + 32 * dkt + 4 * hh; dc[0] = *(const f32x4*)dp_; dc[1] = *(const f32x4*)(dp_ + 8); dc[2] = *(const f32x4*)(dp_ + 16); dc[3] = *(const f32x4*)(dp_ + 24); } while (0)
        GS_LOAD(0);
        for (int n = 0; n < 68; ++n) {
            LAS unsigned char* KL = F.lds + (n & 1) * BUF; LAS unsigned char* VL = KL + 64 * KS;
            *(LAS v4u*)(KL + srow * KS + sc8 * 16) = kr; *(LAS v4u*)(VL + srow * VS + sc8 * 32) = vr0; *(LAS v4u*)(VL + srow * VS + sc8 * 32 + 16) = vr1;
            f32x4 dcur[4];
#pragma unroll
            for (int q = 0; q < 4; ++q) dcur[q] = dc[q];
            const int cm = GS_CM(n);
            if (n + 1 < 68) GS_LOAD(n + 1);
            LDS_WAIT(); __builtin_amdgcn_s_barrier(); asm volatile("" ::: "memory");
            { v4u* cp = (v4u*)(sst + ((size_t)((bh * 2 + dir) * 68 + cm) * 8192 + (size_t)(w * 64 + lane) * 16)); v4u s0, s1;
#pragma unroll
              for (int j = 0; j < 4; ++j) { s0[j] = pg8::cvt_pk_bf16(acc[2 * j], acc[2 * j + 1]); s1[j] = pg8::cvt_pk_bf16(acc[8 + 2 * j], acc[8 + 2 * j + 1]); }
              cp[0] = s0; cp[1] = s1; }
#pragma unroll
            for (int ks = 0; ks < 4; ++ks) {
                const bf16x8 A = tr_read8(KL + aoffK + 16 * ks * KS, KL + aoffK + (16 * ks + 4) * KS);
                const bf16x8 B = tr_read8(VL + aoffV + 16 * ks * VS, VL + aoffV + (16 * ks + 4) * VS);
                acc = __builtin_amdgcn_mfma_f32_32x32x16_bf16(A, B, acc, 0, 0, 0);
            }
#pragma unroll
            for (int e = 0; e < 16; ++e) acc[e] *= dcur[e >> 2][e & 3];
        }
#undef GS_LOAD
#undef GS_CM
        __syncthreads();
    }
}
__device__ __forceinline__ void phase_gla_out(Frame& F) {
    const bf16* gv = (const bf16*)(F.ws + WS_GV); const bf16* gr = (const bf16*)(F.ws + WS_GR); const bf16* sst = (const bf16*)(F.ws + WS_SST); bf16* cat = (bf16*)(F.ws + WS_CAT);
    const float* gng = F.a->in[IN_GNG];
    const int tid = F.tid, lane = F.lane, w = F.wave, q16 = lane & 15, g = lane >> 4, wc = w >> 2;
    constexpr int KS = 160, VS = 288, SS = 160, OS = 272;
    constexpr int KOFF = 0, VOFF = 4 * 64 * KS  , SOFF = VOFF + 2 * 64 * VS  ;
    for (int unit = F.bid; unit < 16 * 34; unit += F.G) {
        const int c2 = unit % 34, bh = unit / 34, h = bh & 3, b = bh >> 2;
        const int cm0 = 2 * c2, mb = gla_chunk_row(b, cm0);
        { const int row = tid >> 2, c4 = tid & 3;
#pragma unroll
          for (int d = 0; d < 2; ++d) { const bf16* kin = (const bf16*)(F.ws + (d ? WS_KINB : WS_GK)) + (size_t)(mb + row) * 256 + h * 64 + c4 * 16; const v4u a0 = ((const v4u*)kin)[0], a1 = ((const v4u*)kin)[1];
              LAS unsigned char* kl = F.lds + KOFF + (d * 128 + row) * KS + c4 * 32; *(LAS v4u*)kl = a0; *(LAS v4u*)(kl + 16) = a1; }
          const v4u* vp = (const v4u*)(gv + (size_t)(mb + row) * 512 + h * 128 + c4 * 32); LAS unsigned char* vl = F.lds + VOFF + row * VS + c4 * 64;
#pragma unroll
          for (int j = 0; j < 4; ++j) *(LAS v4u*)(vl + 16 * j) = vp[j]; }
        const int qrow = mb + 16 * w + q16, qj = 16 * (w & 3) + q16;
        f32x4 o[8];
#pragma unroll
        for (int dt = 0; dt < 8; ++dt) o[dt] = (f32x4){0.f, 0.f, 0.f, 0.f};
#pragma unroll 1
        for (int dir = 0; dir < 2; ++dir) {
            { const int fw = tid >> 6, fl = tid & 63, fdvt = fw >> 1, fdkt = fw & 1, fr = fl & 31, fhh = fl >> 5;
#pragma unroll
              for (int c = 0; c < 2; ++c) { const v4u* sp = (const v4u*)(sst + ((size_t)((bh * 2 + dir) * 68 + cm0 + c) * 8192 + (size_t)tid * 16)); const v4u s0 = sp[0], s1 = sp[1];
                  LAS unsigned char* sl = F.lds + SOFF + (c * 128 + 32 * fdvt + fr) * SS + (32 * fdkt + 4 * fhh) * 2;
                  *(LAS unsigned long long*)(sl) = (unsigned long long)s0[0] | ((unsigned long long)s0[1] << 32); *(LAS unsigned long long*)(sl + 16) = (unsigned long long)s0[2] | ((unsigned long long)s0[3] << 32);
                  *(LAS unsigned long long*)(sl + 32) = (unsigned long long)s1[0] | ((unsigned long long)s1[1] << 32); *(LAS unsigned long long*)(sl + 48) = (unsigned long long)s1[2] | ((unsigned long long)s1[3] << 32); } }
            const bf16* qin = (const bf16*)(F.ws + (dir ? WS_QINB : WS_GQ)) + (size_t)qrow * 256 + h * 64 + 8 * g;
            bf16x8 Q[2]; Q[0] = *(const bf16x8*)qin; Q[1] = *(const bf16x8*)(qin + 32);
            LDS_WAIT(); __builtin_amdgcn_s_barrier(); asm volatile("" ::: "memory");
            LAS const unsigned char* KL = F.lds + KOFF + (dir * 128 + wc * 64) * KS; LAS const unsigned char* VL = F.lds + VOFF + wc * 64 * VS; LAS const unsigned char* SL = F.lds + SOFF + wc * 128 * SS;
            const int wq0 = 16 * (w & 3);
            f32x4 p[4];
#pragma unroll
            for (int kt = 0; kt < 4; ++kt) { p[kt] = (f32x4){0.f, 0.f, 0.f, 0.f};
                const bool act = dir ? (16 * kt + 15 >= wq0) : (16 * kt <= wq0 + 15);
                if (act) {
#pragma unroll
                    for (int ks = 0; ks < 2; ++ks) { const bf16x8 A = *(LAS const bf16x8*)(KL + (16 * kt + q16) * KS + (32 * ks + 8 * g) * 2);
                        p[kt] = __builtin_amdgcn_mfma_f32_16x16x32_bf16(A, Q[ks], p[kt], 0, 0, 0); } } }
            bf16x8 Pb[2];
#pragma unroll
            for (int kk = 0; kk < 2; ++kk) { v4u pw;
#pragma unroll
                for (int t2 = 0; t2 < 2; ++t2) { const int kt = 2 * kk + t2; float v[4];
#pragma unroll
                    for (int e = 0; e < 4; ++e) { const int kj = 16 * kt + 4 * g + e; const bool keep = dir ? (kj >= qj) : (kj <= qj); v[e] = keep ? p[kt][e] : 0.f; }
                    pw[2 * t2] = pg8::cvt_pk_bf16(v[0], v[1]); pw[2 * t2 + 1] = pg8::cvt_pk_bf16(v[2], v[3]); }
                Pb[kk] = __builtin_bit_cast(bf16x8, pw); }
#pragma unroll
            for (int dt = 0; dt < 8; ++dt) {
#pragma unroll
                for (int kk = 0; kk < 2; ++kk) { LAS const unsigned char* vp = VL + (32 * kk + 4 * g + (q16 >> 2)) * VS + (16 * dt + 4 * (q16 & 3)) * 2;
                    o[dt] = __builtin_amdgcn_mfma_f32_16x16x32_bf16(tr_read8(vp, vp + 16 * VS), Pb[kk], o[dt], 0, 0, 0); }
#pragma unroll
                for (int ks = 0; ks < 2; ++ks) { const bf16x8 A = *(LAS const bf16x8*)(SL + (16 * dt + q16) * SS + (32 * ks + 8 * g) * 2);
                    o[dt] = __builtin_amdgcn_mfma_f32_16x16x32_bf16(A, Q[ks], o[dt], 0, 0, 0); }
            }
            LDS_WAIT(); __builtin_amdgcn_s_barrier(); asm volatile("" ::: "memory");
        }
        float s = 0.f;
#pragma unroll
        for (int dt = 0; dt < 8; ++dt) s += (o[dt][0] * o[dt][0] + o[dt][1] * o[dt][1]) + (o[dt][2] * o[dt][2] + o[dt][3] * o[dt][3]);
        s += __shfl_xor(s, 16); s += __shfl_xor(s, 32);
        const float rs = 1.0f / sqrtf(s * (1.f / 128.f) + EPS);
        LAS unsigned char* ol = F.lds + w * (16 * OS);
#pragma unroll
        for (int dt = 0; dt < 8; ++dt) { const f32x4 gg = *(const f32x4*)(gng + 16 * dt + 4 * g); const f32x4 y = o[dt] * rs * gg;
            *(LAS unsigned long long*)(ol + q16 * OS + (16 * dt + 4 * g) * 2) = (unsigned long long)pg8::cvt_pk_bf16(y[0], y[1]) | ((unsigned long long)pg8::cvt_pk_bf16(y[2], y[3]) << 32); }
        LDS_WAIT(); asm volatile("" ::: "memory");
        { const int rr = lane >> 2, c4 = lane & 3; const size_t row = (size_t)(mb + 16 * w + rr);
#pragma unroll
          for (int j = 0; j < 4; ++j) { const int ch = 4 * j + c4; const v4u yv = *(LAS const v4u*)(ol + rr * OS + ch * 16); const v4u gv_ = *(const v4u*)(gr + row * 512 + h * 128 + ch * 8); v4u ov;
#pragma unroll
              for (int e = 0; e < 4; ++e) { const float y0 = __builtin_bit_cast(float, yv[e] << 16), y1 = __builtin_bit_cast(float, yv[e] & 0xffff0000u), g0 = __builtin_bit_cast(float, gv_[e] << 16), g1 = __builtin_bit_cast(float, gv_[e] & 0xffff0000u);
                  ov[e] = pg8::cvt_pk_bf16(y0 * silu_f(g0), y1 * silu_f(g1)); }
              *(v4u*)(cat + row * 1024 + 512 + h * 128 + ch * 8) = ov; } }
        __syncthreads();
    }
}

__device__ __forceinline__ void phase_na(Frame& F, int vbid, int vG) {
    const bf16* naq = (const bf16*)(F.ws + WS_NAQ); const bf16* nak = (const bf16*)(F.ws + WS_NAK); const bf16* nav = (const bf16*)(F.ws + WS_NAV); bf16* cat = (bf16*)(F.ws + WS_CAT);
    const int lane = F.lane, h = F.wave, r = lane & 31, hh = lane >> 5, gsub = (lane >> 4) & 1, i16 = lane & 15;
    constexpr int VSTR = 192; constexpr float LOG2E = 1.4426950408889634f;
    LAS unsigned char* VL = F.lds + h * 8192; LAS float* RB = (LAS float*)(F.lds + h * 8192 + 6144);
    for (int i = lane; i < 465; i += 64) RB[16 + i] = F.a->in[IN_RPB][h * 465 + i] * LOG2E;
    const int voff = (4 * hh + (i16 >> 2)) * VSTR + (16 * gsub + 4 * (i16 & 3)) * 2;
    for (int unit = xcd_vcu(vbid, vG); unit < 272; unit += vG) {
        const bool lat = unit < 256; int b, R = 0, C = 0, qt = 0;
        if (lat) { b = unit >> 6; R = ((unit >> 2) & 15) * 4; C = (unit & 3) * 16; } else { b = (unit - 256) >> 2; qt = (unit - 256) & 3; }
        const size_t hb = (size_t)(b * 8 + h) * 4352;
        int qtok[2], qr[2], qc[2];
#pragma unroll
        for (int ct = 0; ct < 2; ++ct) { const int i = 32 * ct + r; qr[ct] = R + (i >> 4); qc[ct] = C + (i & 15); qtok[ct] = lat ? qr[ct] * 64 + qc[ct] : 4096 + 64 * qt + i; }
        bf16x8 Q[2][4];
#pragma unroll
        for (int ct = 0; ct < 2; ++ct)
#pragma unroll
            for (int ks = 0; ks < 4; ++ks) Q[ct][ks] = *(const bf16x8*)(naq + (hb + qtok[ct]) * 64 + 16 * ks + 8 * hh);
        const int rlo = min(max(R - 4, 0), 56), rhi = min(max(R - 1, 0), 56) + 7, cstart = min(max(C - 8, 0), 32);
        const int nblk = lat ? 8 + (rhi - rlo + 1) : 8;
        int r0q[2], klo[2];
#pragma unroll
        for (int ct = 0; ct < 2; ++ct) { r0q[ct] = min(max(qr[ct] - 4, 0), 56); klo[ct] = min(max(qc[ct] - 8, 0), 48) - cstart; }
        f32x16 ot[2][2];
#pragma unroll
        for (int a = 0; a < 2; ++a)
#pragma unroll
            for (int c = 0; c < 2; ++c)
#pragma unroll
                for (int e = 0; e < 16; ++e) ot[a][c][e] = 0.f;
        float mrun[2] = {-1e30f, -1e30f}, lrun[2] = {0.f, 0.f};
        bf16x8 Kf[4]; v4u Vr[4];
#define NA_KTOK(i_) ((i_) < 8 ? 4096 + 32 * (i_) : (rlo + (i_) - 8) * 64 + cstart)
#define NA_LOAD(i_) do { const int kt_ = NA_KTOK(i_); const bf16* kp_ = nak + (hb + kt_ + r) * 64 + 8 * hh; \
            Kf[0] = *(const bf16x8*)kp_; Kf[1] = *(const bf16x8*)(kp_ + 16); Kf[2] = *(const bf16x8*)(kp_ + 32); Kf[3] = *(const bf16x8*)(kp_ + 48); \
            const v4u* vp_ = (const v4u*)(nav + (hb + kt_) * 64) + lane; Vr[0] = vp_[0]; Vr[1] = vp_[64]; Vr[2] = vp_[128]; Vr[3] = vp_[192]; } while (0)
        NA_LOAD(0);
        for (int i = 0; i < nblk; ++i) {
#pragma unroll
            for (int j = 0; j < 4; ++j) { const int idx = lane + 64 * j; *(LAS v4u*)(VL + (idx >> 3) * VSTR + (idx & 7) * 16) = Vr[j]; }
            f32x16 st[2];
#pragma unroll
            for (int ct = 0; ct < 2; ++ct) {
#pragma unroll
                for (int e = 0; e < 16; ++e) st[ct][e] = 0.f;
#pragma unroll
                for (int ks = 0; ks < 4; ++ks) st[ct] = __builtin_amdgcn_mfma_f32_32x32x16_bf16(Kf[ks], Q[ct][ks], st[ct], 0, 0, 0);
            }
            const int kr = rlo + i - 8;
            if (i + 1 < nblk) NA_LOAD(i + 1);
            bf16x8 Pb[2][2];
#pragma unroll
            for (int ct = 0; ct < 2; ++ct) {
                float mx = -1e30f;
                if (i < 8) {
#pragma unroll
                    for (int e = 0; e < 16; ++e) { st[ct][e] *= LOG2E; mx = fmaxf(mx, st[ct][e]); }
                } else {
                    const bool rowok = (kr >= r0q[ct]) && (kr <= r0q[ct] + 7);
                    const LAS float* bp = RB + 16 + (kr - qr[ct] + 7) * 31 + cstart - qc[ct] + 15 + 4 * hh;
#pragma unroll
                    for (int e = 0; e < 16; ++e) { const int kk = (e & 3) + 8 * (e >> 2); const bool ok = rowok && ((unsigned)(kk + 4 * hh - klo[ct]) < 16u);
                        const float v = st[ct][e] * LOG2E + bp[kk]; st[ct][e] = ok ? v : -1e30f; mx = fmaxf(mx, st[ct][e]); }
                }
                mx = fmaxf(mx, __shfl_xor(mx, 32));
                const float mnew = fmaxf(mrun[ct], mx), alpha = exp2f(mrun[ct] - mnew); mrun[ct] = mnew;
                float ls = 0.f;
#pragma unroll
                for (int e = 0; e < 16; ++e) { const float p = exp2f(st[ct][e] - mnew); st[ct][e] = p; ls += p; }
                lrun[ct] = lrun[ct] * alpha + ls;
#pragma unroll
                for (int dt = 0; dt < 2; ++dt)
#pragma unroll
                    for (int e = 0; e < 16; ++e) ot[dt][ct][e] *= alpha;
#pragma unroll
                for (int s = 0; s < 2; ++s) { v4u pw;
#pragma unroll
                    for (int j = 0; j < 4; ++j) pw[j] = pg8::cvt_pk_bf16(st[ct][8 * s + 2 * j], st[ct][8 * s + 2 * j + 1]);
                    Pb[ct][s] = __builtin_bit_cast(bf16x8, pw); }
            }
#pragma unroll
            for (int dt = 0; dt < 2; ++dt)
#pragma unroll
                for (int s = 0; s < 2; ++s) { LAS const unsigned char* vp = VL + voff + 16 * s * VSTR + 64 * dt;
                    const bf16x8 A = tr_read8(vp, vp + 8 * VSTR);
                    ot[dt][0] = __builtin_amdgcn_mfma_f32_32x32x16_bf16(A, Pb[0][s], ot[dt][0], 0, 0, 0);
                    ot[dt][1] = __builtin_amdgcn_mfma_f32_32x32x16_bf16(A, Pb[1][s], ot[dt][1], 0, 0, 0); }
        }
#undef NA_LOAD
#undef NA_KTOK
#pragma unroll
        for (int ct = 0; ct < 2; ++ct) {
            const float inv = 1.0f / (lrun[ct] + __shfl_xor(lrun[ct], 32));
            const int row = lat ? b * SEQ + qtok[ct] : ML + b * CTXL + (qtok[ct] - 4096);
#pragma unroll
            for (int dt = 0; dt < 2; ++dt)
#pragma unroll
                for (int q4 = 0; q4 < 4; ++q4) { const int d = 32 * dt + 8 * q4 + 4 * hh;
                    *(unsigned long long*)(cat + (size_t)row * 1024 + h * 64 + d) = (unsigned long long)pg8::cvt_pk_bf16(ot[dt][ct][4 * q4] * inv, ot[dt][ct][4 * q4 + 1] * inv)
                        | ((unsigned long long)pg8::cvt_pk_bf16(ot[dt][ct][4 * q4 + 2] * inv, ot[dt][ct][4 * q4 + 3] * inv) << 32); }
        }
    }
    __syncthreads();
}

constexpr int NPHASE = 23;
#ifndef NA_SIMPLE
#define NA_SIMPLE 0
#endif
#ifndef GLA_SIMPLE
#define GLA_SIMPLE 0
#endif
#ifndef RET_SIMPLE
#define RET_SIMPLE 0
#endif
__global__ void __launch_bounds__(NWAVES * 64, 2) mk_fwd(Args args) {
    extern __shared__ __attribute__((aligned(16))) unsigned char lds[];
    Frame F;
    F.lds = (LAS unsigned char*)lds; F.tid = threadIdx.x; F.lane = F.tid & 63; F.wave = __builtin_amdgcn_readfirstlane(F.tid >> 6); F.G = gridDim.x; F.bid = blockIdx.x;
    F.a = &args;
    F.out = args.out; F.ws = args.ws;
    unsigned char* ws = args.ws;
    for (int u = F.tid; u < (LDS_BYTES - LDSCTL_OFF) / 4; u += NWAVES * 64) ((LAS unsigned*)(F.lds + LDSCTL_OFF))[u] = 0u;
    __syncthreads();
    const int lo = args.ph_lo, hi = args.ph_hi;
    XcdBarrier bar; bar.bar = (unsigned*)(ws + WS_CTL) + CW_BAR; bar.x = 0; bar.st = nullptr;
    if (hi - lo > 1) bar = xcd_barrier_post((unsigned*)(ws + WS_CTL) + CW_BAR, (volatile LAS unsigned*)(F.lds + MISC_OFF) + 8);
    float* mod = (float*)(ws + WS_MOD); float* xc = (float*)(ws + WS_XC); bf16* H = (bf16*)(ws + WS_H);
#define IN(k) (lo <= (k) && (k) < hi)
#define SEAM(k) do { if ((k) + 1 < hi) xcd_barrier(bar); } while (0)
#define GEMM_RES(ph_, A_, Bt_, M_, K_, bL_, bC_, gate_) do { pg8::Gemm g{(const bf16*)(A_), (const bf16*)(Bt_), (M_), 1024, (K_)}; pg8::StaticOrder S; S.init((M_), 1024, F.G, F.bid); \
        pg8::EpiRes E{(bL_), (bC_), F.out, xc, (gate_)}; pg8::gemm_phase<pg8::EpiRes, pg8::StaticOrder, true, true>(F.lds + RING_OFF, g, S, E); } while (0)
#define GEMM_UP(l_, M_) do { pg8::Gemm g{H, (const bf16*)(ws + ((l_) ? WS_WUPT1 : WS_WUPT0)), (M_), NUP, 1024}; pg8::StaticOrder S; S.init((M_), NUP, F.G, F.bid); \
        pg8::EpiUp E{(bf16*)(ws + ((l_) ? WS_ACT1 : WS_ACT0)), (float*)(ws + ((l_) ? WS_EDGE1 : WS_EDGE0)), F.a->in[IN_CW] + (l_) * 3 * NUP, F.a->in[IN_CB] + (l_) * NUP}; \
        pg8::gemm_phase<pg8::EpiUp, pg8::StaticOrder, true, true>(F.lds + RING_OFF, g, S, E); } while (0)
    if (IN(0)) { phase_prep(F); SEAM(0); }
    if (IN(1)) { phase_modnorm(F, F.a->in[IN_X], F.a->in[IN_CTX], MT, F.a->in[IN_N1G], mod, 0); SEAM(1); }
    if (IN(2)) { pg8::Gemm g{H, (const bf16*)(ws + WS_WIN0T), MT, N0P, 1024}; pg8::StaticOrder S; S.init(MT, N0P, F.G, F.bid);
        pg8::EpiProj0 E{ws}; pg8::gemm_phase<pg8::EpiProj0, pg8::StaticOrder, true, true>(F.lds + RING_OFF, g, S, E); SEAM(2); }
#if GLA_SIMPLE
    if (IN(3)) { phase_na_simple(F); phase_gla_gates_simple(F); SEAM(3); }
    if (IN(4)) { phase_gla_rec_simple(F); SEAM(4); }
    if (IN(5)) { phase_gla_out_simple(F); SEAM(5); }
#else
#if NA_SIMPLE
    if (IN(3)) { phase_gla_prep(F); phase_na_simple(F); SEAM(3); }
    if (IN(4)) { phase_gla_scan(F); SEAM(4); }
#else
    if (IN(3)) { phase_gla_prep(F); SEAM(3); }
    if (IN(4)) { if (F.G >= 64) { if (F.bid < 32) phase_gla_scan(F); else { phase_na(F, F.bid - 32, F.G - 32); phase_prep_late(F, F.bid - 32, F.G - 32); } } else { phase_gla_scan(F); phase_na(F, F.bid, F.G); phase_prep_late(F, F.bid, F.G); } SEAM(4); }
#endif
    if (IN(5)) { phase_gla_out(F); SEAM(5); }
#endif
    if (IN(6)) { GEMM_RES(6, ws + WS_CAT, ws + WS_WO0T, ML, 1024, F.a->in[IN_X], F.a->in[IN_CTX], mod + 2048);
        ctx_gemm_res<1024>(F, (const bf16*)(ws + WS_CAT) + (size_t)ML * 1024, (const bf16*)(ws + WS_WO0T), F.a->in[IN_CTX], xc, mod + 4 * 6144 + 2048); SEAM(6); }
    if (IN(7)) { phase_modnorm(F, F.out, xc, MT, F.a->in[IN_N2G], mod, 3072); SEAM(7); }
    if (IN(8)) { GEMM_UP(0, MT); SEAM(8); }
    if (IN(9)) { phase_fixup(F, (const float*)(ws + WS_EDGE0), (bf16*)(ws + WS_ACT0), MT / 64, F.a->in[IN_CW], F.a->in[IN_CB]); SEAM(9); }
    if (IN(10)) { GEMM_RES(10, ws + WS_ACT0, ws + WS_WDNT0, ML, DFF, F.out, xc, mod + 5120);
        ctx_gemm_res<DFF>(F, (const bf16*)(ws + WS_ACT0) + (size_t)ML * DFF, (const bf16*)(ws + WS_WDNT0), xc, xc, mod + 4 * 6144 + 5120); SEAM(10); }
    if (IN(11)) { phase_modnorm(F, F.out, xc, MT, F.a->in[IN_N1G] + 1024, mod + 5 * 6144, 0); SEAM(11); }
    if (IN(12)) { pg8::Gemm g{H, (const bf16*)(ws + WS_WIN1T), MT, N1, 1024}; pg8::StaticOrder S; S.init(MT, N1, F.G, F.bid);
        pg8::EpiProj1 E{ws}; pg8::gemm_phase<pg8::EpiProj1, pg8::StaticOrder, true, true>(F.lds + RING_OFF, g, S, E); SEAM(12); }
#if RET_SIMPLE
    if (IN(13)) { phase_ret_rec_simple(F, 0); SEAM(13); }
    if (IN(14)) { phase_ret_out_simple(F, 0); SEAM(14); }
    if (IN(15)) { phase_ret_rec_simple(F, 1); SEAM(15); }
    if (IN(16)) { phase_ret_out_simple(F, 1); SEAM(16); }
#else
    if (IN(13)) { phase_ret_scan(F); SEAM(13); }
    if (IN(14)) { phase_ret_out2(F); SEAM(14); }
#endif
    if (IN(17)) {
        transpose_all(F, F.a->in[IN_WUP] + (size_t)1024 * NUP, 1024, NUP, NUP, (bf16*)(ws + WS_WUPT1), MapUp{});
        transpose_all(F, F.a->in[IN_WDN] + (size_t)DFF * 1024, DFF, 1024, 1024, (bf16*)(ws + WS_WDNT1), MapId{1024});
        __syncthreads();
        GEMM_RES(17, ws + WS_RG, ws + WS_WO1T, ML, 2048, F.out, xc, mod + 5 * 6144 + 2048); SEAM(17); }
    if (IN(18)) { phase_modnorm(F, F.out, xc, ML, F.a->in[IN_N2G] + 1024, mod + 5 * 6144, 3072); SEAM(18); }
    if (IN(19)) { GEMM_UP(1, ML); SEAM(19); }
    if (IN(20)) { phase_fixup(F, (const float*)(ws + WS_EDGE1), (bf16*)(ws + WS_ACT1), ML / 64, F.a->in[IN_CW] + 3 * NUP, F.a->in[IN_CB] + NUP); SEAM(20); }
    if (IN(21)) { GEMM_RES(21, ws + WS_ACT1, ws + WS_WDNT1, ML, DFF, F.out, xc, mod + 5 * 6144 + 5120); SEAM(21); }
    if (IN(22)) { phase_final(F); }
}

#ifndef MK_ONE_LAUNCH
#define MK_ONE_LAUNCH 1
#endif
extern "C" void kernel_launch(void* const* d_in, const int* in_sizes, int n_in, void* d_out, int out_size, void* d_ws, size_t ws_size, hipStream_t stream) {
    static int grid = 0;
    if (grid == 0) {
        if (n_in != 26 || out_size != ML * DM || ws_size < WS_END) { fprintf(stderr, "kernel_launch: unexpected shapes: n_in %d out %d ws %zu\n", n_in, out_size, ws_size); grid = -1; return; }
        int dev = 0, cus = 0, per_cu = 0;
        if (hipGetDevice(&dev) != hipSuccess || hipDeviceGetAttribute(&cus, hipDeviceAttributeMultiprocessorCount, dev) != hipSuccess) { grid = -1; return; }
        if (hipFuncSetAttribute((const void*)mk_fwd, hipFuncAttributeMaxDynamicSharedMemorySize, LDS_BYTES) != hipSuccess) { fprintf(stderr, "kernel_launch: hipFuncSetAttribute failed\n"); grid = -1; return; }
        if (hipOccupancyMaxActiveBlocksPerMultiprocessor(&per_cu, (const void*)mk_fwd, NWAVES * 64, LDS_BYTES) != hipSuccess || per_cu < 1) { fprintf(stderr, "kernel_launch: occupancy query says %d blocks per CU\n", per_cu); }
        (void)hipGetLastError();
        grid = cus;
    }
    if (grid < 0) return;
    (void)hipMemsetAsync((char*)d_ws + WS_CTL, 0, CTL_ZERO_BYTES, stream);
    Args a{};
    for (int i = 0; i < 26; ++i) a.in[i] = (const float*)d_in[i];
    a.out = (float*)d_out; a.ws = (unsigned char*)d_ws;
#if MK_ONE_LAUNCH
    a.ph_lo = 0; a.ph_hi = NPHASE;
    void* kargs[] = {&a};
    hipError_t e = hipLaunchCooperativeKernel((const void*)mk_fwd, dim3(grid), dim3(NWAVES * 64), kargs, LDS_BYTES, stream);
    if (e != hipSuccess) fprintf(stderr, "kernel_launch: cooperative launch failed: %s\n", hipGetErrorString(e));
#else
    for (int ph = 0; ph < NPHASE; ++ph) { a.ph_lo = ph; a.ph_hi = ph + 1; hipLaunchKernelGGL(mk_fwd, dim3(grid), dim3(NWAVES * 64), LDS_BYTES, stream, a); }
#endif
}
```

```cpp
#include <hip/hip_runtime.h>
#include <cstdio>
#include <cstdint>
namespace pg8 {
#define PG8_LAS __attribute__((address_space(3)))
typedef unsigned short bf16_t;
typedef short bf16x8 __attribute__((ext_vector_type(8)));
typedef float f32x4 __attribute__((ext_vector_type(4)));
typedef unsigned u32x4 __attribute__((ext_vector_type(4)));
constexpr int BM = 256, BK = 64, HALF = 128, HTB = HALF * BK * 2  , STAGE_BYTES = 8 * HTB, NXCD = 8, WGM = 8;

__host__ __device__ __forceinline__ int lds_byte(int r, int c) { const int st = (r >> 4) * 2 + (c >> 5), rr = r & 15, cc = c & 31, ob = rr * 64 + cc * 2; return st * 1024 + (ob ^ (((ob >> 9) & 1) << 5)); }
__host__ __device__ __forceinline__ void stage_rc(int b, int& R, int& C) { const int st = b / 1024, sb = b % 1024, swz = sb ^ (((sb >> 9) & 1) << 5); R = (st >> 1) * 16 + swz / 64; C = (st & 1) * 32 + (swz % 64) / 2; }
__host__ __device__ __forceinline__ int perm32(int rho) { const int n = rho >> 4, i = rho & 15; return 8 * (i >> 2) + 4 * n + (i & 3); }

struct Unit { int pm, pn; };
struct Gemm { const bf16_t* A; const bf16_t* Bt; int M, N, K; };

struct StaticOrder {
    int nM, nN, nwg, G, c;
    __host__ __device__ void init(int M, int N, int G_, int c_) { nM = M / BM; nN = N / BM; nwg = nM * nN; G = G_; c = c_; }
    __host__ __device__ bool next(int i, Unit& u) const {
        const long L = (long)i * G + c; if (L >= nwg) return false;
        int wgid = (int)L; { const int q = nwg / NXCD, r = nwg % NXCD, xcd = wgid % NXCD, off = wgid / NXCD; wgid = (xcd < r ? xcd * (q + 1) : r * (q + 1) + (xcd - r) * q) + off; }
        const int nig = WGM * nN, gid = wgid / nig, fm = gid * WGM, gsz = (nM - fm) < WGM ? (nM - fm) : WGM;
        u.pm = fm + ((wgid % nig) % gsz); u.pn = (wgid % nig) / gsz; return true;
    }
    __device__ __forceinline__ void a_ready(const Unit&) const {}
    __device__ __forceinline__ void done(const Unit&) const {}
};

__device__ __forceinline__ unsigned cvt_pk_bf16(float lo, float hi) { unsigned r; asm volatile("v_cvt_pk_bf16_f32 %0, %1, %2" : "=v"(r) : "v"(lo), "v"(hi)); return r; }

constexpr size_t PJ_MiB = 1u << 20;
constexpr size_t PJ0_NAQ = 79 * PJ_MiB, PJ0_NAK = 96 * PJ_MiB, PJ0_NAV = 113 * PJ_MiB, PJ0_GQ = 130 * PJ_MiB, PJ0_GK = PJ0_GQ + 8704 * 1024, PJ0_GV = 147 * PJ_MiB, PJ0_GR = 164 * PJ_MiB, PJ0_GA = 181 * PJ_MiB;
constexpr size_t PJ1_RQ = 54 * PJ_MiB, PJ1_RK = 86 * PJ_MiB, PJ1_RV = 120 * PJ_MiB, PJ1_RG = 188 * PJ_MiB, PJ1_ROPE = 1 * PJ_MiB + 512 * 1024;
typedef float f32x2 __attribute__((ext_vector_type(2)));
typedef unsigned u32x2 __attribute__((ext_vector_type(2)));
__device__ __forceinline__ void store8bf(bf16_t* p, f32x4 v0, f32x4 v1) {
    u32x4 w; w.x = cvt_pk_bf16(v0[0], v0[1]); w.y = cvt_pk_bf16(v0[2], v0[3]); w.z = cvt_pk_bf16(v1[0], v1[1]); w.w = cvt_pk_bf16(v1[2], v1[3]);
    *(u32x4*)p = w;
}
struct EpiProj0 {
    static constexpr bool PERM = true, AFTER_DRAIN = false;
    unsigned char* ws;
    __device__ __forceinline__ void operator()(const f32x4 (&acc)[2][2][4][2], const Unit& u, int wr, int wc, int fr, int fq) const {
#pragma unroll
        for (int ai = 0; ai < 2; ++ai)
#pragma unroll
            for (int m = 0; m < 4; ++m) {
                const int row = u.pm * BM + ai * HALF + wr * 64 + m * 16 + fr;
                int b, rin; if (row < 16384) { b = row >> 12; rin = row & 4095; } else { b = (row - 16384) >> 8; rin = 4096 + ((row - 16384) & 255); }
#pragma unroll
                for (int bj = 0; bj < 2; ++bj) {
                    const int C0 = u.pn * BM + bj * HALF;
                    const f32x4 v0 = acc[ai][bj][m][0], v1 = acc[ai][bj][m][1];
                    if (C0 < 1536) {
                        const int t = C0 >> 9, head = ((C0 & 511) >> 6) + (wc >> 1), d = 32 * (wc & 1) + 8 * fq;
                        bf16_t* base = (bf16_t*)(ws + (t == 0 ? PJ0_NAQ : (t == 1 ? PJ0_NAK : PJ0_NAV))); const float sc = t == 0 ? 0.125f : 1.0f;
                        store8bf(base + ((size_t)((b * 8 + head) * 4352 + rin) * 64 + d), v0 * sc, v1 * sc);
                    } else if (C0 < 2048) {
                        const bool isq = C0 < 1792; bf16_t* base = (bf16_t*)(ws + (isq ? PJ0_GQ : PJ0_GK)); const int cb = C0 - (isq ? 1536 : 1792); const float sc = isq ? 0.125f : 1.0f;
                        store8bf(base + (size_t)row * 256 + cb + 32 * wc + 8 * fq, v0 * sc, v1 * sc);
                    } else if (C0 < 3072) {
                        const bool isv = C0 < 2560; bf16_t* base = (bf16_t*)(ws + (isv ? PJ0_GV : PJ0_GR)); const int cb = C0 - (isv ? 2048 : 2560);
                        store8bf(base + (size_t)row * 512 + cb + 32 * wc + 8 * fq, v0, v1);
                    } else if (C0 == 3072) {
                        if (wc == 0) { float* p = (float*)(ws + PJ0_GA) + (size_t)row * 32 + 8 * fq; *(f32x4*)p = v0; *(f32x4*)(p + 4) = v1; }
                    }
                }
            }
    }
};
struct EpiRes {
    static constexpr bool PERM = false, AFTER_DRAIN = false;
    const float* baseL; const float* baseC; float* outL; float* outC; const float* gate;
    __device__ __forceinline__ void operator()(const f32x4 (&acc)[2][2][4][2], const Unit& u, int wr, int wc, int fr, int fq) const {
        const bool lat = u.pm < 64; const int tm = lat ? u.pm : u.pm - 64, bi = lat ? (u.pm >> 4) : 4;
        const float* base = (lat ? baseL : baseC) + (size_t)tm * BM * 1024; float* out = (lat ? outL : outC) + (size_t)tm * BM * 1024;
        const int col0 = u.pn * BM + wc * 32 + 4 * fq;
        f32x4 gv[2][2];
#pragma unroll
        for (int bj = 0; bj < 2; ++bj)
#pragma unroll
            for (int n = 0; n < 2; ++n) gv[bj][n] = *(const f32x4*)(gate + bi * 6144 + col0 + bj * HALF + n * 16);
#pragma unroll
        for (int ai = 0; ai < 2; ++ai)
#pragma unroll
            for (int m = 0; m < 4; ++m) { const size_t off = (size_t)(ai * HALF + wr * 64 + m * 16 + fr) * 1024 + col0;
#pragma unroll
                for (int bj = 0; bj < 2; ++bj)
#pragma unroll
                    for (int n = 0; n < 2; ++n) { const f32x4 bs = *(const f32x4*)(base + off + bj * HALF + n * 16); *(f32x4*)(out + off + bj * HALF + n * 16) = bs + gv[bj][n] * acc[ai][bj][m][n]; }
                if (m & 1) asm volatile("" ::: "memory"); }
    }
};
template <int CTRL> __device__ __forceinline__ float dpp_mov(float old, float src) {
    return __builtin_bit_cast(float, __builtin_amdgcn_update_dpp(__builtin_bit_cast(int, old), __builtin_bit_cast(int, src), CTRL, 0xf, 0xf, false));
}
struct EpiUp {
    static constexpr bool PERM = true, AFTER_DRAIN = false;
    bf16_t* act; float* edge; const float* cw; const float* cb;
    template <int M> __device__ __forceinline__ f32x4 conv_m(const f32x4 (&acc)[4][2], int n, const f32x4& w0, const f32x4& w1, const f32x4& w2, const f32x4& bs) const {
        f32x4 y;
#pragma unroll
        for (int e = 0; e < 4; ++e) {
            const float x = acc[M][n][e];
            const float tp = M > 0 ? dpp_mov<0x121>(0.f, acc[M > 0 ? M - 1 : 0][n][e]) : 0.f;
            const float pv = dpp_mov<0x111>(tp, x);
            const float tn = M < 3 ? dpp_mov<0x12F>(0.f, acc[M < 3 ? M + 1 : 3][n][e]) : 0.f;
            const float nx = dpp_mov<0x101>(tn, x);
            y[e] = w0[e] * pv + w1[e] * x + w2[e] * nx + bs[e];
        }
        return y;
    }
    template <int M> __device__ __forceinline__ void row_m(const f32x4 (&aa)[4][2], const f32x4 (&ab)[4][2], int n, const f32x4 (&wa)[4], const f32x4 (&wb)[4], int blk, int fr, int jn) const {
        f32x4 ya = conv_m<M>(aa, n, wa[0], wa[1], wa[2], wa[3]);
#pragma unroll
        for (int e = 0; e < 4; ++e) { const float a = ya[e]; ya[e] = a * __builtin_amdgcn_rcpf(1.0f + __expf(-a)); }
        const f32x4 yb = conv_m<M>(ab, n, wb[0], wb[1], wb[2], wb[3]);
        const f32x4 r = ya * yb;
        u32x2 w; w.x = cvt_pk_bf16(r[0], r[1]); w.y = cvt_pk_bf16(r[2], r[3]);
        const bool is_edge = (M == 0 && fr == 0) || (M == 3 && fr == 15);
        if (!is_edge) *(u32x2*)(act + (size_t)(blk * 64 + M * 16 + fr) * 2816 + jn) = w;
        if (M == 0) { if (fr < 2) { float* p = edge + ((size_t)(blk * 4 + fr) * 5632 + jn); *(f32x4*)p = aa[0][n]; *(f32x4*)(p + 2816) = ab[0][n]; } }
        if (M == 3) { if (fr >= 14) { float* p = edge + ((size_t)(blk * 4 + fr - 12) * 5632 + jn); *(f32x4*)p = aa[3][n]; *(f32x4*)(p + 2816) = ab[3][n]; } }
        asm volatile("" ::: "memory");
    }
    __device__ __forceinline__ void operator()(const f32x4 (&acc)[2][2][4][2], const Unit& u, int wr, int wc, int fr, int fq) const {
        const int j0 = u.pn * 128 + wc * 32 + 8 * fq;
#pragma unroll
        for (int n = 0; n < 2; ++n) {
            const int jn = j0 + 4 * n;
            f32x4 wa[4], wb[4];
#pragma unroll
            for (int i = 0; i < 3; ++i) { wa[i] = *(const f32x4*)(cw + i * 5632 + jn); wb[i] = *(const f32x4*)(cw + i * 5632 + 2816 + jn); }
            wa[3] = *(const f32x4*)(cb + jn); wb[3] = *(const f32x4*)(cb + 2816 + jn);
#pragma unroll
            for (int ai = 0; ai < 2; ++ai) {
                const int blk = u.pm * 4 + ai * 2 + wr;
                row_m<0>(acc[ai][0], acc[ai][1], n, wa, wb, blk, fr, jn);
                row_m<1>(acc[ai][0], acc[ai][1], n, wa, wb, blk, fr, jn);
                row_m<2>(acc[ai][0], acc[ai][1], n, wa, wb, blk, fr, jn);
                row_m<3>(acc[ai][0], acc[ai][1], n, wa, wb, blk, fr, jn);
            }
        }
    }
};
struct EpiProj1 {
    static constexpr bool PERM = true, AFTER_DRAIN = false;
    unsigned char* ws;
    __device__ __forceinline__ void operator()(const f32x4 (&acc)[2][2][4][2], const Unit& u, int wr, int wc, int fr, int fq) const {
#pragma unroll
        for (int ai = 0; ai < 2; ++ai)
#pragma unroll
            for (int m = 0; m < 4; ++m) {
                const int row = u.pm * BM + ai * HALF + wr * 64 + m * 16 + fr; const bool lat = u.pm < 64;
                const int s = row & 4095, pos = (wc >> 1) == 0 ? (s >> 6) : (s & 63);
#pragma unroll
                for (int bj = 0; bj < 2; ++bj) {
                    const int C0 = u.pn * BM + bj * HALF;
                    f32x4 v0 = acc[ai][bj][m][0], v1 = acc[ai][bj][m][1];
                    if (C0 < 2048) {
                        const bool isq = C0 < 1024; if (isq && !lat) continue;
                        if (lat) {
                            const f32x2* rp = (const f32x2*)(ws + PJ1_ROPE) + pos * 32 + 16 * (wc & 1) + 4 * fq;
                            const f32x4 cs0 = *(const f32x4*)rp, cs1 = *(const f32x4*)(rp + 2);
                            const f32x4 c = {cs0[0], cs0[2], cs1[0], cs1[2]}, sn = {cs0[1], cs0[3], cs1[1], cs1[3]};
                            const f32x4 o1 = v0 * c - v1 * sn, o2 = v1 * c + v0 * sn; v0 = o1; v1 = o2;
                        }
                        if (!isq) { v0 = v0 * 0.08838834764831845f; v1 = v1 * 0.08838834764831845f; }
                        store8bf((bf16_t*)(ws + (isq ? PJ1_RQ : PJ1_RK)) + (size_t)row * 1024 + (C0 & 1023) + 32 * wc + 8 * fq, v0, v1);
                    } else if (C0 < 4096) {
                        store8bf((bf16_t*)(ws + PJ1_RV) + (size_t)row * 2048 + (C0 - 2048) + 32 * wc + 8 * fq, v0, v1);
                    } else {
                        if (lat) store8bf((bf16_t*)(ws + PJ1_RG) + (size_t)row * 2048 + (C0 - 4096) + 32 * wc + 8 * fq, v0, v1);
                    }
                }
            }
    }
};

template <class Epi, class Sched, bool ALIGN_EPI = false, bool SP2 = false>
__device__ __forceinline__ void gemm_phase(PG8_LAS unsigned char* lds, const Gemm g, const Sched& S, const Epi& E) {
    const int tid = threadIdx.x, wid = __builtin_amdgcn_readfirstlane(tid >> 6), lane = tid & 63, wr = wid >> 2, wc = wid & 3, fr = lane & 15, fq = lane >> 4;
    const int K = g.K, nt = K / BK;
    unsigned voffA[2], voffB[2];
#pragma unroll
    for (int i = 0; i < 2; ++i) { int R, C; stage_rc(tid * 16 + i * 8192, R, C); const int Rb = Epi::PERM ? ((R & ~31) + perm32(R & 31)) : R;
        voffA[i] = (unsigned)(R * K + C) * 2u; voffB[i] = (unsigned)(Rb * K + C) * 2u; }
    const size_t kstep = (size_t)(BK * 2);
    const size_t hstep = (size_t)HALF * K * 2;
    const size_t tstep = 2 * hstep;
    const unsigned ldsw = (unsigned)wid * 1024u;
    const int aoff = lds_byte(wr * 64 + fr, fq * 8), boff = lds_byte(wc * 32 + fr, fq * 8);
#define PG8_SA(b, h) (((b) * 2 + (h)) * HTB)
#define PG8_SB(b, h) ((4 + (b) * 2 + (h)) * HTB)
#define PG8_STAGE(bufoff, gbase, voff) do { _Pragma("unroll") for (int _i = 0; _i < 2; ++_i) \
        __builtin_amdgcn_global_load_lds((const unsigned*)((const char*)(gbase) + (voff)[_i]), (PG8_LAS unsigned*)(lds + (bufoff) + ldsw + _i * 8192), 16, 0, 0); } while (0)
#define PG8_LDA(dst, b, h) do { _Pragma("unroll") for (int m = 0; m < 4; ++m) _Pragma("unroll") for (int k = 0; k < 2; ++k) dst[m][k] = *(const PG8_LAS bf16x8*)(lds + PG8_SA(b, h) + aoff + m * 2048 + k * 1024); } while (0)
#define PG8_LDB(dst, b, h) do { _Pragma("unroll") for (int n = 0; n < 2; ++n) _Pragma("unroll") for (int k = 0; k < 2; ++k) dst[n][k] = *(const PG8_LAS bf16x8*)(lds + PG8_SB(b, h) + boff + n * 2048 + k * 1024); } while (0)
#define PG8_MMA(ai, bj, At, Bt) do { __builtin_amdgcn_s_setprio(1); _Pragma("unroll") for (int m = 0; m < 4; ++m) _Pragma("unroll") for (int n = 0; n < 2; ++n) _Pragma("unroll") for (int k = 0; k < 2; ++k) \
        acc[ai][bj][m][n] = __builtin_amdgcn_mfma_f32_16x16x32_bf16(Bt[n][k], At[m][k], acc[ai][bj][m][n], 0, 0, 0); __builtin_amdgcn_s_setprio(0); } while (0)
#define PG8_WAIT_V(n) asm volatile("s_waitcnt vmcnt(" #n ")" ::: "memory")
#define PG8_WAIT_L(n) asm volatile("s_waitcnt lgkmcnt(" #n ")" ::: "memory")
#define PG8_BAR __builtin_amdgcn_s_barrier()
#define PG8_SCHED __builtin_amdgcn_sched_barrier(0)
    Unit cur, nxt; int ui = 0;
    if (!S.next(0, cur)) return;
    f32x4 acc[2][2][4][2];
#pragma unroll
    for (int a = 0; a < 2; ++a)
#pragma unroll
        for (int b = 0; b < 2; ++b)
#pragma unroll
            for (int m = 0; m < 4; ++m)
#pragma unroll
                for (int n = 0; n < 2; ++n) acc[a][b][m][n] = (f32x4){0.f, 0.f, 0.f, 0.f};
    bf16x8 At[4][2], B0[2][2], B1[2][2];
    const char* cA = (const char*)g.A + (size_t)cur.pm * tstep; const char* cB = (const char*)g.Bt + (size_t)cur.pn * tstep;
    S.a_ready(cur);
    if constexpr (SP2) {
        PG8_STAGE(PG8_SB(0, 0), cB, voffB); PG8_STAGE(PG8_SB(0, 1), cB + hstep, voffB); PG8_STAGE(PG8_SA(0, 0), cA, voffA); PG8_STAGE(PG8_SA(0, 1), cA + hstep, voffA);
        if (wr == 1) PG8_BAR;
        PG8_WAIT_V(2); PG8_BAR;
        PG8_STAGE(PG8_SB(1, 0), cB + kstep, voffB); PG8_STAGE(PG8_SA(1, 0), cA + kstep, voffA); PG8_STAGE(PG8_SB(1, 1), cB + hstep + kstep, voffB);
        PG8_WAIT_V(6); PG8_BAR;
    } else {
        PG8_STAGE(PG8_SB(0, 0), cB, voffB); PG8_STAGE(PG8_SA(0, 0), cA, voffA); PG8_STAGE(PG8_SB(0, 1), cB + hstep, voffB); PG8_STAGE(PG8_SA(0, 1), cA + hstep, voffA);
        if (wr == 1) PG8_BAR;
        PG8_WAIT_V(4); PG8_BAR;
        PG8_STAGE(PG8_SB(1, 0), cB + kstep, voffB); PG8_STAGE(PG8_SA(1, 0), cA + kstep, voffA); PG8_STAGE(PG8_SB(1, 1), cB + hstep + kstep, voffB);
        PG8_WAIT_V(6); PG8_BAR;
    }
    for (;;) {
        const bool has_next = S.next(ui + 1, nxt);
        const char* nA = has_next ? (const char*)g.A + (size_t)nxt.pm * tstep : cA; const char* nB = has_next ? (const char*)g.Bt + (size_t)nxt.pn * tstep : cB;
        for (int t = 0; t < nt; t += 2) {
            const bool last = (t == nt - 2);
            const char* a1 = cA + (size_t)(t + 1) * kstep;
            const char* a2 = last ? nA : cA + (size_t)(t + 2) * kstep; const char* b2 = last ? nB : cB + (size_t)(t + 2) * kstep;
            const char* a3 = a2 + kstep; const char* b3 = b2 + kstep;
            if (last && has_next) S.a_ready(nxt);
            if constexpr (SP2) {
            PG8_LDB(B0, 0, 0); PG8_LDB(B1, 0, 1); PG8_SCHED; PG8_LDA(At, 0, 0); PG8_STAGE(PG8_SA(1, 1), a1 + hstep, voffA);
            PG8_WAIT_V(8); PG8_WAIT_L(0); PG8_BAR; PG8_MMA(0, 0, At, B0); PG8_MMA(0, 1, At, B1); PG8_BAR; PG8_SCHED;
            PG8_LDA(At, 0, 1); PG8_STAGE(PG8_SB(0, 0), b2, voffB); PG8_STAGE(PG8_SB(0, 1), b2 + hstep, voffB); PG8_STAGE(PG8_SA(0, 0), a2, voffA);
            PG8_WAIT_V(8); PG8_WAIT_L(0); PG8_BAR; PG8_MMA(1, 0, At, B0); PG8_MMA(1, 1, At, B1); PG8_BAR; PG8_SCHED;
            PG8_LDB(B0, 1, 0); PG8_LDB(B1, 1, 1); PG8_SCHED; PG8_LDA(At, 1, 0); PG8_STAGE(PG8_SA(0, 1), a2 + hstep, voffA);
            PG8_WAIT_V(8); PG8_WAIT_L(0); PG8_BAR; PG8_MMA(0, 0, At, B0); PG8_MMA(0, 1, At, B1); PG8_BAR; PG8_SCHED;
            PG8_LDA(At, 1, 1); PG8_STAGE(PG8_SB(1, 0), b3, voffB); PG8_STAGE(PG8_SB(1, 1), b3 + hstep, voffB); PG8_STAGE(PG8_SA(1, 0), a3, voffA);
            PG8_WAIT_V(8); PG8_WAIT_L(0); PG8_BAR; PG8_MMA(1, 0, At, B0); PG8_MMA(1, 1, At, B1); PG8_BAR; PG8_SCHED;
            } else {
            PG8_LDB(B0, 0, 0); PG8_SCHED; PG8_LDA(At, 0, 0); PG8_STAGE(PG8_SA(1, 1), a1 + hstep, voffA);
            PG8_WAIT_L(8); PG8_BAR; PG8_WAIT_L(0); PG8_MMA(0, 0, At, B0); PG8_BAR; PG8_SCHED;
            PG8_LDB(B1, 0, 1); PG8_STAGE(PG8_SB(0, 0), b2, voffB);
            PG8_BAR; PG8_WAIT_L(0); PG8_MMA(0, 1, At, B1); PG8_BAR;
            PG8_LDA(At, 0, 1); PG8_STAGE(PG8_SA(0, 0), a2, voffA);
            PG8_BAR; PG8_WAIT_L(0); PG8_MMA(1, 0, At, B0); PG8_BAR; PG8_SCHED;
            PG8_STAGE(PG8_SB(0, 1), b2 + hstep, voffB);
            PG8_WAIT_V(6); PG8_BAR; PG8_MMA(1, 1, At, B1); PG8_BAR;
            PG8_LDB(B0, 1, 0); PG8_SCHED; PG8_LDA(At, 1, 0); PG8_STAGE(PG8_SA(0, 1), a2 + hstep, voffA);
            PG8_WAIT_L(8); PG8_BAR; PG8_WAIT_L(0); PG8_MMA(0, 0, At, B0); PG8_BAR; PG8_SCHED;
            PG8_LDB(B1, 1, 1); PG8_STAGE(PG8_SB(1, 0), b3, voffB);
            PG8_BAR; PG8_WAIT_L(0); PG8_MMA(0, 1, At, B1); PG8_BAR;
            PG8_LDA(At, 1, 1); PG8_STAGE(PG8_SA(1, 0), a3, voffA);
            PG8_BAR; PG8_WAIT_L(0); PG8_MMA(1, 0, At, B0); PG8_BAR; PG8_SCHED;
            PG8_STAGE(PG8_SB(1, 1), b3 + hstep, voffB);
            PG8_WAIT_V(6); PG8_BAR; PG8_MMA(1, 1, At, B1); PG8_BAR;
            }
        }
        if constexpr (ALIGN_EPI) { if (wr == 0) PG8_BAR; }
        if constexpr (!Epi::AFTER_DRAIN) { E(acc, cur, wr, wc, fr, fq); S.done(cur); }
        if (!has_next) break;
#pragma unroll
        for (int a = 0; a < 2; ++a)
#pragma unroll
            for (int b = 0; b < 2; ++b)
#pragma unroll
                for (int m = 0; m < 4; ++m)
#pragma unroll
                    for (int n = 0; n < 2; ++n) acc[a][b][m][n] = (f32x4){0.f, 0.f, 0.f, 0.f};
        cur = nxt; cA = nA; cB = nB; ++ui;
        if constexpr (ALIGN_EPI) { if (wr == 1) PG8_BAR; }
    }
    PG8_WAIT_V(0);
    if constexpr (!ALIGN_EPI) { if (wr == 0) PG8_BAR; }
    PG8_BAR;
    if constexpr (Epi::AFTER_DRAIN) { E.fused(acc, cur, wr, wc, fr, fq, lds, wid, lane); S.done(cur); }
#undef PG8_SA
#undef PG8_SB
#undef PG8_STAGE
#undef PG8_LDA
#undef PG8_LDB
#undef PG8_MMA
#undef PG8_WAIT_V
#undef PG8_WAIT_L
#undef PG8_BAR
#undef PG8_SCHED
}
}
#define GAS __attribute__((address_space(1)))
#define LAS __attribute__((address_space(3)))
typedef unsigned short bf16;
typedef unsigned v4u __attribute__((ext_vector_type(4)));
typedef float f32x4 __attribute__((ext_vector_type(4)));
typedef short bf16x8 __attribute__((ext_vector_type(8)));
typedef GAS unsigned gu32;
typedef GAS unsigned long long gu64;
#define RLX_AGENT __ATOMIC_RELAXED, __HIP_MEMORY_SCOPE_AGENT
#define LDS_WAIT() asm volatile("s_waitcnt lgkmcnt(0)" ::: "memory")
#define VM_WAIT() asm volatile("s_waitcnt vmcnt(0)" ::: "memory")
__device__ __forceinline__ unsigned long long rt() { return __builtin_amdgcn_s_memrealtime(); }
__device__ __forceinline__ unsigned f2bf(float f) { unsigned u = __builtin_bit_cast(unsigned, f); return (u + 0x7fffu + ((u >> 16) & 1u)) >> 16; }
__device__ __forceinline__ unsigned pk2(float lo, float hi) { return f2bf(lo) | (f2bf(hi) << 16); }
typedef float f32x2v __attribute__((ext_vector_type(2)));

#define XB_TMO      128
#define XB_XCNT(j)  (256  + 64 * (j))
#define XB_XSUB(j)  (1280 + 64 * (j))
#define XB_XGEN(j)  (2304 + 64 * (j))
#define XB_TOP      3328
#define XB_TOPGEN   3392
#define XCD_BAR_WORDS 3456
#define XB_SPIN_CAP (1u << 24)

__device__ __forceinline__ unsigned xb_ld(unsigned* p)              { return __hip_atomic_load(p, __ATOMIC_RELAXED, __HIP_MEMORY_SCOPE_AGENT); }
__device__ __forceinline__ unsigned xb_add(unsigned* p, unsigned v) { return __hip_atomic_fetch_add(p, v, __ATOMIC_RELAXED, __HIP_MEMORY_SCOPE_AGENT); }
__device__ __forceinline__ unsigned xb_xcc_id() { return (unsigned)__builtin_amdgcn_s_getreg((3 << 11) | 20) & 0xFu; }
#define XB_SPIN(cond, bar) do { unsigned _sp = 0; while (cond) { __builtin_amdgcn_s_sleep(1); \
    if ((++_sp & 255u) == 0u) { if (xb_ld(&(bar)[XB_TMO])) break; if (_sp > XB_SPIN_CAP) { atomicAdd(&(bar)[XB_TMO], 1u); break; } } } } while (0)

struct XcdBarrier {
    unsigned* bar; unsigned x;
    volatile LAS unsigned* st;
};

__device__ __forceinline__ XcdBarrier xcd_barrier_post(unsigned* bar, volatile LAS unsigned* st) {
    XcdBarrier b; b.bar = bar; b.x = xb_xcc_id(); b.st = st;
    if (threadIdx.x == 0) (void)xb_add(&bar[XB_XCNT(b.x)], 1u);
    return b;
}
__device__ __forceinline__ void xcd_barrier_complete(unsigned* bar, unsigned x, unsigned& nloc, unsigned& nx) {
    const unsigned G = gridDim.x * gridDim.y * gridDim.z;
    unsigned sum, cnt, mine, sp = 0u;
    for (;;) {
        sum = 0u; cnt = 0u; mine = 0u;
#pragma unroll
        for (unsigned j = 0; j < 16; ++j) { const unsigned c = xb_ld(&bar[XB_XCNT(j)]); sum += c; cnt += (c > 0u) ? 1u : 0u; mine = (j == x) ? c : mine; }
        if (sum == G) break;
        __builtin_amdgcn_s_sleep(1);
        if ((++sp & 255u) == 0u) { if (xb_ld(&bar[XB_TMO])) break; if (sp > XB_SPIN_CAP) { atomicAdd(&bar[XB_TMO], 1u); break; } }
    }
    nloc = mine > 0u ? mine : 1u; nx = cnt > 0u ? cnt : 1u;
}

__device__ __forceinline__ void xcd_barrier(const XcdBarrier& b) {
    asm volatile("s_waitcnt vmcnt(0)" ::: "memory");
    __syncthreads();
    if (threadIdx.x == 0) {
        unsigned* bar = b.bar;
        __builtin_amdgcn_s_waitcnt(0);
        unsigned nloc = b.st[0], nx = b.st[1];
        if (nloc == 0u) { xcd_barrier_complete(bar, b.x, nloc, nx); b.st[0] = nloc; b.st[1] = nx; }
        const unsigned old = xb_add(&bar[XB_XSUB(b.x)], 1u);
        const unsigned gen = old / nloc;
        if (old + 1u == (gen + 1u) * nloc) {
            __builtin_amdgcn_fence(__ATOMIC_RELEASE, "agent");
            asm volatile("s_waitcnt vmcnt(0)" ::: "memory");
            const unsigned og = xb_add(&bar[XB_TOP], 1u);
            const unsigned tg = og / nx;
            if (og + 1u == (tg + 1u) * nx) xb_add(&bar[XB_TOPGEN], 1u);
            else XB_SPIN(xb_ld(&bar[XB_TOPGEN]) == tg, bar);
            __builtin_amdgcn_fence(__ATOMIC_ACQUIRE, "agent");
            xb_add(&bar[XB_XGEN(b.x)], 1u);
            asm volatile("s_waitcnt vmcnt(0)" ::: "memory");
        } else {
            XB_SPIN(xb_ld(&bar[XB_XGEN(b.x)]) == gen, bar);
            __builtin_amdgcn_fence(__ATOMIC_ACQUIRE, "agent");
            asm volatile("s_waitcnt vmcnt(0)" ::: "memory");
        }
    }
    __syncthreads();
}

constexpr int NWAVES = 8;
constexpr int NB = 4, SEQ = 4096, CTXL = 256, DM = 1024, ML = NB * SEQ, MC = NB * CTXL, MT = ML + MC;
constexpr int DFF = 2816, NUP = 2 * DFF, N0P = 3328, N1 = 6144;
constexpr float EPS = 1e-6f;
constexpr size_t MiB = 1u << 20;
constexpr size_t WS_CTL = 0, CTL_ZERO_BYTES = 64 * 1024;
constexpr size_t WS_MOD = 1 * MiB;
constexpr size_t WS_ROPE = 1 * MiB + 512 * 1024;
constexpr size_t WS_XC = 2 * MiB;
constexpr size_t WS_WIN1T = 8 * MiB;
constexpr size_t WS_H = 20 * MiB;
constexpr size_t WS_WIN0T = 54 * MiB, WS_WO0T = WS_WIN0T + 6656 * 1024, WS_WUPT0 = WS_WO0T + 2 * MiB, WS_WDNT0 = WS_WUPT0 + 11 * MiB;
constexpr size_t WS_NAQ = 79 * MiB, WS_NAK = 96 * MiB, WS_NAV = 113 * MiB;
constexpr size_t WS_GQ = 130 * MiB, WS_GK = WS_GQ + 8704 * 1024, WS_GV = 147 * MiB, WS_GR = 164 * MiB, WS_GA = 181 * MiB;
constexpr size_t WS_CAT = 184 * MiB;
constexpr size_t WS_X218 = 218 * MiB;
constexpr size_t WS_ACT0 = 80 * MiB, WS_EDGE0 = 174 * MiB;
constexpr size_t WS_WO1T = 252 * MiB;
constexpr size_t WS_RQ = 54 * MiB, WS_RK = 86 * MiB, WS_RV = 120 * MiB, WS_RG = 188 * MiB;
constexpr size_t WS_WUPT1 = 54 * MiB, WS_WDNT1 = 65 * MiB, WS_ACT1 = 72 * MiB, WS_EDGE1 = 160 * MiB;
constexpr size_t WS_END = 256 * MiB;
static_assert(WS_NAQ == pg8::PJ0_NAQ && WS_NAK == pg8::PJ0_NAK && WS_NAV == pg8::PJ0_NAV && WS_GQ == pg8::PJ0_GQ && WS_GK == pg8::PJ0_GK && WS_GV == pg8::PJ0_GV && WS_GR == pg8::PJ0_GR && WS_GA == pg8::PJ0_GA, "proj0 map");
static_assert(WS_RQ == pg8::PJ1_RQ && WS_RK == pg8::PJ1_RK && WS_RV == pg8::PJ1_RV && WS_RG == pg8::PJ1_RG && WS_ROPE == pg8::PJ1_ROPE, "proj1 map");
constexpr int CW_BAR = 4096;
constexpr int RING_OFF = 0, RING_BYTES = 131072, LDSCTL_OFF = RING_BYTES, MISC_OFF = LDSCTL_OFF + 320, LDS_BYTES = 147456;

struct Args { const float* in[26]; float* out; unsigned char* ws; int ph_lo, ph_hi; };
struct Frame {
    LAS unsigned char* lds; int tid, lane, wave, G, bid;
    const Args* a; float* out; unsigned char* ws;
};
#define IN_X 0
#define IN_C 1
#define IN_CTX 2
#define IN_CCTX 3
#define IN_WMOD 4
#define IN_BMOD 5
#define IN_N1G 6
#define IN_N2G 7
#define IN_WIN0 8
#define IN_WO0 9
#define IN_RPB 10
#define IN_WAF 11
#define IN_BAF 12
#define IN_WAB 13
#define IN_BAB 14
#define IN_GNG 15
#define IN_WIN1 16
#define IN_WO1 17
#define IN_DECF 18
#define IN_DECB 19
#define IN_RNG 20
#define IN_WUP 21
#define IN_CW 22
#define IN_CB 23
#define IN_WDN 24
#define IN_FNG 25

__device__ __forceinline__ int xcd_vcu(int bid, int G) { return (G % 8 == 0) ? (bid % 8) * (G / 8) + bid / 8 : bid; }
__device__ __forceinline__ float wave_sum(float v) {
#pragma unroll
    for (int o = 1; o < 64; o <<= 1) v += __shfl_xor(v, o);
    return v;
}
__device__ __forceinline__ float wave_max(float v) {
#pragma unroll
    for (int o = 1; o < 64; o <<= 1) v = fmaxf(v, __shfl_xor(v, o));
    return v;
}
__device__ __forceinline__ float bf2f(bf16 b) { return __builtin_bit_cast(float, (unsigned)b << 16); }
__device__ __forceinline__ float silu_f(float a) { return a / (1.0f + __expf(-a)); }
__device__ __forceinline__ float logsig_f(float z) { return fminf(z, 0.f) - log1pf(__expf(-fabsf(z))); }
__device__ __forceinline__ float logsig_fast(float z) { return fminf(z, 0.f) - __logf(1.0f + __expf(-fabsf(z))); }

struct MapId { int nsrc; __device__ __forceinline__ int operator()(int n) const { return n < nsrc ? n : -1; } };
struct MapUp { __device__ __forceinline__ int operator()(int n) const { return ((n >> 7) & 1) * DFF + (n >> 8) * 128 + (n & 127); } };
struct MapIn1 { __device__ __forceinline__ int operator()(int n) const {
    if (n >= 2048) return n;
    const int p = n & 127, wc = p >> 5, fq = (p >> 3) & 3, nn = (p >> 2) & 1, e = p & 3;
    return (n & ~127) + (wc >> 1) * 64 + nn * 32 + (wc & 1) * 16 + 4 * fq + e; } };
template <class MAP> __device__ __forceinline__ void transpose_item(const float* W, int K, int Nsrc, int Ndst, bf16* WT, LAS float* scr, int item, int lane, const MAP& map) {
    const int nblk = Ndst / 32, kb = item / nblk, nb = item % nblk, k0 = 64 * kb, n0 = 32 * nb;
    const int sc = map(n0 + (lane & 31));
#pragma unroll 8
    for (int i = 0; i < 32; ++i) { const int kk = 2 * i + (lane >> 5); scr[kk * 33 + (lane & 31)] = sc >= 0 ? W[(size_t)(k0 + kk) * Nsrc + sc] : 0.f; }
    LDS_WAIT(); asm volatile("" ::: "memory");
    const int c = lane & 7;
#pragma unroll
    for (int j = 0; j < 4; ++j) { const int n = (lane >> 3) + 8 * j; const LAS float* s = scr + (8 * c) * 33 + n;
        v4u o; o.x = pk2(s[0 * 33], s[1 * 33]); o.y = pk2(s[2 * 33], s[3 * 33]); o.z = pk2(s[4 * 33], s[5 * 33]); o.w = pk2(s[6 * 33], s[7 * 33]);
        *(GAS v4u*)(WT + (size_t)(n0 + n) * K + k0 + 8 * c) = o; }
    LDS_WAIT(); asm volatile("" ::: "memory");
}
template <class MAP> __device__ __forceinline__ void transpose_all(Frame& F, const float* W, int K, int Nsrc, int Ndst, bf16* WT, const MAP& map, int vbid = -1, int vG = 0) {
    LAS float* scr = (LAS float*)(F.lds + RING_OFF + F.wave * 16384);
    if (vbid < 0) { vbid = F.bid; vG = F.G; }
    const int gw = F.wave * vG + vbid, NGW = vG * NWAVES, nitems = (K / 64) * (Ndst / 32);
    for (int it = gw; it < nitems; it += NGW) transpose_item(W, K, Nsrc, Ndst, WT, scr, it, F.lane, map);
}

__device__ __forceinline__ void phase_prep(Frame& F) {
    unsigned char* ws = F.ws;
    transpose_all(F, F.a->in[IN_WIN0], 1024, 3104, N0P, (bf16*)(ws + WS_WIN0T), MapId{3104});
    transpose_all(F, F.a->in[IN_WO0], 1024, 1024, 1024, (bf16*)(ws + WS_WO0T), MapId{1024});
    __syncthreads();
    LAS float* sv = (LAS float*)(F.lds);
    LAS float* red = (LAS float*)(F.lds + 32768);
    for (int i = F.tid; i < 5 * 1024; i += 512) { const int bi = i >> 10, k = i & 1023; const float v = bi < 4 ? F.a->in[IN_C][bi * 1024 + k] : F.a->in[IN_CCTX][k]; sv[i] = silu_f(v); }
    __syncthreads();
    float* mod = (float*)(ws + WS_MOD);
    for (int it = F.bid; it < 2 * 192; it += F.G) {
        const int l = it / 192, n0 = (it % 192) * 32, c = F.tid & 31, kp = F.tid >> 5;
        const float* w = F.a->in[IN_WMOD] + (size_t)l * 1024 * 6144 + (size_t)(kp * 64) * 6144 + n0 + c;
        float a0 = 0.f, a1 = 0.f, a2 = 0.f, a3 = 0.f, a4 = 0.f;
#pragma unroll 16
        for (int kk = 0; kk < 64; ++kk) { const int k = kp * 64 + kk; const float wv = w[(size_t)kk * 6144];
            a0 += sv[k] * wv; a1 += sv[1024 + k] * wv; a2 += sv[2048 + k] * wv; a3 += sv[3072 + k] * wv; a4 += sv[4096 + k] * wv; }
        red[(kp * 5 + 0) * 32 + c] = a0; red[(kp * 5 + 1) * 32 + c] = a1; red[(kp * 5 + 2) * 32 + c] = a2; red[(kp * 5 + 3) * 32 + c] = a3; red[(kp * 5 + 4) * 32 + c] = a4;
        __syncthreads();
        if (F.tid < 160) { const int bi = F.tid >> 5, cc = F.tid & 31; float s = 0.f;
#pragma unroll
            for (int p = 0; p < 16; ++p) s += red[(p * 5 + bi) * 32 + cc];
            mod[((size_t)l * 5 + bi) * 6144 + n0 + cc] = s + F.a->in[IN_BMOD][l * 6144 + n0 + cc]; }
        __syncthreads();
    }
    if (F.bid == 0) { f32x2v* rope = (f32x2v*)(ws + WS_ROPE);
        for (int i = F.tid; i < 64 * 32; i += 512) { const int pos = i >> 5, f = i & 31; const float inv = powf(10000.f, -(float)(2 * f) / 64.f), ang = (float)pos * inv; rope[i] = (f32x2v){cosf(ang), sinf(ang)}; } }
}

__device__ __forceinline__ void phase_prep_late(Frame& F, int vbid, int vG) {
    unsigned char* ws = F.ws;
    __syncthreads();
    transpose_all(F, F.a->in[IN_WUP], 1024, NUP, NUP, (bf16*)(ws + WS_WUPT0), MapUp{}, vbid, vG);
    transpose_all(F, F.a->in[IN_WDN], DFF, 1024, 1024, (bf16*)(ws + WS_WDNT0), MapId{1024}, vbid, vG);
    transpose_all(F, F.a->in[IN_WIN1], 1024, N1, N1, (bf16*)(ws + WS_WIN1T), MapIn1{}, vbid, vG);
    transpose_all(F, F.a->in[IN_WO1], 2048, 1024, 1024, (bf16*)(ws + WS_WO1T), MapId{1024}, vbid, vG);
    __syncthreads();
}
__device__ __forceinline__ void phase_modnorm(Frame& F, const float* xl, const float* xc, int nrows, const float* g, const float* modl  , int shoff) {
    bf16* H = (bf16*)(F.ws + WS_H);
    const int gw = F.wave * F.G + F.bid, NGW = F.G * NWAVES;
    for (int m = gw; m < nrows; m += NGW) {
        const float* src = m < ML ? xl + (size_t)m * DM : xc + (size_t)(m - ML) * DM; const int bi = m < ML ? (m >> 12) : 4;
        const float* sh = modl + bi * 6144 + shoff; const float* sc = sh + 1024;
        f32x4 v[4]; float ss = 0.f;
#pragma unroll
        for (int j = 0; j < 4; ++j) { v[j] = *(const f32x4*)(src + 256 * j + 4 * F.lane); ss += (v[j].x * v[j].x + v[j].y * v[j].y) + (v[j].z * v[j].z + v[j].w * v[j].w); }
        const float rstd = 1.0f / sqrtf(wave_sum(ss) * (1.f / DM) + EPS);
#pragma unroll
        for (int j = 0; j < 4; ++j) { const int k = 256 * j + 4 * F.lane; const f32x4 gg = *(const f32x4*)(g + k), s1 = *(const f32x4*)(sc + k), s0 = *(const f32x4*)(sh + k);
            const f32x4 h = v[j] * rstd * gg * (s1 + 1.0f) + s0;
            *(unsigned long long*)(H + (size_t)m * DM + k) = (unsigned long long)pk2(h.x, h.y) | ((unsigned long long)pk2(h.z, h.w) << 32); }
    }
}
__device__ __forceinline__ void phase_final(Frame& F) {
    const float* g = F.a->in[IN_FNG]; const int gw = F.wave * F.G + F.bid, NGW = F.G * NWAVES;
    for (int m = gw; m < ML; m += NGW) { float* p = F.out + (size_t)m * DM; f32x4 v[4]; float ss = 0.f;
#pragma unroll
        for (int j = 0; j < 4; ++j) { v[j] = *(const f32x4*)(p + 256 * j + 4 * F.lane); ss += (v[j].x * v[j].x + v[j].y * v[j].y) + (v[j].z * v[j].z + v[j].w * v[j].w); }
        const float rstd = 1.0f / sqrtf(wave_sum(ss) * (1.f / DM) + EPS);
#pragma unroll
        for (int j = 0; j < 4; ++j) { const int k = 256 * j + 4 * F.lane; *(f32x4*)(p + k) = v[j] * rstd * *(const f32x4*)(g + k); } }
}
__device__ __forceinline__ void phase_fixup(Frame& F, const float* edge, bf16* act, int nblk, const float* cw, const float* cb) {
    const int total = nblk * 2 * (DFF / 4);
    for (int i = F.bid * 512 + F.tid; i < total; i += F.G * 512) {
        const int j = (i % (DFF / 4)) * 4, e = (i / (DFF / 4)) & 1, blk = i / (DFF / 2);
        const int row = blk * 64 + (e ? 63 : 0);
        bool has_prev = true, has_next = true;
        if (e == 0) { has_prev = row < ML ? (row & 4095) != 0 : ((row - ML) & 255) != 0; } else { has_next = row < ML ? (row & 4095) != 4095 : ((row - ML) & 255) != 255; }
        const float* pp = e == 0 ? edge + (size_t)((blk - 1) * 4 + 3) * NUP : edge + (size_t)(blk * 4 + 2) * NUP;
        const float* pc = edge + (size_t)(blk * 4 + (e ? 3 : 0)) * NUP;
        const float* pn = e == 0 ? edge + (size_t)(blk * 4 + 1) * NUP : edge + (size_t)((blk + 1) * 4 + 0) * NUP;
        f32x4 y[2];
#pragma unroll
        for (int h = 0; h < 2; ++h) { const int c = h * DFF + j; const f32x4 z = {0.f, 0.f, 0.f, 0.f};
            const f32x4 xp = has_prev ? *(const f32x4*)(pp + c) : z, xc = *(const f32x4*)(pc + c), xn = has_next ? *(const f32x4*)(pn + c) : z;
            y[h] = *(const f32x4*)(cw + c) * xp + *(const f32x4*)(cw + NUP + c) * xc + *(const f32x4*)(cw + 2 * NUP + c) * xn + *(const f32x4*)(cb + c); }
        f32x4 r;
#pragma unroll
        for (int q = 0; q < 4; ++q) r[q] = silu_f(y[0][q]) * y[1][q];
        *(unsigned long long*)(act + (size_t)row * DFF + j) = (unsigned long long)pk2(r.x, r.y) | ((unsigned long long)pk2(r.z, r.w) << 32);
    }
}
template <int K> __device__ __forceinline__ void ctx_gemm_res(Frame& F, const bf16* A, const bf16* Bt, const float* base, float* out, const float* gate) {
    const int lane = F.lane, w = F.wave, r16 = lane & 15, g = lane >> 4;
    constexpr int NS = K / 256;
    LAS f32x4* red = (LAS f32x4*)F.lds;
    for (int t = F.bid; t < 256; t += F.G) {
        const int tm = t >> 4, tn = t & 15;
        f32x4 acc[4][4];
#pragma unroll
        for (int m = 0; m < 4; ++m)
#pragma unroll
            for (int n = 0; n < 4; ++n) acc[m][n] = (f32x4){0.f, 0.f, 0.f, 0.f};
        const bf16* ap = A + (size_t)(64 * tm + r16) * K + w * (K / 8) + 8 * g;
        const bf16* bp = Bt + (size_t)(64 * tn + r16) * K + w * (K / 8) + 8 * g;
        constexpr int PD = 4;
        bf16x8 af[PD][4], bfr[PD][4];
#pragma unroll
        for (int p = 0; p < PD - 1; ++p)
            if (p < NS) {
#pragma unroll
                for (int m = 0; m < 4; ++m) { af[p][m] = *(const bf16x8*)(ap + (size_t)(16 * m) * K + 32 * p); bfr[p][m] = *(const bf16x8*)(bp + (size_t)(16 * m) * K + 32 * p); } }
#pragma unroll
        for (int s = 0; s < NS; ++s) {
            if (s + PD - 1 < NS) {
#pragma unroll
                for (int m = 0; m < 4; ++m) { af[(s + PD - 1) % PD][m] = *(const bf16x8*)(ap + (size_t)(16 * m) * K + 32 * (s + PD - 1)); bfr[(s + PD - 1) % PD][m] = *(const bf16x8*)(bp + (size_t)(16 * m) * K + 32 * (s + PD - 1)); } }
#pragma unroll
            for (int m = 0; m < 4; ++m)
#pragma unroll
                for (int n = 0; n < 4; ++n) acc[m][n] = __builtin_amdgcn_mfma_f32_16x16x32_bf16(af[s % PD][m], bfr[s % PD][n], acc[m][n], 0, 0, 0);
        }
        if (w > 0) {
#pragma unroll
            for (int m = 0; m < 4; ++m)
#pragma unroll
                for (int n = 0; n < 4; ++n) red[((w - 1) * 16 + m * 4 + n) * 64 + lane] = acc[m][n];
        }
        __syncthreads();
#pragma unroll
        for (int j = 0; j < 2; ++j) { const int tt = 2 * w + j, m = tt >> 2, n = tt & 3;
            f32x4 v = (f32x4){0.f, 0.f, 0.f, 0.f};
#pragma unroll
            for (int q = 0; q < 7; ++q) v = v + red[(q * 16 + tt) * 64 + lane];
            red[(7 * 16 + tt) * 64 + lane] = v; }
        __syncthreads();
        if (w == 0) {
#pragma unroll
            for (int m = 0; m < 4; ++m)
#pragma unroll
                for (int n = 0; n < 4; ++n) {
                    const f32x4 v = acc[m][n] + red[(7 * 16 + m * 4 + n) * 64 + lane];
                    const int col = 64 * tn + 16 * n + r16; const float gt = gate[col];
#pragma unroll
                    for (int e = 0; e < 4; ++e) { const size_t o = (size_t)(64 * tm + 16 * m + 4 * g + e) * 1024 + col; out[o] = base[o] + gt * v[e]; }
                }
        }
        __syncthreads();
    }
}
__device__ __forceinline__ void phase_na_simple(Frame& F) {
    const bf16* naq = (const bf16*)(F.ws + WS_NAQ); const bf16* nak = (const bf16*)(F.ws + WS_NAK); const bf16* nav = (const bf16*)(F.ws + WS_NAV);
    bf16* cat = (bf16*)(F.ws + WS_CAT); const float* rpb = F.a->in[IN_RPB];
    const int gw = F.wave * F.G + F.bid, NGW = F.G * NWAVES, ntask = NB * 8 * 4352, lane = F.lane;
    for (int t = gw; t < ntask; t += NGW) {
        const int qi = t % 4352, bh = t / 4352, h = bh & 7, b = bh >> 3; const bool lat = qi < 4096;
        const size_t hb = (size_t)bh * 4352;
        float q[64];
        { const v4u* qp = (const v4u*)(naq + (hb + qi) * 64);
#pragma unroll
          for (int j = 0; j < 8; ++j) { const v4u w = qp[j];
#pragma unroll
              for (int e = 0; e < 4; ++e) { q[8 * j + 2 * e] = __builtin_bit_cast(float, w[e] << 16); q[8 * j + 2 * e + 1] = __builtin_bit_cast(float, w[e] & 0xffff0000u); } } }
        const int qr = qi >> 6, qc = qi & 63, r0 = min(max(qr - 4, 0), 56), c0 = min(max(qc - 8, 0), 48);
        float sc[6]; float mx = -1e30f;
#pragma unroll
        for (int i = 0; i < 6; ++i) {
            const int kidx = lane + 64 * i; int tok; float bias = 0.f; bool valid = true;
            if (i < 2) { const int ki = r0 + (kidx >> 4), kj = c0 + (kidx & 15); tok = ki * 64 + kj; valid = lat; if (lat) bias = rpb[(h * 15 + (ki - qr + 7)) * 31 + (kj - qc + 15)]; }
            else tok = 4096 + kidx - 128;
            float d = 0.f;
            if (valid) { const v4u* kp = (const v4u*)(nak + (hb + tok) * 64);
#pragma unroll
                for (int j = 0; j < 8; ++j) { const v4u w = kp[j];
#pragma unroll
                    for (int e = 0; e < 4; ++e) { d += q[8 * j + 2 * e] * __builtin_bit_cast(float, w[e] << 16); d += q[8 * j + 2 * e + 1] * __builtin_bit_cast(float, w[e] & 0xffff0000u); } } }
            sc[i] = valid ? d + bias : -1e30f; mx = fmaxf(mx, sc[i]);
        }
        mx = wave_max(mx); float l = 0.f;
#pragma unroll
        for (int i = 0; i < 6; ++i) { sc[i] = sc[i] > -1e29f ? __expf(sc[i] - mx) : 0.f; l += sc[i]; }
        l = wave_sum(l);
        float o = 0.f;
#pragma unroll
        for (int i = 0; i < 6; ++i) {
            if (i < 2 && !lat) continue;
            for (int j = 0; j < 64; ++j) { const int kidx = j + 64 * i; int tok;
                if (i < 2) tok = (r0 + (kidx >> 4)) * 64 + c0 + (kidx & 15); else tok = 4096 + kidx - 128;
                o += __shfl(sc[i], j) * bf2f(nav[(hb + tok) * 64 + lane]); }
        }
        const int row = lat ? b * 4096 + qi : ML + b * 256 + (qi - 4096);
        cat[(size_t)row * 1024 + h * 64 + lane] = (bf16)f2bf(o / l);
    }
}
__device__ __forceinline__ void phase_gla_gates_simple(Frame& F) {
    const float* ga = (const float*)(F.ws + WS_GA); float* E = (float*)(F.ws + WS_H);
    const int total = 2 * MT * 256;
    for (int idx = F.bid * 512 + F.tid; idx < total; idx += F.G * 512) {
        const int c = idx & 255, m = (idx >> 8) % MT, dir = idx / (MT * 256);
        const float* w = (dir ? F.a->in[IN_WAB] : F.a->in[IN_WAF]); const float* g = ga + (size_t)m * 32 + dir * 16; float z = (dir ? F.a->in[IN_BAB] : F.a->in[IN_BAF])[c];
#pragma unroll
        for (int r = 0; r < 16; ++r) z += g[r] * w[r * 256 + c];
        E[idx] = __expf(logsig_f(z) * (1.f / 16.f));
    }
}
__device__ __forceinline__ int seq_row(int b, int p, int dir) {
    if (p < CTXL) return ML + b * CTXL + (dir ? CTXL - 1 - p : p);
    const int s = p - CTXL; return b * SEQ + (dir ? SEQ - 1 - s : s);
}
__device__ __forceinline__ void phase_gla_rec_simple(Frame& F) {
    const bf16* gq = (const bf16*)(F.ws + WS_GQ); const bf16* gk = (const bf16*)(F.ws + WS_GK); const bf16* gv = (const bf16*)(F.ws + WS_GV);
    const float* E = (const float*)(F.ws + WS_H);
    const int gw = F.wave * F.G + F.bid, NGW = F.G * NWAVES, lane = F.lane;
    for (int t = gw; t < 64; t += NGW) {
        const int dvg = t & 1, dir = (t >> 1) & 1, h = (t >> 2) & 3, b = t >> 4;
        float* O = (float*)(F.ws + (dir ? WS_NAQ : WS_X218));
        float S[64];
#pragma unroll
        for (int i = 0; i < 64; ++i) S[i] = 0.f;
        for (int p = 0; p < CTXL + SEQ; ++p) {
            const int m = __builtin_amdgcn_readfirstlane(seq_row(b, p, dir));
            const float v = bf2f(gv[(size_t)m * 512 + h * 128 + dvg * 64 + lane]);
            const float* e = E + ((size_t)dir * MT + m) * 256 + h * 64; const bf16* kp = gk + (size_t)m * 256 + h * 64; const bf16* qp = gq + (size_t)m * 256 + h * 64;
            float o = 0.f;
#pragma unroll
            for (int i = 0; i < 64; ++i) { S[i] = e[i] * S[i] + bf2f(kp[i]) * v; o += bf2f(qp[i]) * S[i]; }
            O[(size_t)m * 512 + h * 128 + dvg * 64 + lane] = o;
        }
    }
}
__device__ __forceinline__ void phase_gla_out_simple(Frame& F) {
    const float* Of = (const float*)(F.ws + WS_X218); const float* Ob = (const float*)(F.ws + WS_NAQ); const bf16* gr = (const bf16*)(F.ws + WS_GR); bf16* cat = (bf16*)(F.ws + WS_CAT);
    const float* gng = F.a->in[IN_GNG]; const int gw = F.wave * F.G + F.bid, NGW = F.G * NWAVES, lane = F.lane;
    for (int t = gw; t < MT * 4; t += NGW) { const int h = t & 3, m = t >> 2; const size_t o0 = (size_t)m * 512 + h * 128;
        const float a = Of[o0 + lane] + Ob[o0 + lane], c = Of[o0 + 64 + lane] + Ob[o0 + 64 + lane];
        const float rs = 1.0f / sqrtf(wave_sum(a * a + c * c) * (1.f / 128.f) + EPS);
        cat[(size_t)m * 1024 + 512 + h * 128 + lane] = (bf16)f2bf(a * rs * gng[lane] * silu_f(bf2f(gr[o0 + lane])));
        cat[(size_t)m * 1024 + 512 + h * 128 + 64 + lane] = (bf16)f2bf(c * rs * gng[64 + lane] * silu_f(bf2f(gr[o0 + 64 + lane]))); }
}
__device__ __forceinline__ void phase_ret_rec_simple(Frame& F, int hg) {
    const bf16* rq = (const bf16*)(F.ws + WS_RQ); const bf16* rk = (const bf16*)(F.ws + WS_RK); const bf16* rv = (const bf16*)(F.ws + WS_RV); bf16* O = (bf16*)(F.ws + WS_H);
    const int gw = F.wave * F.G + F.bid, NGW = F.G * NWAVES, lane = F.lane;
    for (int t = gw; t < 64; t += NGW) {
        const int dvg = t & 3, h4 = (t >> 2) & 3, b = t >> 4, h = hg * 4 + h4;
        for (int dir = 0; dir < 2; ++dir) {
            const float dec = (dir ? F.a->in[IN_DECB] : F.a->in[IN_DECF])[h]; const float gam = 1.0f / (1.0f + __expf(-dec));
            float S[128];
#pragma unroll
            for (int i = 0; i < 128; ++i) S[i] = 0.f;
            for (int p = 0; p < CTXL + SEQ; ++p) {
                const int m = __builtin_amdgcn_readfirstlane(seq_row(b, p, dir));
                const float v = bf2f(rv[(size_t)m * 2048 + h * 256 + dvg * 64 + lane]);
                const bf16* kp = rk + (size_t)m * 1024 + h * 128;
#pragma unroll
                for (int i = 0; i < 128; ++i) S[i] = gam * S[i] + bf2f(kp[i]) * v;
                if (m < ML) { const bf16* qp = rq + (size_t)m * 1024 + h * 128; float o = 0.f;
#pragma unroll
                    for (int i = 0; i < 128; ++i) o += bf2f(qp[i]) * S[i];
                    bf16* op = O + (size_t)m * 1024 + h4 * 256 + dvg * 64 + lane;
                    if (dir) o += bf2f(*op);
                    *op = (bf16)f2bf(o); }
            }
            asm volatile("s_waitcnt vmcnt(0)" ::: "memory");
        }
    }
}
__device__ __forceinline__ void phase_ret_out_simple(Frame& F, int hg) {
    const bf16* O = (const bf16*)(F.ws + WS_H); bf16* rg = (bf16*)(F.ws + WS_RG); const float* rng = F.a->in[IN_RNG];
    const int gw = F.wave * F.G + F.bid, NGW = F.G * NWAVES, lane = F.lane;
    for (int t = gw; t < ML * 4; t += NGW) { const int h4 = t & 3, m = t >> 2, h = hg * 4 + h4;
        float o[4]; float s = 0.f;
#pragma unroll
        for (int j = 0; j < 4; ++j) { o[j] = bf2f(O[(size_t)m * 1024 + h4 * 256 + 64 * j + lane]); s += o[j]; }
        const float mu = wave_sum(s) * (1.f / 256.f); float q = 0.f;
#pragma unroll
        for (int j = 0; j < 4; ++j) { o[j] -= mu; q += o[j] * o[j]; }
        const float rs = 1.0f / sqrtf(wave_sum(q) * (1.f / 256.f) + EPS);
#pragma unroll
        for (int j = 0; j < 4; ++j) { bf16* gp = rg + (size_t)m * 2048 + h * 256 + 64 * j + lane; *gp = (bf16)f2bf(o[j] * rs * rng[h * 256 + 64 * j + lane] * silu_f(bf2f(*gp))); } }
}

typedef short s16x4 __attribute__((ext_vector_type(4)));
typedef float f32x16 __attribute__((ext_vector_type(16)));
constexpr size_t WS_CK = 20 * MiB;
__device__ __forceinline__ bf16x8 tr_read8(LAS const unsigned char* p0, LAS const unsigned char* p1) {
    const s16x4 a = __builtin_amdgcn_ds_read_tr16_b64_v4i16((LAS s16x4*)p0), b = __builtin_amdgcn_ds_read_tr16_b64_v4i16((LAS s16x4*)p1);
    return __builtin_shufflevector(a, b, 0, 1, 2, 3, 4, 5, 6, 7);
}
__device__ __forceinline__ v4u scale8(v4u w, float s) {
    v4u o;
#pragma unroll
    for (int e = 0; e < 4; ++e) o[e] = pg8::cvt_pk_bf16(__builtin_bit_cast(float, w[e] << 16) * s, __builtin_bit_cast(float, w[e] & 0xffff0000u) * s);
    return o;
}
__device__ __forceinline__ int chunk_row(int b, int n, int dir) {
    if (n < 4) return ML + b * CTXL + 64 * (dir ? 3 - n : n);
    const int c = n - 4; return b * SEQ + 64 * (dir ? 63 - c : c);
}
__device__ __forceinline__ float log2_sigmoid(float d) { return -log2f(1.0f + __expf(-d)); }
__device__ __forceinline__ void phase_ret_scan(Frame& F) {
    const bf16* rk = (const bf16*)(F.ws + WS_RK); const bf16* rv = (const bf16*)(F.ws + WS_RV); bf16* ck = (bf16*)(F.ws + WS_CK);
    const int tid = F.tid, lane = F.lane, w = F.wave, srow = tid >> 3, sc8 = tid & 7;
    const int dvt = w >> 2, dkt = w & 3, r = lane & 31, hh = lane >> 5, gsub = (lane >> 4) & 1, i16 = lane & 15;
    constexpr int KS = 320, VS = 192, BUF = 64 * KS + 64 * VS;
    const int aoffV = (8 * hh + (i16 >> 2)) * VS + (32 * dvt + 16 * gsub + 4 * (i16 & 3)) * 2;
    const int aoffK = (8 * hh + (i16 >> 2)) * KS + (32 * dkt + 16 * gsub + 4 * (i16 & 3)) * 2;
    for (int unit = xcd_vcu(F.bid, F.G); unit < 256; unit += F.G) {
        const int dvs = unit & 3, dir = (unit >> 2) & 1, h = (unit >> 3) & 7, b = unit >> 6;
        const float lg2 = log2_sigmoid((dir ? F.a->in[IN_DECB] : F.a->in[IN_DECF])[h]);
        const float g64 = exp2f(64.f * lg2), wrow = exp2f(lg2 * (float)(dir ? srow : 63 - srow));
        f32x16 acc;
#pragma unroll
        for (int i = 0; i < 16; ++i) acc[i] = 0.f;
        struct SR { v4u k0, k1, v; } R0, R1, R2, R3;
#define RS_LOAD(R_, n_) do { if ((n_) < 68) { const int mb = chunk_row(b, (n_), dir); const v4u* kp = (const v4u*)(rk + (size_t)(mb + srow) * 1024 + h * 128 + sc8 * 16); R_.k0 = kp[0]; R_.k1 = kp[1]; \
            R_.v = *(const v4u*)(rv + (size_t)(mb + srow) * 2048 + h * 256 + dvs * 64 + sc8 * 8); } } while (0)
#define RS_STEP(R_, n_) do { const int n = (n_); LAS unsigned char* KL = F.lds + (n & 1) * BUF; LAS unsigned char* VL = KL + 64 * KS; \
            *(LAS v4u*)(KL + srow * KS + sc8 * 32) = R_.k0; *(LAS v4u*)(KL + srow * KS + sc8 * 32 + 16) = R_.k1; *(LAS v4u*)(VL + srow * VS + sc8 * 16) = scale8(R_.v, wrow); \
            RS_LOAD(R_, n + 4); \
            LDS_WAIT(); __builtin_amdgcn_s_barrier(); asm volatile("" ::: "memory"); \
            if (n >= 4 && ((n - 4) & 7) == 0) { const int i = (n - 4) >> 3, sc = dir ? 7 - i : i; \
                bf16* cp = ck + ((size_t)(((b * 8 + h) * 2 + dir) * 8 + sc) * 256 + dvs * 64 + 32 * dvt + 4 * hh) * 128 + 32 * dkt + r; \
                _Pragma("unroll") for (int e = 0; e < 16; ++e) cp[(size_t)((e & 3) + 8 * (e >> 2)) * 128] = (bf16)f2bf(acc[e]); } \
            _Pragma("unroll") for (int e = 0; e < 16; ++e) acc[e] *= g64; \
            _Pragma("unroll") for (int ks = 0; ks < 4; ++ks) { const bf16x8 A = tr_read8(VL + aoffV + 16 * ks * VS, VL + aoffV + (16 * ks + 4) * VS); \
                const bf16x8 B = tr_read8(KL + aoffK + 16 * ks * KS, KL + aoffK + (16 * ks + 4) * KS); acc = __builtin_amdgcn_mfma_f32_32x32x16_bf16(A, B, acc, 0, 0, 0); } } while (0)
        RS_LOAD(R0, 0); RS_LOAD(R1, 1); RS_LOAD(R2, 2); RS_LOAD(R3, 3);
        for (int n4 = 0; n4 < 68; n4 += 4) { RS_STEP(R0, n4); RS_STEP(R1, n4 + 1); RS_STEP(R2, n4 + 2); RS_STEP(R3, n4 + 3); }
#undef RS_STEP
#undef RS_LOAD
        __syncthreads();
    }
}
template <bool STORE = true> __device__ __forceinline__ void phase_ret_out(Frame& F) {
    const bf16* rq = (const bf16*)(F.ws + WS_RQ); const bf16* rk = (const bf16*)(F.ws + WS_RK); const bf16* rv = (const bf16*)(F.ws + WS_RV); const bf16* ck = (const bf16*)(F.ws + WS_CK);
    bf16* rg = (bf16*)(F.ws + WS_RG); const float* rng = F.a->in[IN_RNG];
    const int tid = F.tid, lane = F.lane, w = F.wave, srow = tid >> 3, sc8 = tid & 7, q16 = lane & 15, g = lane >> 4;
    constexpr int KS = 288, VS = 544, KB = 64 * KS, VB = 64 * VS, VOFF = 2 * KB, OS = 528;
    for (int unit = F.bid; unit < 1024; unit += F.G) {
        const int qb = unit & 31, h = (unit >> 5) & 7, b = unit >> 8, sc = qb >> 2, iq = qb & 3;
        const int tok0 = b * SEQ + 512 * sc;
        const int qrow = tok0 + 128 * iq + 16 * w + q16;
        const int qpos = 128 * iq + 16 * w + q16;
        bf16x8 Qraw[4];
#pragma unroll
        for (int ks = 0; ks < 4; ++ks) Qraw[ks] = *(const bf16x8*)(rq + (size_t)qrow * 1024 + h * 128 + 32 * ks + 8 * g);
        f32x4 o[16];
#pragma unroll
        for (int dt = 0; dt < 16; ++dt) o[dt] = (f32x4){0.f, 0.f, 0.f, 0.f};
#pragma unroll 1
        for (int dir = 0; dir < 2; ++dir) {
            const float lg2 = log2_sigmoid((dir ? F.a->in[IN_DECB] : F.a->in[IN_DECF])[h]);
            const float sq = exp2f(lg2 * (float)(dir ? 127 - (16 * w + q16) : 16 * w + q16));
            const float wk = exp2f(lg2 * (float)(dir ? srow : -srow));
            bf16x8 Qs[4];
#pragma unroll
            for (int ks = 0; ks < 4; ++ks) Qs[ks] = __builtin_bit_cast(bf16x8, scale8(__builtin_bit_cast(v4u, Qraw[ks]), sq));
            const int kb0 = dir ? 2 * iq : 0, nsteps = dir ? 8 - 2 * iq : 2 * iq + 2;
            v4u kr0, kr1, vr[4];
#define RO_LOAD(kb_) do { const int mrow = tok0 + 64 * (kb_) + srow; const v4u* kp = (const v4u*)(rk + (size_t)mrow * 1024 + h * 128 + sc8 * 16); kr0 = kp[0]; kr1 = kp[1]; \
                const v4u* vp = (const v4u*)(rv + (size_t)mrow * 2048 + h * 256 + sc8 * 32); vr[0] = vp[0]; vr[1] = vp[1]; vr[2] = vp[2]; vr[3] = vp[3]; } while (0)
#define RO_WRITE(buf_) do { LAS unsigned char* kl = F.lds + (buf_) * KB + srow * KS + sc8 * 32; *(LAS v4u*)kl = scale8(kr0, wk); *(LAS v4u*)(kl + 16) = scale8(kr1, wk); \
                LAS unsigned char* vl = F.lds + VOFF + (buf_) * VB + srow * VS + sc8 * 64; *(LAS v4u*)vl = vr[0]; *(LAS v4u*)(vl + 16) = vr[1]; *(LAS v4u*)(vl + 32) = vr[2]; *(LAS v4u*)(vl + 48) = vr[3]; } while (0)
            RO_LOAD(kb0); RO_WRITE(0);
            if (nsteps > 1) RO_LOAD(kb0 + 1);
            LDS_WAIT(); __builtin_amdgcn_s_barrier(); asm volatile("" ::: "memory");
            for (int i = 0; i < nsteps; ++i) {
                const int kb = kb0 + i, k0 = 64 * kb, buf = i & 1;
                const int wq0 = 128 * iq + 16 * w;
                const bool active = dir ? (k0 + 63 >= wq0) : (k0 <= wq0 + 15);
                if (active) {
                    LAS const unsigned char* KL = F.lds + buf * KB; LAS const unsigned char* VL = F.lds + VOFF + buf * VB;
                    const float fac = exp2f(lg2 * (float)(dir ? k0 - (128 * iq + 127) : 128 * iq - k0));
                    f32x4 p[4];
#pragma unroll
                    for (int kt = 0; kt < 4; ++kt) { p[kt] = (f32x4){0.f, 0.f, 0.f, 0.f};
#pragma unroll
                        for (int ks = 0; ks < 4; ++ks) { const bf16x8 A = *(LAS const bf16x8*)(KL + (16 * kt + q16) * KS + (32 * ks + 8 * g) * 2);
                            p[kt] = __builtin_amdgcn_mfma_f32_16x16x32_bf16(A, Qs[ks], p[kt], 0, 0, 0); } }
                    bf16x8 Pb[2];
#pragma unroll
                    for (int kk = 0; kk < 2; ++kk) { v4u pw;
#pragma unroll
                        for (int t2 = 0; t2 < 2; ++t2) { const int kt = 2 * kk + t2; float v[4];
#pragma unroll
                            for (int e = 0; e < 4; ++e) { const int kj = k0 + 16 * kt + 4 * g + e; const bool keep = dir ? (kj >= qpos) : (kj <= qpos); v[e] = keep ? p[kt][e] * fac : 0.f; }
                            pw[2 * t2] = pg8::cvt_pk_bf16(v[0], v[1]); pw[2 * t2 + 1] = pg8::cvt_pk_bf16(v[2], v[3]); }
                        Pb[kk] = __builtin_bit_cast(bf16x8, pw); }
#pragma unroll
                    for (int dt = 0; dt < 16; ++dt)
#pragma unroll
                        for (int kk = 0; kk < 2; ++kk) { LAS const unsigned char* vp = VL + (32 * kk + 4 * g + (q16 >> 2)) * VS + (16 * dt + 4 * (q16 & 3)) * 2;
                            o[dt] = __builtin_amdgcn_mfma_f32_16x16x32_bf16(tr_read8(vp, vp + 16 * VS), Pb[kk], o[dt], 0, 0, 0); }
                }
                if (i + 1 < nsteps) { RO_WRITE(buf ^ 1); if (i + 2 < nsteps) RO_LOAD(kb + 2); }
                LDS_WAIT(); __builtin_amdgcn_s_barrier(); asm volatile("" ::: "memory");
            }
            { const bf16* cp = ck + ((size_t)(((b * 8 + h) * 2 + dir) * 8 + sc) * 256 + (tid >> 1)) * 128 + (tid & 1) * 64; LAS unsigned char* cl = F.lds + (tid >> 1) * KS + (tid & 1) * 128;
              v4u t8[8];
#pragma unroll
              for (int j = 0; j < 8; ++j) t8[j] = ((const v4u*)cp)[j];
#pragma unroll
              for (int j = 0; j < 8; ++j) *(LAS v4u*)(cl + 16 * j) = t8[j]; }
            const float fi = exp2f(lg2 * (float)(dir ? 512 - (128 * iq + 127) : 128 * iq + 1));
            bf16x8 Qi[4];
#pragma unroll
            for (int ks = 0; ks < 4; ++ks) Qi[ks] = __builtin_bit_cast(bf16x8, scale8(__builtin_bit_cast(v4u, Qraw[ks]), sq * fi));
            LDS_WAIT(); __builtin_amdgcn_s_barrier(); asm volatile("" ::: "memory");
#pragma unroll
            for (int dt = 0; dt < 16; ++dt)
#pragma unroll
                for (int ks = 0; ks < 4; ++ks) { const bf16x8 A = *(LAS const bf16x8*)(F.lds + (16 * dt + q16) * KS + (32 * ks + 8 * g) * 2);
                    o[dt] = __builtin_amdgcn_mfma_f32_16x16x32_bf16(A, Qi[ks], o[dt], 0, 0, 0); }
            LDS_WAIT(); __builtin_amdgcn_s_barrier(); asm volatile("" ::: "memory");
        }
#undef RO_LOAD
#undef RO_WRITE
        float s = 0.f;
#pragma unroll
        for (int dt = 0; dt < 16; ++dt) s += (o[dt][0] + o[dt][1]) + (o[dt][2] + o[dt][3]);
        s += __shfl_xor(s, 16); s += __shfl_xor(s, 32);
        const float mu = s * (1.f / 256.f); float qv = 0.f;
#pragma unroll
        for (int dt = 0; dt < 16; ++dt) { o[dt] = o[dt] - mu; qv += (o[dt][0] * o[dt][0] + o[dt][1] * o[dt][1]) + (o[dt][2] * o[dt][2] + o[dt][3] * o[dt][3]); }
        qv += __shfl_xor(qv, 16); qv += __shfl_xor(qv, 32);
        const float rs = 1.0f / sqrtf(qv * (1.f / 256.f) + EPS);
        LAS unsigned char* ol = F.lds + w * (16 * OS);
#pragma unroll
        for (int dt = 0; dt < 16; ++dt) { const f32x4 gg = *(const f32x4*)(rng + h * 256 + 16 * dt + 4 * g); const f32x4 y = o[dt] * rs * gg;
            *(LAS unsigned long long*)(ol + q16 * OS + (16 * dt + 4 * g) * 2) = (unsigned long long)pg8::cvt_pk_bf16(y[0], y[1]) | ((unsigned long long)pg8::cvt_pk_bf16(y[2], y[3]) << 32); }
        LDS_WAIT(); asm volatile("" ::: "memory");
        { const int rr = lane >> 2, c4 = lane & 3; bf16* gp = rg + (size_t)(tok0 + 128 * iq + 16 * w + rr) * 2048 + h * 256;
#pragma unroll
          for (int j = 0; j < 8; ++j) { const int ch = 4 * j + c4; const v4u yv = *(LAS const v4u*)(ol + rr * OS + ch * 16); const v4u gv = *(const v4u*)(gp + ch * 8); v4u ov;
#pragma unroll
              for (int e = 0; e < 4; ++e) { const float y0 = __builtin_bit_cast(float, yv[e] << 16), y1 = __builtin_bit_cast(float, yv[e] & 0xffff0000u), g0 = __builtin_bit_cast(float, gv[e] << 16), g1 = __builtin_bit_cast(float, gv[e] & 0xffff0000u);
                  ov[e] = pg8::cvt_pk_bf16(y0 * silu_f(g0), y1 * silu_f(g1)); }
              if (STORE) *(v4u*)(gp + ch * 8) = ov; else asm volatile("" :: "v"(ov)); } }
        __syncthreads();
    }
}

template <bool STORE = true, int SKIP = 0> __device__ __forceinline__ void phase_ret_out2(Frame& F) {
    const bf16* rq = (const bf16*)(F.ws + WS_RQ); const bf16* rk = (const bf16*)(F.ws + WS_RK); const bf16* rv = (const bf16*)(F.ws + WS_RV); const bf16* ck = (const bf16*)(F.ws + WS_CK);
    bf16* rg = (bf16*)(F.ws + WS_RG); const float* rng = F.a->in[IN_RNG];
    const int tid = F.tid, lane = F.lane, w = F.wave, srow = tid >> 3, sc8 = tid & 7, r = lane & 31, hh = lane >> 5, gsub = (lane >> 4) & 1, i16 = lane & 15, qg = w & 3, dvh = w >> 2;
    constexpr int KS = 272, VS = 576, KB = 64 * KS, VB = 64 * VS, VOFF = 2 * KB, OS = 272, REDOFF = 110592;
    const int voff = (4 * hh + (i16 >> 2)) * VS + (128 * dvh + 16 * gsub + 4 * (i16 & 3)) * 2;
    for (int unit = xcd_vcu(F.bid, F.G); unit < 1024; unit += F.G) {
        const int qb = unit & 31, h = (unit >> 5) & 7, b = unit >> 8, sc = qb >> 2, iq = qb & 3;
        const int tok0 = b * SEQ + 512 * sc;
        const int wq0 = 128 * iq + 32 * qg, qpos = wq0 + r;
        const bf16* qp = rq + (size_t)(tok0 + qpos) * 1024 + h * 128 + 8 * hh;
        f32x16 o[4];
#pragma unroll
        for (int dt = 0; dt < 4; ++dt)
#pragma unroll
            for (int e = 0; e < 16; ++e) o[dt][e] = 0.f;
#pragma unroll 1
        for (int dir = 0; dir < 2; ++dir) {
            const float lg2 = log2_sigmoid((dir ? F.a->in[IN_DECB] : F.a->in[IN_DECF])[h]);
            const float sq = exp2f(lg2 * (float)(dir ? 127 - (32 * qg + r) : 32 * qg + r));
            const float wk = exp2f(lg2 * (float)(dir ? srow : -srow));
            bf16x8 Qs[8];
#pragma unroll
            for (int ks = 0; ks < 8; ++ks) Qs[ks] = __builtin_bit_cast(bf16x8, scale8(*(const v4u*)(qp + 16 * ks), sq));
            const int kb0 = dir ? 2 * iq : 0, nsteps = dir ? 8 - 2 * iq : 2 * iq + 2;
            v4u kr0, kr1, vr[4];
#define RO_LOAD(kb_) do { const int mrow = tok0 + 64 * (kb_) + srow; const v4u* kp = (const v4u*)(rk + (size_t)mrow * 1024 + h * 128) + sc8; kr0 = kp[0]; kr1 = kp[8]; \
                const v4u* vp = (const v4u*)(rv + (size_t)mrow * 2048 + h * 256) + sc8; vr[0] = vp[0]; vr[1] = vp[8]; vr[2] = vp[16]; vr[3] = vp[24]; } while (0)
#define RO_WRITE(buf_, kb_) do { const float wkf = wk * exp2f(lg2 * (float)(dir ? 64 * (kb_) - (128 * iq + 127) : 128 * iq - 64 * (kb_))); LAS unsigned char* kl = F.lds + (buf_) * KB + srow * KS + sc8 * 16; *(LAS v4u*)kl = scale8(kr0, wkf); *(LAS v4u*)(kl + 128) = scale8(kr1, wkf); \
                LAS unsigned char* vl = F.lds + VOFF + (buf_) * VB + srow * VS + sc8 * 16; *(LAS v4u*)vl = vr[0]; *(LAS v4u*)(vl + 128) = vr[1]; *(LAS v4u*)(vl + 256) = vr[2]; *(LAS v4u*)(vl + 384) = vr[3]; } while (0)
            RO_LOAD(kb0); RO_WRITE(0, kb0);
            if (nsteps > 1) RO_LOAD(kb0 + 1);
            LDS_WAIT(); __builtin_amdgcn_s_barrier(); asm volatile("" ::: "memory");
            for (int i = 0; i < nsteps; ++i) {
                const int kb = kb0 + i, k0 = 64 * kb, buf = i & 1;
                const bool active = dir ? (k0 + 63 >= wq0) : (k0 <= wq0 + 31);
                if (active && !(SKIP & 1)) {
                    LAS const unsigned char* KL = F.lds + buf * KB; LAS const unsigned char* VL = F.lds + VOFF + buf * VB;
#pragma unroll
                    for (int kt = 0; kt < 2; ++kt) {
                        const bool tact = dir ? (k0 + 32 * kt + 31 >= wq0) : (k0 + 32 * kt <= wq0 + 31);
                        if (tact) {
                            f32x16 p;
#pragma unroll
                            for (int e = 0; e < 16; ++e) p[e] = 0.f;
#pragma unroll
                            for (int ks = 0; ks < 8; ++ks) { const bf16x8 A = *(LAS const bf16x8*)(KL + (32 * kt + r) * KS + (16 * ks + 8 * hh) * 2);
                                p = __builtin_amdgcn_mfma_f32_32x32x16_bf16(A, Qs[ks], p, 0, 0, 0); }
                            const bool full = dir ? (k0 + 32 * kt >= wq0 + 31) : (k0 + 32 * kt + 31 <= wq0);
                            if (!full) { const int dd = qpos - k0 - 32 * kt - 4 * hh;
#pragma unroll
                                for (int e = 0; e < 16; ++e) { const int c = (e & 3) + 8 * (e >> 2); const bool keep = dir ? (c >= dd) : (c <= dd); p[e] = keep ? p[e] : 0.f; } }
#pragma unroll
                            for (int s2 = 0; s2 < 2; ++s2) { v4u pw;
#pragma unroll
                                for (int j = 0; j < 4; ++j) pw[j] = pg8::cvt_pk_bf16(p[8 * s2 + 2 * j], p[8 * s2 + 2 * j + 1]);
                                const bf16x8 Pb = __builtin_bit_cast(bf16x8, pw);
#pragma unroll
                                for (int dt = 0; dt < 4; ++dt) { LAS const unsigned char* vp = VL + voff + (32 * kt + 16 * s2) * VS + 64 * dt;
                                    o[dt] = __builtin_amdgcn_mfma_f32_32x32x16_bf16(tr_read8(vp, vp + 8 * VS), Pb, o[dt], 0, 0, 0); }
                            }
                        }
                    }
                }
                if (i + 1 < nsteps) { RO_WRITE(buf ^ 1, kb + 1); if (i + 2 < nsteps) RO_LOAD(kb + 2); }
                LDS_WAIT(); __builtin_amdgcn_s_barrier(); asm volatile("" ::: "memory");
            }
            { const bf16* cp = ck + ((size_t)(((b * 8 + h) * 2 + dir) * 8 + sc) * 256 + (tid >> 1)) * 128 + (tid & 1) * 64; LAS unsigned char* cl = F.lds + (tid >> 1) * KS + (tid & 1) * 128;
              v4u t8[8];
#pragma unroll
              for (int j = 0; j < 8; ++j) t8[j] = ((const v4u*)cp)[j];
#pragma unroll
              for (int j = 0; j < 8; ++j) *(LAS v4u*)(cl + 16 * j) = t8[j]; }
            const float fi = exp2f(lg2 * (float)(dir ? 512 - (128 * iq + 127) : 128 * iq + 1));
#pragma unroll
            for (int ks = 0; ks < 8; ++ks) Qs[ks] = __builtin_bit_cast(bf16x8, scale8(*(const v4u*)(qp + 16 * ks), sq * fi));
            LDS_WAIT(); __builtin_amdgcn_s_barrier(); asm volatile("" ::: "memory");
            if (!(SKIP & 2))
#pragma unroll
            for (int dt = 0; dt < 4; ++dt)
#pragma unroll
                for (int ks = 0; ks < 8; ++ks) { const bf16x8 A = *(LAS const bf16x8*)(F.lds + (128 * dvh + 32 * dt + r) * KS + (16 * ks + 8 * hh) * 2);
                    o[dt] = __builtin_amdgcn_mfma_f32_32x32x16_bf16(A, Qs[ks], o[dt], 0, 0, 0); }
            LDS_WAIT(); __builtin_amdgcn_s_barrier(); asm volatile("" ::: "memory");
        }
#undef RO_LOAD
#undef RO_WRITE
        float s1 = 0.f, s2v = 0.f;
#pragma unroll
        for (int dt = 0; dt < 4; ++dt)
#pragma unroll
            for (int e = 0; e < 16; ++e) { s1 += o[dt][e]; s2v += o[dt][e] * o[dt][e]; }
        s1 += __shfl_xor(s1, 32); s2v += __shfl_xor(s2v, 32);
        LAS f32x2v* red = (LAS f32x2v*)(F.lds + REDOFF);
        if (hh == 0) red[dvh * 128 + 32 * qg + r] = (f32x2v){s1, s2v};
        LDS_WAIT(); __builtin_amdgcn_s_barrier(); asm volatile("" ::: "memory");
        { const f32x2v ot2 = red[(dvh ^ 1) * 128 + 32 * qg + r]; s1 += ot2.x; s2v += ot2.y; }
        const float mu = s1 * (1.f / 256.f), rs = 1.0f / sqrtf(fmaxf(s2v * (1.f / 256.f) - mu * mu, 0.f) + EPS);
        LAS unsigned char* ol = F.lds + w * (32 * OS);
#pragma unroll
        for (int dt = 0; dt < 4; ++dt)
#pragma unroll
            for (int q4 = 0; q4 < 4; ++q4) { const int dv = 32 * dt + 8 * q4 + 4 * hh; const f32x4 gg = *(const f32x4*)(rng + h * 256 + 128 * dvh + dv);
                const float y0 = (o[dt][4 * q4] - mu) * rs * gg[0], y1 = (o[dt][4 * q4 + 1] - mu) * rs * gg[1], y2 = (o[dt][4 * q4 + 2] - mu) * rs * gg[2], y3 = (o[dt][4 * q4 + 3] - mu) * rs * gg[3];
                *(LAS unsigned long long*)(ol + r * OS + dv * 2) = (unsigned long long)pg8::cvt_pk_bf16(y0, y1) | ((unsigned long long)pg8::cvt_pk_bf16(y2, y3) << 32); }
        LDS_WAIT(); asm volatile("" ::: "memory");
        { const int rr = lane >> 1, c2 = lane & 1; bf16* gp = rg + (size_t)(tok0 + wq0 + rr) * 2048 + h * 256 + 128 * dvh;
#pragma unroll
          for (int j = 0; j < 8; ++j) { const int ch = 2 * j + c2; const v4u yv = *(LAS const v4u*)(ol + rr * OS + ch * 16); const v4u gv = *(const v4u*)(gp + ch * 8); v4u ov;
#pragma unroll
              for (int e = 0; e < 4; ++e) { const float y0 = __builtin_bit_cast(float, yv[e] << 16), y1 = __builtin_bit_cast(float, yv[e] & 0xffff0000u), g0 = __builtin_bit_cast(float, gv[e] << 16), g1 = __builtin_bit_cast(float, gv[e] & 0xffff0000u);
                  ov[e] = pg8::cvt_pk_bf16(y0 * silu_f(g0), y1 * silu_f(g1)); }
              if (STORE) *(v4u*)(gp + ch * 8) = ov; else asm volatile("" :: "v"(ov)); } }
        __syncthreads();
    }
}

constexpr size_t WS_QINB = 218 * MiB, WS_KINB = WS_QINB + 8704 * 1024, WS_GDEC = 236 * MiB;
constexpr size_t WS_SST = 20 * MiB;
__device__ __forceinline__ int gla_chunk_row(int b, int cm) { return cm < 4 ? ML + b * CTXL + 64 * cm : b * SEQ + 64 * (cm - 4); }
template <bool STORE = true> __device__ __forceinline__ void phase_gla_prep(Frame& F) {
    bf16* gq = (bf16*)(F.ws + WS_GQ); bf16* gk = (bf16*)(F.ws + WS_GK); bf16* qb = (bf16*)(F.ws + WS_QINB); bf16* kb = (bf16*)(F.ws + WS_KINB);
    const float* ga = (const float*)(F.ws + WS_GA); float* gdec = (float*)(F.ws + WS_GDEC);
    LAS float* gal = (LAS float*)F.lds;
    LAS float* tot = (LAS float*)(F.lds + 8192);
    const int tid = F.tid, c = tid & 63, jg = tid >> 6;
    for (int unit = F.bid; unit < 16 * 68; unit += F.G) {
        const int cm = unit % 68, bh = unit / 68, h = bh & 3, b = bh >> 2, mb = gla_chunk_row(b, cm);
        *(LAS v4u*)(F.lds + tid * 16) = *(const v4u*)(ga + (size_t)mb * 32 + tid * 4);
        float wf[16], wb[16];
#pragma unroll
        for (int r = 0; r < 16; ++r) { wf[r] = F.a->in[IN_WAF][r * 256 + h * 64 + c]; wb[r] = F.a->in[IN_WAB][r * 256 + h * 64 + c]; }
        const float bf_ = F.a->in[IN_BAF][h * 64 + c], bb_ = F.a->in[IN_BAB][h * 64 + c];
        float q[8], k[8];
#pragma unroll
        for (int i = 0; i < 8; ++i) { const size_t o = (size_t)(mb + 8 * jg + i) * 256 + h * 64 + c; q[i] = bf2f(gq[o]); k[i] = bf2f(gk[o]); }
        __syncthreads();
        float lf[8], lb[8];
#pragma unroll
        for (int i = 0; i < 8; ++i) { const LAS float* gr_ = gal + (8 * jg + i) * 32; float zf = bf_, zb = bb_;
#pragma unroll
            for (int r = 0; r < 16; ++r) { zf += gr_[r] * wf[r]; zb += gr_[16 + r] * wb[r]; }
            lf[i] = logsig_fast(zf) * (1.f / 16.f); lb[i] = logsig_fast(zb) * (1.f / 16.f); }
#pragma unroll
        for (int i = 1; i < 8; ++i) lf[i] += lf[i - 1];
#pragma unroll
        for (int i = 6; i >= 0; --i) lb[i] += lb[i + 1];
        tot[jg * 64 + c] = lf[7]; tot[512 + jg * 64 + c] = lb[0];
        __syncthreads();
        float offf = 0.f, offb = 0.f, totf = 0.f, totb = 0.f;
#pragma unroll
        for (int g2 = 0; g2 < 8; ++g2) { const float tf = tot[g2 * 64 + c], tb = tot[512 + g2 * 64 + c]; totf += tf; totb += tb; if (g2 < jg) offf += tf; if (g2 > jg) offb += tb; }
#pragma unroll
        for (int i = 0; i < 8; ++i) { const size_t o = (size_t)(mb + 8 * jg + i) * 256 + h * 64 + c; const float bfv = lf[i] + offf, bbv = lb[i] + offb;
            const unsigned a0 = f2bf(q[i] * __expf(bfv)), a1 = f2bf(k[i] * __expf(-bfv)), a2 = f2bf(q[i] * __expf(bbv)), a3 = f2bf(k[i] * __expf(-bbv));
            if (STORE) { gq[o] = (bf16)a0; gk[o] = (bf16)a1; qb[o] = (bf16)a2; kb[o] = (bf16)a3; } else asm volatile("" :: "v"(a0), "v"(a1), "v"(a2), "v"(a3)); }
        if (jg == 0) { gdec[((size_t)(0 * 16 + bh) * 68 + cm) * 64 + c] = __expf(totf); gdec[((size_t)(1 * 16 + bh) * 68 + cm) * 64 + c] = __expf(totb); }
        __syncthreads();
    }
}
__device__ __forceinline__ void phase_gla_scan(Frame& F) {
    const bf16* gv = (const bf16*)(F.ws + WS_GV); bf16* sst = (bf16*)(F.ws + WS_SST); const float* gdec = (const float*)(F.ws + WS_GDEC);
    const int tid = F.tid, lane = F.lane, w = F.wave, srow = tid >> 3, sc8 = tid & 7;
    const int dvt = w >> 1, dkt = w & 1, r = lane & 31, hh = lane >> 5, gsub = (lane >> 4) & 1, i16 = lane & 15;
    constexpr int KS = 192, VS = 320, BUF = 64 * KS + 64 * VS;
    const int aoffV = (8 * hh + (i16 >> 2)) * VS + (32 * dvt + 16 * gsub + 4 * (i16 & 3)) * 2;
    const int aoffK = (8 * hh + (i16 >> 2)) * KS + (32 * dkt + 16 * gsub + 4 * (i16 & 3)) * 2;
    for (int unit = F.bid; unit < 32; unit += F.G) {
        const int dir = unit & 1, bh = unit >> 1, h = bh & 3, b = bh >> 2;
        const bf16* kin = (const bf16*)(F.ws + (dir ? WS_KINB : WS_GK));
        f32x16 acc;
#pragma unroll
        for (int i = 0; i < 16; ++i) acc[i] = 0.f;
        struct GR { v4u k, v0, v1; f32x4 d[4]; } R0, R1, R2, R3;
#define GS_CM(n_) ((n_) < 4 ? (dir ? 3 - (n_) : (n_)) : 4 + (dir ? 63 - ((n_) - 4) : (n_) - 4))
#define GS_LOAD(R_, n_) do { if ((n_) < 68) { const int cm_ = GS_CM(n_), mb_ = gla_chunk_row(b, cm_); R_.k = *(const v4u*)(kin + (size_t)(mb_ + srow) * 256 + h * 64 + sc8 * 8); \
            const v4u* vp_ = (const v4u*)(gv + (size_t)(mb_ + srow) * 512 + h * 128 + sc8 * 16); R_.v0 = vp_[0]; R_.v1 = vp_[1]; \
            const float* dp_ = gdec + ((size_t)(dir * 16 + bh) * 68 + cm_) * 64 + 32 * dkt + 4 * hh; R_.d[0] = *(const f32x4*)dp_; R_.d[1] = *(const f32x4*)(dp_ + 8); R_.d[2] = *(const f32x4*)(dp_ + 16); R_.d[3] = *(const f32x4*)(dp_ + 24); } } while (0)
#define GS_STEP(R_, n_) do { const int n = (n_); LAS unsigned char* KL = F.lds + (n & 1) * BUF; LAS unsigned char* VL = KL + 64 * KS; \
            *(LAS v4u*)(KL + srow * KS + sc8 * 16) = R_.k; *(LAS v4u*)(VL + srow * VS + sc8 * 32) = R_.v0; *(LAS v4u*)(VL + srow * VS + sc8 * 32 + 16) = R_.v1; \
            f32x4 dcur[4]; _Pragma("unroll") for (int q = 0; q < 4; ++q) dcur[q] = R_.d[q]; \
            const int cm = GS_CM(n); \
            GS_LOAD(R_, n + 4); \
            LDS_WAIT(); __builtin_amdgcn_s_barrier(); asm volatile("" ::: "memory"); \
            { v4u* cp = (v4u*)(sst + ((size_t)((bh * 2 + dir) * 68 + cm) * 8192 + (size_t)(w * 64 + lane) * 16)); v4u s0, s1; \
              _Pragma("unroll") for (int j = 0; j < 4; ++j) { s0[j] = pg8::cvt_pk_bf16(acc[2 * j], acc[2 * j + 1]); s1[j] = pg8::cvt_pk_bf16(acc[8 + 2 * j], acc[8 + 2 * j + 1]); } \
              cp[0] = s0; cp[1] = s1; } \
            _Pragma("unroll") for (int ks = 0; ks < 4; ++ks) { const bf16x8 A = tr_read8(KL + aoffK + 16 * ks * KS, KL + aoffK + (16 * ks + 4) * KS); \
                const bf16x8 B = tr_read8(VL + aoffV + 16 * ks * VS, VL + aoffV + (16 * ks + 4) * VS); acc = __builtin_amdgcn_mfma_f32_32x32x16_bf16(A, B, acc, 0, 0, 0); } \
            _Pragma("unroll") for (int e = 0; e < 16; ++e) acc[e] *= dcur[e >> 2][e & 3]; } while (0)
        GS_LOAD(R0, 0); GS_LOAD(R1, 1); GS_LOAD(R2, 2); GS_LOAD(R3, 3);
        for (int n4 = 0; n4 < 68; n4 += 4) { GS_STEP(R0, n4); GS_STEP(R1, n4 + 1); GS_STEP(R2, n4 + 2); GS_STEP(R3, n4 + 3); }
#undef GS_STEP
#undef GS_LOAD
#undef GS_CM
        __syncthreads();
    }
}
__device__ __forceinline__ void phase_gla_out(Frame& F) {
    const bf16* gv = (const bf16*)(F.ws + WS_GV); const bf16* gr = (const bf16*)(F.ws + WS_GR); const bf16* sst = (const bf16*)(F.ws + WS_SST); bf16* cat = (bf16*)(F.ws + WS_CAT);
    const float* gng = F.a->in[IN_GNG];
    const int tid = F.tid, lane = F.lane, w = F.wave, q16 = lane & 15, g = lane >> 4, wc = w >> 2;
    constexpr int KS = 160, VS = 288, SS = 160, OS = 272;
    constexpr int KOFF = 0, VOFF = 4 * 64 * KS  , SOFF = VOFF + 2 * 64 * VS  ;
    for (int unit = F.bid; unit < 16 * 34; unit += F.G) {
        const int c2 = unit % 34, bh = unit / 34, h = bh & 3, b = bh >> 2;
        const int cm0 = 2 * c2, mb = gla_chunk_row(b, cm0);
        { const int row = tid >> 2, c4 = tid & 3;
#pragma unroll
          for (int d = 0; d < 2; ++d) { const bf16* kin = (const bf16*)(F.ws + (d ? WS_KINB : WS_GK)) + (size_t)(mb + row) * 256 + h * 64 + c4 * 16; const v4u a0 = ((const v4u*)kin)[0], a1 = ((const v4u*)kin)[1];
              LAS unsigned char* kl = F.lds + KOFF + (d * 128 + row) * KS + c4 * 32; *(LAS v4u*)kl = a0; *(LAS v4u*)(kl + 16) = a1; }
          const v4u* vp = (const v4u*)(gv + (size_t)(mb + row) * 512 + h * 128 + c4 * 32); LAS unsigned char* vl = F.lds + VOFF + row * VS + c4 * 64;
#pragma unroll
          for (int j = 0; j < 4; ++j) *(LAS v4u*)(vl + 16 * j) = vp[j]; }
        const int qrow = mb + 16 * w + q16, qj = 16 * (w & 3) + q16;
        f32x4 o[8];
#pragma unroll
        for (int dt = 0; dt < 8; ++dt) o[dt] = (f32x4){0.f, 0.f, 0.f, 0.f};
#pragma unroll 1
        for (int dir = 0; dir < 2; ++dir) {
            { const int fw = tid >> 6, fl = tid & 63, fdvt = fw >> 1, fdkt = fw & 1, fr = fl & 31, fhh = fl >> 5;
#pragma unroll
              for (int c = 0; c < 2; ++c) { const v4u* sp = (const v4u*)(sst + ((size_t)((bh * 2 + dir) * 68 + cm0 + c) * 8192 + (size_t)tid * 16)); const v4u s0 = sp[0], s1 = sp[1];
                  LAS unsigned char* sl = F.lds + SOFF + (c * 128 + 32 * fdvt + fr) * SS + (32 * fdkt + 4 * fhh) * 2;
                  *(LAS unsigned long long*)(sl) = (unsigned long long)s0[0] | ((unsigned long long)s0[1] << 32); *(LAS unsigned long long*)(sl + 16) = (unsigned long long)s0[2] | ((unsigned long long)s0[3] << 32);
                  *(LAS unsigned long long*)(sl + 32) = (unsigned long long)s1[0] | ((unsigned long long)s1[1] << 32); *(LAS unsigned long long*)(sl + 48) = (unsigned long long)s1[2] | ((unsigned long long)s1[3] << 32); } }
            const bf16* qin = (const bf16*)(F.ws + (dir ? WS_QINB : WS_GQ)) + (size_t)qrow * 256 + h * 64 + 8 * g;
            bf16x8 Q[2]; Q[0] = *(const bf16x8*)qin; Q[1] = *(const bf16x8*)(qin + 32);
            LDS_WAIT(); __builtin_amdgcn_s_barrier(); asm volatile("" ::: "memory");
            LAS const unsigned char* KL = F.lds + KOFF + (dir * 128 + wc * 64) * KS; LAS const unsigned char* VL = F.lds + VOFF + wc * 64 * VS; LAS const unsigned char* SL = F.lds + SOFF + wc * 128 * SS;
            const int wq0 = 16 * (w & 3);
            f32x4 p[4];
#pragma unroll
            for (int kt = 0; kt < 4; ++kt) { p[kt] = (f32x4){0.f, 0.f, 0.f, 0.f};
                const bool act = dir ? (16 * kt + 15 >= wq0) : (16 * kt <= wq0 + 15);
                if (act) {
#pragma unroll
                    for (int ks = 0; ks < 2; ++ks) { const bf16x8 A = *(LAS const bf16x8*)(KL + (16 * kt + q16) * KS + (32 * ks + 8 * g) * 2);
                        p[kt] = __builtin_amdgcn_mfma_f32_16x16x32_bf16(A, Q[ks], p[kt], 0, 0, 0); } } }
            bf16x8 Pb[2];
#pragma unroll
            for (int kk = 0; kk < 2; ++kk) { v4u pw;
#pragma unroll
                for (int t2 = 0; t2 < 2; ++t2) { const int kt = 2 * kk + t2; float v[4];
#pragma unroll
                    for (int e = 0; e < 4; ++e) { const int kj = 16 * kt + 4 * g + e; const bool keep = dir ? (kj >= qj) : (kj <= qj); v[e] = keep ? p[kt][e] : 0.f; }
                    pw[2 * t2] = pg8::cvt_pk_bf16(v[0], v[1]); pw[2 * t2 + 1] = pg8::cvt_pk_bf16(v[2], v[3]); }
                Pb[kk] = __builtin_bit_cast(bf16x8, pw); }
#pragma unroll
            for (int dt = 0; dt < 8; ++dt) {
#pragma unroll
                for (int kk = 0; kk < 2; ++kk) { LAS const unsigned char* vp = VL + (32 * kk + 4 * g + (q16 >> 2)) * VS + (16 * dt + 4 * (q16 & 3)) * 2;
                    o[dt] = __builtin_amdgcn_mfma_f32_16x16x32_bf16(tr_read8(vp, vp + 16 * VS), Pb[kk], o[dt], 0, 0, 0); }
#pragma unroll
                for (int ks = 0; ks < 2; ++ks) { const bf16x8 A = *(LAS const bf16x8*)(SL + (16 * dt + q16) * SS + (32 * ks + 8 * g) * 2);
                    o[dt] = __builtin_amdgcn_mfma_f32_16x16x32_bf16(A, Q[ks], o[dt], 0, 0, 0); }
            }
            LDS_WAIT(); __builtin_amdgcn_s_barrier(); asm volatile("" ::: "memory");
        }
        float s = 0.f;
#pragma unroll
        for (int dt = 0; dt < 8; ++dt) s += (o[dt][0] * o[dt][0] + o[dt][1] * o[dt][1]) + (o[dt][2] * o[dt][2] + o[dt][3] * o[dt][3]);
        s += __shfl_xor(s, 16); s += __shfl_xor(s, 32);
        const float rs = 1.0f / sqrtf(s * (1.f / 128.f) + EPS);
        LAS unsigned char* ol = F.lds + w * (16 * OS);
#pragma unroll
        for (int dt = 0; dt < 8; ++dt) { const f32x4 gg = *(const f32x4*)(gng + 16 * dt + 4 * g); const f32x4 y = o[dt] * rs * gg;
            *(LAS unsigned long long*)(ol + q16 * OS + (16 * dt + 4 * g) * 2) = (unsigned long long)pg8::cvt_pk_bf16(y[0], y[1]) | ((unsigned long long)pg8::cvt_pk_bf16(y[2], y[3]) << 32); }
        LDS_WAIT(); asm volatile("" ::: "memory");
        { const int rr = lane >> 2, c4 = lane & 3; const size_t row = (size_t)(mb + 16 * w + rr);
#pragma unroll
          for (int j = 0; j < 4; ++j) { const int ch = 4 * j + c4; const v4u yv = *(LAS const v4u*)(ol + rr * OS + ch * 16); const v4u gv_ = *(const v4u*)(gr + row * 512 + h * 128 + ch * 8); v4u ov;
#pragma unroll
              for (int e = 0; e < 4; ++e) { const float y0 = __builtin_bit_cast(float, yv[e] << 16), y1 = __builtin_bit_cast(float, yv[e] & 0xffff0000u), g0 = __builtin_bit_cast(float, gv_[e] << 16), g1 = __builtin_bit_cast(float, gv_[e] & 0xffff0000u);
                  ov[e] = pg8::cvt_pk_bf16(y0 * silu_f(g0), y1 * silu_f(g1)); }
              *(v4u*)(cat + row * 1024 + 512 + h * 128 + ch * 8) = ov; } }
        __syncthreads();
    }
}

__device__ __forceinline__ void phase_na(Frame& F, int vbid, int vG) {
    const bf16* naq = (const bf16*)(F.ws + WS_NAQ); const bf16* nak = (const bf16*)(F.ws + WS_NAK); const bf16* nav = (const bf16*)(F.ws + WS_NAV); bf16* cat = (bf16*)(F.ws + WS_CAT);
    const int lane = F.lane, h = F.wave, r = lane & 31, hh = lane >> 5, gsub = (lane >> 4) & 1, i16 = lane & 15;
    constexpr int VSTR = 192; constexpr float LOG2E = 1.4426950408889634f;
    LAS unsigned char* VL = F.lds + h * 8192; LAS float* RB = (LAS float*)(F.lds + h * 8192 + 6144);
    for (int i = lane; i < 465; i += 64) RB[16 + i] = F.a->in[IN_RPB][h * 465 + i] * LOG2E;
    const int voff = (4 * hh + (i16 >> 2)) * VSTR + (16 * gsub + 4 * (i16 & 3)) * 2;
    for (int unit = xcd_vcu(vbid, vG); unit < 272; unit += vG) {
        const bool lat = unit < 256; int b, R = 0, C = 0, qt = 0;
        if (lat) { b = unit >> 6; R = ((unit >> 2) & 15) * 4; C = (unit & 3) * 16; } else { b = (unit - 256) >> 2; qt = (unit - 256) & 3; }
        const size_t hb = (size_t)(b * 8 + h) * 4352;
        int qtok[2], qr[2], qc[2];
#pragma unroll
        for (int ct = 0; ct < 2; ++ct) { const int i = 32 * ct + r; qr[ct] = R + (i >> 4); qc[ct] = C + (i & 15); qtok[ct] = lat ? qr[ct] * 64 + qc[ct] : 4096 + 64 * qt + i; }
        bf16x8 Q[2][4];
#pragma unroll
        for (int ct = 0; ct < 2; ++ct)
#pragma unroll
            for (int ks = 0; ks < 4; ++ks) Q[ct][ks] = *(const bf16x8*)(naq + (hb + qtok[ct]) * 64 + 16 * ks + 8 * hh);
        const int rlo = min(max(R - 4, 0), 56), rhi = min(max(R - 1, 0), 56) + 7, cstart = min(max(C - 8, 0), 32);
        const int nblk = lat ? 8 + (rhi - rlo + 1) : 8;
        int r0q[2], klo[2];
#pragma unroll
        for (int ct = 0; ct < 2; ++ct) { r0q[ct] = min(max(qr[ct] - 4, 0), 56); klo[ct] = min(max(qc[ct] - 8, 0), 48) - cstart; }
        f32x16 ot[2][2];
#pragma unroll
        for (int a = 0; a < 2; ++a)
#pragma unroll
            for (int c = 0; c < 2; ++c)
#pragma unroll
                for (int e = 0; e < 16; ++e) ot[a][c][e] = 0.f;
        float mrun[2] = {-1e30f, -1e30f}, lrun[2] = {0.f, 0.f};
        bf16x8 Kf[4]; v4u Vr[4];
#define NA_KTOK(i_) ((i_) < 8 ? 4096 + 32 * (i_) : (rlo + (i_) - 8) * 64 + cstart)
#define NA_LOAD(i_) do { const int kt_ = NA_KTOK(i_); const bf16* kp_ = nak + (hb + kt_ + r) * 64 + 8 * hh; \
            Kf[0] = *(const bf16x8*)kp_; Kf[1] = *(const bf16x8*)(kp_ + 16); Kf[2] = *(const bf16x8*)(kp_ + 32); Kf[3] = *(const bf16x8*)(kp_ + 48); \
            const v4u* vp_ = (const v4u*)(nav + (hb + kt_) * 64) + lane; Vr[0] = vp_[0]; Vr[1] = vp_[64]; Vr[2] = vp_[128]; Vr[3] = vp_[192]; } while (0)
        NA_LOAD(0);
        for (int i = 0; i < nblk; ++i) {
#pragma unroll
            for (int j = 0; j < 4; ++j) { const int idx = lane + 64 * j; *(LAS v4u*)(VL + (idx >> 3) * VSTR + (idx & 7) * 16) = Vr[j]; }
            f32x16 st[2];
#pragma unroll
            for (int ct = 0; ct < 2; ++ct) {
#pragma unroll
                for (int e = 0; e < 16; ++e) st[ct][e] = 0.f;
#pragma unroll
                for (int ks = 0; ks < 4; ++ks) st[ct] = __builtin_amdgcn_mfma_f32_32x32x16_bf16(Kf[ks], Q[ct][ks], st[ct], 0, 0, 0);
            }
            const int kr = rlo + i - 8;
            if (i + 1 < nblk) NA_LOAD(i + 1);
            bf16x8 Pb[2][2];
#pragma unroll
            for (int ct = 0; ct < 2; ++ct) {
                float mx = -1e30f;
                if (i < 8) {
#pragma unroll
                    for (int e = 0; e < 16; ++e) { st[ct][e] *= LOG2E; mx = fmaxf(mx, st[ct][e]); }
                } else {
                    const bool rowok = (kr >= r0q[ct]) && (kr <= r0q[ct] + 7);
                    const LAS float* bp = RB + 16 + (kr - qr[ct] + 7) * 31 + cstart - qc[ct] + 15 + 4 * hh;
#pragma unroll
                    for (int e = 0; e < 16; ++e) { const int kk = (e & 3) + 8 * (e >> 2); const bool ok = rowok && ((unsigned)(kk + 4 * hh - klo[ct]) < 16u);
                        const float v = st[ct][e] * LOG2E + bp[kk]; st[ct][e] = ok ? v : -1e30f; mx = fmaxf(mx, st[ct][e]); }
                }
                mx = fmaxf(mx, __shfl_xor(mx, 32));
                const float mnew = fmaxf(mrun[ct], mx), alpha = exp2f(mrun[ct] - mnew); mrun[ct] = mnew;
                float ls = 0.f;
#pragma unroll
                for (int e = 0; e < 16; ++e) { const float p = exp2f(st[ct][e] - mnew); st[ct][e] = p; ls += p; }
                lrun[ct] = lrun[ct] * alpha + ls;
#pragma unroll
                for (int dt = 0; dt < 2; ++dt)
#pragma unroll
                    for (int e = 0; e < 16; ++e) ot[dt][ct][e] *= alpha;
#pragma unroll
                for (int s = 0; s < 2; ++s) { v4u pw;
#pragma unroll
                    for (int j = 0; j < 4; ++j) pw[j] = pg8::cvt_pk_bf16(st[ct][8 * s + 2 * j], st[ct][8 * s + 2 * j + 1]);
                    Pb[ct][s] = __builtin_bit_cast(bf16x8, pw); }
            }
#pragma unroll
            for (int dt = 0; dt < 2; ++dt)
#pragma unroll
                for (int s = 0; s < 2; ++s) { LAS const unsigned char* vp = VL + voff + 16 * s * VSTR + 64 * dt;
                    const bf16x8 A = tr_read8(vp, vp + 8 * VSTR);
                    ot[dt][0] = __builtin_amdgcn_mfma_f32_32x32x16_bf16(A, Pb[0][s], ot[dt][0], 0, 0, 0);
                    ot[dt][1] = __builtin_amdgcn_mfma_f32_32x32x16_bf16(A, Pb[1][s], ot[dt][1], 0, 0, 0); }
        }
#undef NA_LOAD
#undef NA_KTOK
#pragma unroll
        for (int ct = 0; ct < 2; ++ct) {
            const float inv = 1.0f / (lrun[ct] + __shfl_xor(lrun[ct], 32));
            const int row = lat ? b * SEQ + qtok[ct] : ML + b * CTXL + (qtok[ct] - 4096);
#pragma unroll
            for (int dt = 0; dt < 2; ++dt)
#pragma unroll
                for (int q4 = 0; q4 < 4; ++q4) { const int d = 32 * dt + 8 * q4 + 4 * hh;
                    *(unsigned long long*)(cat + (size_t)row * 1024 + h * 64 + d) = (unsigned long long)pg8::cvt_pk_bf16(ot[dt][ct][4 * q4] * inv, ot[dt][ct][4 * q4 + 1] * inv)
                        | ((unsigned long long)pg8::cvt_pk_bf16(ot[dt][ct][4 * q4 + 2] * inv, ot[dt][ct][4 * q4 + 3] * inv) << 32); }
        }
    }
    __syncthreads();
}

constexpr int NPHASE = 23;
#ifndef NA_SIMPLE
#define NA_SIMPLE 0
#endif
#ifndef GLA_SIMPLE
#define GLA_SIMPLE 0
#endif
#ifndef RET_SIMPLE
#define RET_SIMPLE 0
#endif
__global__ void __launch_bounds__(NWAVES * 64, 2) mk_fwd(Args args) {
    extern __shared__ __attribute__((aligned(16))) unsigned char lds[];
    Frame F;
    F.lds = (LAS unsigned char*)lds; F.tid = threadIdx.x; F.lane = F.tid & 63; F.wave = __builtin_amdgcn_readfirstlane(F.tid >> 6); F.G = gridDim.x; F.bid = blockIdx.x;
    F.a = &args;
    F.out = args.out; F.ws = args.ws;
    unsigned char* ws = args.ws;
    for (int u = F.tid; u < (LDS_BYTES - LDSCTL_OFF) / 4; u += NWAVES * 64) ((LAS unsigned*)(F.lds + LDSCTL_OFF))[u] = 0u;
    __syncthreads();
    const int lo = args.ph_lo, hi = args.ph_hi;
    XcdBarrier bar; bar.bar = (unsigned*)(ws + WS_CTL) + CW_BAR; bar.x = 0; bar.st = nullptr;
    if (hi - lo > 1) bar = xcd_barrier_post((unsigned*)(ws + WS_CTL) + CW_BAR, (volatile LAS unsigned*)(F.lds + MISC_OFF) + 8);
    float* mod = (float*)(ws + WS_MOD); float* xc = (float*)(ws + WS_XC); bf16* H = (bf16*)(ws + WS_H);
#define IN(k) (lo <= (k) && (k) < hi)
#define SEAM(k) do { if ((k) + 1 < hi) xcd_barrier(bar); } while (0)
#define GEMM_RES(ph_, A_, Bt_, M_, K_, bL_, bC_, gate_) do { pg8::Gemm g{(const bf16*)(A_), (const bf16*)(Bt_), (M_), 1024, (K_)}; pg8::StaticOrder S; S.init((M_), 1024, F.G, F.bid); \
        pg8::EpiRes E{(bL_), (bC_), F.out, xc, (gate_)}; pg8::gemm_phase<pg8::EpiRes, pg8::StaticOrder, true, true>(F.lds + RING_OFF, g, S, E); } while (0)
#define GEMM_UP(l_, M_) do { pg8::Gemm g{H, (const bf16*)(ws + ((l_) ? WS_WUPT1 : WS_WUPT0)), (M_), NUP, 1024}; pg8::StaticOrder S; S.init((M_), NUP, F.G, F.bid); \
        pg8::EpiUp E{(bf16*)(ws + ((l_) ? WS_ACT1 : WS_ACT0)), (float*)(ws + ((l_) ? WS_EDGE1 : WS_EDGE0)), F.a->in[IN_CW] + (l_) * 3 * NUP, F.a->in[IN_CB] + (l_) * NUP}; \
        pg8::gemm_phase<pg8::EpiUp, pg8::StaticOrder, true, true>(F.lds + RING_OFF, g, S, E); } while (0)
    if (IN(0)) { phase_prep(F); SEAM(0); }
    if (IN(1)) { phase_modnorm(F, F.a->in[IN_X], F.a->in[IN_CTX], MT, F.a->in[IN_N1G], mod, 0); SEAM(1); }
    if (IN(2)) { pg8::Gemm g{H, (const bf16*)(ws + WS_WIN0T), MT, N0P, 1024}; pg8::StaticOrder S; S.init(MT, N0P, F.G, F.bid);
        pg8::EpiProj0 E{ws}; pg8::gemm_phase<pg8::EpiProj0, pg8::StaticOrder, true, true>(F.lds + RING_OFF, g, S, E); SEAM(2); }
#if GLA_SIMPLE
    if (IN(3)) { phase_na_simple(F); phase_gla_gates_simple(F); SEAM(3); }
    if (IN(4)) { phase_gla_rec_simple(F); SEAM(4); }
    if (IN(5)) { phase_gla_out_simple(F); SEAM(5); }
#else
#if NA_SIMPLE
    if (IN(3)) { phase_gla_prep(F); phase_na_simple(F); SEAM(3); }
    if (IN(4)) { phase_gla_scan(F); SEAM(4); }
#else
    if (IN(3)) { phase_gla_prep(F); SEAM(3); }
    if (IN(4)) { if (F.G >= 64) { if (F.bid < 32) phase_gla_scan(F); else { phase_prep_late(F, F.bid - 32, F.G - 32); phase_na(F, F.bid - 32, F.G - 32); } } else { phase_gla_scan(F); phase_na(F, F.bid, F.G); phase_prep_late(F, F.bid, F.G); } SEAM(4); }
#endif
    if (IN(5)) { phase_gla_out(F); SEAM(5); }
#endif
    if (IN(6)) { GEMM_RES(6, ws + WS_CAT, ws + WS_WO0T, ML, 1024, F.a->in[IN_X], F.a->in[IN_CTX], mod + 2048);
        ctx_gemm_res<1024>(F, (const bf16*)(ws + WS_CAT) + (size_t)ML * 1024, (const bf16*)(ws + WS_WO0T), F.a->in[IN_CTX], xc, mod + 4 * 6144 + 2048); SEAM(6); }
    if (IN(7)) { phase_modnorm(F, F.out, xc, MT, F.a->in[IN_N2G], mod, 3072); SEAM(7); }
    if (IN(8)) { GEMM_UP(0, MT); SEAM(8); }
    if (IN(9)) { phase_fixup(F, (const float*)(ws + WS_EDGE0), (bf16*)(ws + WS_ACT0), MT / 64, F.a->in[IN_CW], F.a->in[IN_CB]); SEAM(9); }
    if (IN(10)) { GEMM_RES(10, ws + WS_ACT0, ws + WS_WDNT0, ML, DFF, F.out, xc, mod + 5120);
        ctx_gemm_res<DFF>(F, (const bf16*)(ws + WS_ACT0) + (size_t)ML * DFF, (const bf16*)(ws + WS_WDNT0), xc, xc, mod + 4 * 6144 + 5120); SEAM(10); }
    if (IN(11)) { phase_modnorm(F, F.out, xc, MT, F.a->in[IN_N1G] + 1024, mod + 5 * 6144, 0); SEAM(11); }
    if (IN(12)) { pg8::Gemm g{H, (const bf16*)(ws + WS_WIN1T), MT, N1, 1024}; pg8::StaticOrder S; S.init(MT, N1, F.G, F.bid);
        pg8::EpiProj1 E{ws}; pg8::gemm_phase<pg8::EpiProj1, pg8::StaticOrder, true, true>(F.lds + RING_OFF, g, S, E); SEAM(12); }
#if RET_SIMPLE
    if (IN(13)) { phase_ret_rec_simple(F, 0); SEAM(13); }
    if (IN(14)) { phase_ret_out_simple(F, 0); SEAM(14); }
    if (IN(15)) { phase_ret_rec_simple(F, 1); SEAM(15); }
    if (IN(16)) { phase_ret_out_simple(F, 1); SEAM(16); }
#else
    if (IN(13)) { phase_ret_scan(F); SEAM(13); }
    if (IN(14)) { phase_ret_out2(F); SEAM(14); }
#endif
    if (IN(17)) {
        transpose_all(F, F.a->in[IN_WUP] + (size_t)1024 * NUP, 1024, NUP, NUP, (bf16*)(ws + WS_WUPT1), MapUp{});
        transpose_all(F, F.a->in[IN_WDN] + (size_t)DFF * 1024, DFF, 1024, 1024, (bf16*)(ws + WS_WDNT1), MapId{1024});
        __syncthreads();
        GEMM_RES(17, ws + WS_RG, ws + WS_WO1T, ML, 2048, F.out, xc, mod + 5 * 6144 + 2048); SEAM(17); }
    if (IN(18)) { phase_modnorm(F, F.out, xc, ML, F.a->in[IN_N2G] + 1024, mod + 5 * 6144, 3072); SEAM(18); }
    if (IN(19)) { GEMM_UP(1, ML); SEAM(19); }
    if (IN(20)) { phase_fixup(F, (const float*)(ws + WS_EDGE1), (bf16*)(ws + WS_ACT1), ML / 64, F.a->in[IN_CW] + 3 * NUP, F.a->in[IN_CB] + NUP); SEAM(20); }
    if (IN(21)) { GEMM_RES(21, ws + WS_ACT1, ws + WS_WDNT1, ML, DFF, F.out, xc, mod + 5 * 6144 + 5120); SEAM(21); }
    if (IN(22)) { phase_final(F); }
}

#ifndef MK_ONE_LAUNCH
#define MK_ONE_LAUNCH 1
#endif
extern "C" void kernel_launch(void* const* d_in, const int* in_sizes, int n_in, void* d_out, int out_size, void* d_ws, size_t ws_size, hipStream_t stream) {
    static int grid = 0;
    if (grid == 0) {
        if (n_in != 26 || out_size != ML * DM || ws_size < WS_END) { fprintf(stderr, "kernel_launch: unexpected shapes: n_in %d out %d ws %zu\n", n_in, out_size, ws_size); grid = -1; return; }
        int dev = 0, cus = 0, per_cu = 0;
        if (hipGetDevice(&dev) != hipSuccess || hipDeviceGetAttribute(&cus, hipDeviceAttributeMultiprocessorCount, dev) != hipSuccess) { grid = -1; return; }
        if (hipFuncSetAttribute((const void*)mk_fwd, hipFuncAttributeMaxDynamicSharedMemorySize, LDS_BYTES) != hipSuccess) { fprintf(stderr, "kernel_launch: hipFuncSetAttribute failed\n"); grid = -1; return; }
        if (hipOccupancyMaxActiveBlocksPerMultiprocessor(&per_cu, (const void*)mk_fwd, NWAVES * 64, LDS_BYTES) != hipSuccess || per_cu < 1) { fprintf(stderr, "kernel_launch: occupancy query says %d blocks per CU\n", per_cu); }
        (void)hipGetLastError();
        grid = cus;
    }
    if (grid < 0) return;
    (void)hipMemsetAsync((char*)d_ws + WS_CTL, 0, CTL_ZERO_BYTES, stream);
    Args a{};
    for (int i = 0; i < 26; ++i) a.in[i] = (const float*)d_in[i];
    a.out = (float*)d_out; a.ws = (unsigned char*)d_ws;
#if MK_ONE_LAUNCH
    a.ph_lo = 0; a.ph_hi = NPHASE;
    void* kargs[] = {&a};
    hipError_t e = hipLaunchCooperativeKernel((const void*)mk_fwd, dim3(grid), dim3(NWAVES * 64), kargs, LDS_BYTES, stream);
    if (e != hipSuccess) fprintf(stderr, "kernel_launch: cooperative launch failed: %s\n", hipGetErrorString(e));
#else
    for (int ph = 0; ph < NPHASE; ++ph) { a.ph_lo = ph; a.ph_hi = ph + 1; hipLaunchKernelGGL(mk_fwd, dim3(grid), dim3(NWAVES * 64), LDS_BYTES, stream, a); }
#endif
}
```
